# Optimizing an MI355X kernel written in HIP

```python
import jax, jax.numpy as jnp
from jax import lax
import numpy as np

D_MODEL = 1024
BATCH = 4
SEQ = 4096
DEPTH = 2

CHUNK = 64
Q_BLOCK = 128
HEAD_DIM = 64
NORM_EPS = 1e-6

A_HEADS = 4
A_W = A_HEADS * HEAD_DIM
A_LEFT_CHUNKS = 8
A_MAX_REL = 128

B_HEADS = 4
B_Q_LORA = 256
B_KV_LORA = 128
B_NOPE = 64
B_ROPE = 32
B_V = 64
ROPE_THETA = 10000.0

C_HEADS = 4
C_W = C_HEADS * HEAD_DIM
FORGET_BIAS_MEAN = 3.0

CONV_CH = 256
CONV_K = 31

N_BRANCH = 4
BRANCH_W = 256
D_FF = 4 * D_MODEL

IN_SPLITS = (A_W, A_W, A_W,
             B_Q_LORA, B_KV_LORA, B_ROPE,
             C_W, C_W, C_W, C_HEADS,
             CONV_CH, CONV_CH)
IN_COLS = sum(IN_SPLITS)

kernel_name = 'hybrid_gated_streaming_encoder'


def _normal(key, shape, scale):
    return scale * jax.random.normal(key, shape, jnp.float32)


def rms_norm(x, g):
    xf = x.astype(jnp.float32)
    y = xf * lax.rsqrt(jnp.mean(xf * xf, axis=-1, keepdims=True) + NORM_EPS)
    return (y * g.astype(jnp.float32)).astype(x.dtype)


def layer_norm(x, g, b):
    xf = x.astype(jnp.float32)
    mu = jnp.mean(xf, axis=-1, keepdims=True)
    xc = xf - mu
    var = jnp.mean(xc * xc, axis=-1, keepdims=True)
    y = xc * lax.rsqrt(var + NORM_EPS) * g.astype(jnp.float32) + b.astype(jnp.float32)
    return y.astype(x.dtype)


def apply_rope(x, positions):
    half = x.shape[-1] // 2
    inv_freq = 1.0 / (ROPE_THETA ** (jnp.arange(half, dtype=jnp.float32) / half))
    ang = positions.astype(jnp.float32)[..., None] * inv_freq
    if x.ndim == 4:
        ang = ang[:, :, None, :]
    cos, sin = jnp.cos(ang), jnp.sin(ang)
    xf = x.astype(jnp.float32)
    x1, x2 = xf[..., :half], xf[..., half:]
    return jnp.concatenate([x1 * cos - x2 * sin, x2 * cos + x1 * sin], axis=-1).astype(x.dtype)


def chunk_band_attention(q, k, v, rel_table):
    b, s, h, d = q.shape
    nc = s // CHUNK
    w = A_LEFT_CHUNKS + 1
    qc = q.reshape(b, nc, CHUNK, h, d)

    def band(t):
        tc = t.reshape(b, nc, CHUNK, h, t.shape[-1])
        tp = jnp.pad(tc, ((0, 0), (A_LEFT_CHUNKS, 0), (0, 0), (0, 0), (0, 0)))
        return jnp.concatenate([tp[:, j:j + nc] for j in range(w)], axis=2)

    kb, vb = band(k), band(v)
    key_chunk = jnp.arange(nc)[:, None] + jnp.arange(w)[None, :] - A_LEFT_CHUNKS
    valid = jnp.repeat(key_chunk >= 0, CHUNK, axis=1)
    rel = (jnp.arange(CHUNK)[:, None] + A_LEFT_CHUNKS * CHUNK) - jnp.arange(w * CHUNK)[None, :]
    rel_idx = jnp.clip(rel, -A_MAX_REL, A_MAX_REL) + A_MAX_REL
    bias = rel_table[:, rel_idx].astype(jnp.float32)
    scores = jnp.einsum('bcqhd,bckhd->bchqk', qc, kb).astype(jnp.float32) * (d ** -0.5)
    scores = scores + bias[None, None]
    scores = jnp.where(valid[None, :, None, None, :], scores, -jnp.inf)
    p = jax.nn.softmax(scores, axis=-1).astype(v.dtype)
    out = jnp.einsum('bchqk,bckhd->bcqhd', p, vb)
    return out.reshape(b, s, h, -1)


def block_causal_attention(q, k, v, causal_unit, log_forget_cum=None):
    b, s, h, dk = q.shape
    nb = s // Q_BLOCK
    scale = dk ** -0.5
    key_unit = jnp.arange(s) // causal_unit
    qb = q.reshape(b, nb, Q_BLOCK, h, dk).swapaxes(0, 1)
    starts = jnp.arange(nb) * Q_BLOCK

    def attend(q_blk, start, f_blk):
        sc = jnp.einsum('bqhd,bkhd->bhqk', q_blk, k).astype(jnp.float32) * scale
        if f_blk is not None:
            f_k = log_forget_cum.transpose(0, 2, 1)[:, :, None, :]
            sc = sc + f_blk.transpose(0, 2, 1)[..., None] - f_k
        q_unit = (start + jnp.arange(Q_BLOCK)) // causal_unit
        mask = key_unit[None, :] <= q_unit[:, None]
        sc = jnp.where(mask[None, None], sc, -jnp.inf)
        p = jax.nn.softmax(sc, axis=-1).astype(v.dtype)
        return jnp.einsum('bhqk,bkhd->bqhd', p, v)

    if log_forget_cum is None:
        out = lax.map(lambda xs: attend(xs[0], xs[1], None), (qb, starts))
    else:
        fb = log_forget_cum.reshape(b, nb, Q_BLOCK, h).swapaxes(0, 1)
        out = lax.map(lambda xs: attend(xs[0], xs[1], xs[2]), (qb, starts, fb))
    return out.swapaxes(0, 1).reshape(b, s, h, -1)


def hybrid_layer(x, positions, g_mix, w_in, w_gate, b_gate, rel_bias, g_q_lat, w_uq, g_kv_lat, w_ukv,
                 b_forget, w_dw, b_dw, g_conv_ln, b_conv_ln, w_branch, w_o, g_ffn, w_up, w_down):
    b, s, _ = x.shape
    h = rms_norm(x, g_mix)
    split_points = [int(i) for i in np.cumsum(IN_SPLITS)[:-1]]
    (a_q, a_k, a_v, b_qlat, b_kvlat, b_krope,
     c_q, c_k, c_v, c_f, d_val, d_gate) = jnp.split(h @ w_in, split_points, axis=-1)

    def heads(t, n):
        return t.reshape(b, s, n, -1)

    out_a = chunk_band_attention(heads(a_q, A_HEADS), heads(a_k, A_HEADS), heads(a_v, A_HEADS), rel_bias)

    q = (rms_norm(b_qlat, g_q_lat) @ w_uq).reshape(b, s, B_HEADS, B_NOPE + B_ROPE)
    q = jnp.concatenate([q[..., :B_NOPE], apply_rope(q[..., B_NOPE:], positions)], axis=-1)
    kv = (rms_norm(b_kvlat, g_kv_lat) @ w_ukv).reshape(b, s, B_HEADS, B_NOPE + B_V)
    k_rot = apply_rope(b_krope, positions)
    k = jnp.concatenate([kv[..., :B_NOPE],
                         jnp.broadcast_to(k_rot[:, :, None, :], (b, s, B_HEADS, B_ROPE))], axis=-1)
    out_b = block_causal_attention(q, k, kv[..., B_NOPE:], CHUNK)

    log_f = jax.nn.log_sigmoid(c_f.astype(jnp.float32) + b_forget.astype(jnp.float32))
    f_cum = jnp.cumsum(log_f, axis=1)
    out_c = block_causal_attention(heads(c_q, C_HEADS), heads(c_k, C_HEADS), heads(c_v, C_HEADS), 1, f_cum)

    u = d_val * jax.nn.sigmoid(d_gate)
    u = lax.conv_general_dilated(u, w_dw[:, None, :], window_strides=(1,), padding=[(CONV_K - 1, 0)],
                                 dimension_numbers=('NWC', 'WIO', 'NWC'),
                                 feature_group_count=CONV_CH) + b_dw
    out_d = jax.nn.silu(layer_norm(u, g_conv_ln, b_conv_ln))

    branches = jnp.stack([out_a.reshape(b, s, BRANCH_W), out_b.reshape(b, s, BRANCH_W),
                          out_c.reshape(b, s, BRANCH_W), out_d], axis=2)
    proj = jnp.einsum('bsnc,ncd->bsnd', branches, w_branch)
    gates = jax.nn.sigmoid(h @ w_gate + b_gate).reshape(b, s, N_BRANCH, D_MODEL)
    x = x + jnp.sum(gates * proj, axis=2) @ w_o

    hf = rms_norm(x, g_ffn)
    x = x + jnp.square(jax.nn.relu(hf @ w_up)) @ w_down
    return x


def setup_inputs(seed: int = 0) -> dict:
    key = jax.random.key(seed)
    ks = jax.random.split(key, 24)
    L = DEPTH
    x = _normal(ks[0], (BATCH, SEQ, D_MODEL), 1.0)
    offset = jax.random.randint(ks[1], (BATCH, 1), 0, 4 * SEQ, dtype=jnp.int32)
    positions = offset + jnp.arange(SEQ, dtype=jnp.int32)[None, :]
    return dict(
        x=x,
        positions=positions,
        g_mix=1.0 + _normal(ks[2], (L, D_MODEL), 0.05),
        w_in=_normal(ks[3], (L, D_MODEL, IN_COLS), D_MODEL ** -0.5),
        w_gate=_normal(ks[4], (L, D_MODEL, N_BRANCH * D_MODEL), D_MODEL ** -0.5),
        b_gate=_normal(ks[5], (L, N_BRANCH * D_MODEL), 0.02),
        rel_bias=_normal(ks[6], (L, A_HEADS, 2 * A_MAX_REL + 1), 0.2),
        g_q_lat=1.0 + _normal(ks[7], (L, B_Q_LORA), 0.05),
        w_uq=_normal(ks[8], (L, B_Q_LORA, B_HEADS * (B_NOPE + B_ROPE)), B_Q_LORA ** -0.5),
        g_kv_lat=1.0 + _normal(ks[9], (L, B_KV_LORA), 0.05),
        w_ukv=_normal(ks[10], (L, B_KV_LORA, B_HEADS * (B_NOPE + B_V)), B_KV_LORA ** -0.5),
        b_forget=FORGET_BIAS_MEAN + _normal(ks[11], (L, C_HEADS), 0.5),
        w_dw=_normal(ks[12], (L, CONV_K, CONV_CH), CONV_K ** -0.5),
        b_dw=_normal(ks[13], (L, CONV_CH), 0.02),
        g_conv_ln=1.0 + _normal(ks[14], (L, CONV_CH), 0.05),
        b_conv_ln=_normal(ks[15], (L, CONV_CH), 0.02),
        w_branch=_normal(ks[16], (L, N_BRANCH, BRANCH_W, D_MODEL), BRANCH_W ** -0.5),
        w_o=_normal(ks[17], (L, D_MODEL, D_MODEL), D_MODEL ** -0.5),
        g_ffn=1.0 + _normal(ks[18], (L, D_MODEL), 0.05),
        w_up=_normal(ks[19], (L, D_MODEL, D_FF), D_MODEL ** -0.5),
        w_down=_normal(ks[20], (L, D_FF, D_MODEL), D_FF ** -0.5),
        g_final=1.0 + _normal(ks[21], (D_MODEL,), 0.05),
    )


def reference(x, positions, g_mix, w_in, w_gate, b_gate, rel_bias, g_q_lat, w_uq, g_kv_lat, w_ukv,
              b_forget, w_dw, b_dw, g_conv_ln, b_conv_ln, w_branch, w_o, g_ffn, w_up, w_down, g_final):
    for l in range(DEPTH):
        x = hybrid_layer(x, positions, g_mix[l], w_in[l], w_gate[l], b_gate[l], rel_bias[l],
                         g_q_lat[l], w_uq[l], g_kv_lat[l], w_ukv[l], b_forget[l], w_dw[l], b_dw[l],
                         g_conv_ln[l], b_conv_ln[l], w_branch[l], w_o[l], g_ffn[l], w_up[l], w_down[l])
    return rms_norm(x, g_final)
```

```cpp
#include <hip/hip_runtime.h>
#include <hip/hip_cooperative_groups.h>
#include <cstdio>
#include <cstdint>
namespace cg = cooperative_groups;

#define LAS __attribute__((address_space(3)))
typedef unsigned short bf16_t;
typedef short bf16x8 __attribute__((ext_vector_type(8)));
typedef short s16x4 __attribute__((ext_vector_type(4)));
typedef float f32x4 __attribute__((ext_vector_type(4)));
typedef float f32x16 __attribute__((ext_vector_type(16)));
typedef unsigned u32x4 __attribute__((ext_vector_type(4)));
typedef unsigned u32x2 __attribute__((ext_vector_type(2)));
typedef float f32x2_t __attribute__((ext_vector_type(2)));
typedef __bf16 bf16x2_t __attribute__((ext_vector_type(2)));

constexpr int NB = 4, SEQ = 4096, DM = 1024, TOK = NB * SEQ, DFF = 4096, INC = 2468, PLD = 2560;
constexpr int C_AQ = 0, C_AK = 256, C_AV = 512, C_BQL = 768, C_BKVL = 1024, C_BKR = 1152, C_CQ = 1184, C_CK = 1440, C_CV = 1696, C_CF = 1952, C_DV = 1956, C_DG = 2212;
constexpr float LOG2E = 1.4426950408889634f;
constexpr float EPS = 1e-6f;
constexpr size_t MiB = 1u << 20;
constexpr size_t WS_W1T = 4 * MiB, WS_W2T = 12 * MiB, WS_XN = 20 * MiB, WS_PROJ = 52 * MiB, WS_XA = 52 * MiB, WS_H = 116 * MiB;
constexpr size_t WS_QKVB = 132 * MiB, WS_MIXED = 132 * MiB, WS_BR = 164 * MiB, WS_LAT = 196 * MiB, WS_U = 208 * MiB;
constexpr size_t WS_WINT = 216 * MiB, WS_WGT = 221 * MiB, WS_WLT = 229 * MiB, WS_WBT = 230 * MiB, WS_WOT = 238 * MiB;
constexpr size_t WS_CTL = 244 * MiB, WS_FCUM = 244 * MiB + 256 * 1024, WS_KROT = 245 * MiB, WS_END = 256 * MiB;
constexpr size_t WS_WINT1 = 251 * MiB, WS_WLT1 = 0;
constexpr size_t WS_ROWSS = 246 * MiB, ROWSS_STRIDE = (size_t)TOK * 16;
constexpr int LDS_RINV = 131072 + 1024 + 16384;
constexpr int LDS_BYTES = LDS_RINV + 1024;

struct Args {
    const float* x; const int* pos; const float* g_mix; const float* w_in; const float* w_gate; const float* b_gate; const float* rel_bias;
    const float* g_q_lat; const float* w_uq; const float* g_kv_lat; const float* w_ukv; const float* b_forget; const float* w_dw; const float* b_dw;
    const float* g_conv_ln; const float* b_conv_ln; const float* w_branch; const float* w_o; const float* g_ffn; const float* w_up; const float* w_down; const float* g_final;
    float* out; unsigned char* ws;
};

typedef const __attribute__((address_space(4))) Args* cargs_t;
__device__ __forceinline__ cargs_t get_args() { cargs_t p = (cargs_t)__builtin_amdgcn_kernarg_segment_ptr(); asm volatile("" : "+s"(p)); return p; }
__device__ __forceinline__ int fresh_tid() { int t = threadIdx.x; asm volatile("" : "+v"(t)); return t; }
__device__ __forceinline__ float bf2f(unsigned short b) { return __uint_as_float((unsigned)b << 16); }
__device__ __forceinline__ unsigned pk2(float lo, float hi) { f32x2_t v = {lo, hi}; bf16x2_t b = __builtin_convertvector(v, bf16x2_t); return __builtin_bit_cast(unsigned, b); }
__device__ __forceinline__ float lo_f(unsigned w) { return __uint_as_float(w << 16); }
__device__ __forceinline__ float hi_f(unsigned w) { return __uint_as_float(w & 0xffff0000u); }
__device__ __forceinline__ float wave_sum(float v) {
#pragma unroll
    for (int o = 1; o < 64; o <<= 1) v += __shfl_xor(v, o);
    return v;
}
__device__ __forceinline__ float sigmoidf_(float x) { return 1.0f / (1.0f + __expf(-x)); }
#define LDS_WAIT() asm volatile("s_waitcnt lgkmcnt(0)" ::: "memory")
__device__ __forceinline__ float row_rinv(const float* slots, int row, int fq) {
    const f32x4 a = *(const f32x4*)(slots + (size_t)row * 16 + 4 * fq);
    float s = (a.x + a.y) + (a.z + a.w);
    s += __shfl_xor(s, 16); s += __shfl_xor(s, 32);
    return __builtin_amdgcn_rsqf(s * (1.0f / 1024.0f) + EPS);
}
__device__ __forceinline__ void fill_rinv_table(LAS unsigned char* lds, const float* slots, int pm) {
    const int t = fresh_tid();
    if (t < 256) { const f32x4* p = (const f32x4*)(slots + (size_t)(pm * 256 + t) * 16); const f32x4 a = p[0], b = p[1], c = p[2], d = p[3];
        const float s = (((a.x + a.y) + (a.z + a.w)) + ((b.x + b.y) + (b.z + b.w))) + (((c.x + c.y) + (c.z + c.w)) + ((d.x + d.y) + (d.z + d.w)));
        ((LAS float*)(lds + LDS_RINV))[t] = __builtin_amdgcn_rsqf(s * (1.0f / 1024.0f) + EPS); }
    __syncthreads();
}
__device__ __forceinline__ float lds_rinv_read(unsigned addr) { float r; asm volatile("ds_read_b32 %0, %1" : "=v"(r) : "v"(addr)); return r; }
namespace pg8 {
constexpr int BM = 256, BK = 64, HALF = 128, HTB = HALF * BK * 2, STAGE_BYTES = 8 * HTB, NXCD = 8, WGM = 8;
__host__ __device__ __forceinline__ int lds_byte(int r, int c) { const int st = (r >> 4) * 2 + (c >> 5), rr = r & 15, cc = c & 31, ob = rr * 64 + cc * 2; return st * 1024 + (ob ^ (((ob >> 9) & 1) << 5)); }
__host__ __device__ __forceinline__ void stage_rc(int b, int& R, int& C) { const int st = b / 1024, sb = b % 1024, swz = sb ^ (((sb >> 9) & 1) << 5); R = (st >> 1) * 16 + swz / 64; C = (st & 1) * 32 + (swz % 64) / 2; }
__host__ __device__ __forceinline__ int perm32(int rho) { const int n = rho >> 4, i = rho & 15; return 8 * (i >> 2) + 4 * n + (i & 3); }

struct Unit { int pm, pn, nt, kind; const char* a; const char* b; };

__device__ __forceinline__ bool tile_of(int L, int nM, int nN, int& pm, int& pn) {
    const int nwg = nM * nN; if (L >= nwg) return false;
    int wgid = L; { const int q = nwg / NXCD, r = nwg % NXCD, xcd = wgid % NXCD, off = wgid / NXCD; wgid = (xcd < r ? xcd * (q + 1) : r * (q + 1) + (xcd - r) * q) + off; }
    const int nig = WGM * nN, gid = wgid / nig, fm = gid * WGM, gsz = (nM - fm) < WGM ? (nM - fm) : WGM;
    pm = fm + ((wgid % nig) % gsz); pn = (wgid % nig) / gsz; return true;
}
struct PlainOrder {
    const char* A; const char* Bt; int lda, ldb, nM, nN, nt, G, c;
    __device__ __forceinline__ bool next(int i, Unit& u) const {
        int pm, pn; if (!tile_of(i * G + c, nM, nN, pm, pn)) return false;
        u.pm = pm; u.pn = pn; u.nt = nt; u.kind = 0; u.a = A + (size_t)pm * 256 * lda * 2; u.b = Bt + (size_t)pn * 256 * ldb * 2; return true;
    }
};
struct GateBranchOrder {
    const char* XN; const char* BR; const char* WgT; const char* WbT; int G, c;
    __device__ __forceinline__ bool next(int i, Unit& u) const {
        const int gi = i >> 3, j = i & 7; int pm, pd; if (!tile_of(gi * G + c, 64, 4, pm, pd)) return false;
        const int n = j >> 1, kind = j & 1; u.pm = pm; u.pn = n * 4 + pd; u.kind = kind;
        if (kind == 0) { u.nt = 16; u.a = XN + (size_t)pm * 256 * 1024 * 2; u.b = WgT + (size_t)u.pn * 256 * 1024 * 2; }
        else { u.nt = 4; u.a = BR + ((size_t)pm * 256 * 1024 + n * 256) * 2; u.b = WbT + ((size_t)u.pn * 256 * 1024 + n * 256) * 2; }
        return true;
    }
};

template <int ACT  , bool RS  > struct EpiBf16 {
    static constexpr bool PERM = true; struct State {};
    bf16_t* O; int ldc; const float* rowss; int pm_tab; unsigned tab;
    __device__ __forceinline__ void operator()(const f32x4 (&acc)[2][2][4][2], State&, const Unit& u, int wr, int wc, int fr, int fq) const {
        asm volatile("" : "+v"(fr), "+v"(fq));
        const int row0 = u.pm * BM + wr * 64 + fr, col0 = u.pn * BM + wc * 32 + 8 * fq;
        float rv[2][4];
        if (RS) {
            if (u.pm == pm_tab) {
#pragma unroll
                for (int ai = 0; ai < 2; ++ai)
#pragma unroll
                    for (int m = 0; m < 4; ++m) rv[ai][m] = lds_rinv_read(tab + (unsigned)(wr * 64 + fr + ai * HALF + m * 16) * 4u);
                asm volatile("s_waitcnt lgkmcnt(0)" : "+v"(rv[0][0]), "+v"(rv[0][1]), "+v"(rv[0][2]), "+v"(rv[0][3]), "+v"(rv[1][0]), "+v"(rv[1][1]), "+v"(rv[1][2]), "+v"(rv[1][3]));
            } else {
#pragma unroll
                for (int ai = 0; ai < 2; ++ai)
#pragma unroll
                    for (int m = 0; m < 4; ++m) rv[ai][m] = row_rinv(rowss, row0 + ai * HALF + m * 16, fq);
            }
        }
#pragma unroll
        for (int ai = 0; ai < 2; ++ai)
#pragma unroll
            for (int m = 0; m < 4; ++m) { bf16_t* rowp = O + (size_t)(row0 + ai * HALF + m * 16) * ldc + col0;
                float rinv = 1.f; if (RS) rinv = rv[ai][m];
#pragma unroll
                for (int bj = 0; bj < 2; ++bj) { f32x4 v0 = acc[ai][bj][m][0], v1 = acc[ai][bj][m][1];
                    if (RS) { v0 = v0 * rinv; v1 = v1 * rinv; }
                    if (ACT == 2) {
#pragma unroll
                        for (int e = 0; e < 4; ++e) { const float a0 = fmaxf(v0[e], 0.f), a1 = fmaxf(v1[e], 0.f); v0[e] = a0 * a0; v1[e] = a1 * a1; } }
                    u32x4 w; w.x = pk2(v0[0], v0[1]); w.y = pk2(v0[2], v0[3]); w.z = pk2(v1[0], v1[1]); w.w = pk2(v1[2], v1[3]);
                    *(u32x4*)(rowp + bj * HALF) = w; } }
    }
};
template <bool BASEF32> struct EpiRes {
    static constexpr bool PERM = true; struct State {};
    const void* base; bf16_t* out; float* rowss;
    __device__ __forceinline__ void operator()(const f32x4 (&acc)[2][2][4][2], State&, const Unit& u, int wr, int wc, int fr, int fq) const {
        asm volatile("" : "+v"(fr), "+v"(fq));
        const int row0 = u.pm * BM + wr * 64 + fr, col0 = u.pn * BM + wc * 32 + 8 * fq;
#pragma unroll
        for (int ai = 0; ai < 2; ++ai) {
            f32x4 bs[4][2][2];
#pragma unroll
            for (int m = 0; m < 4; ++m) { const size_t off = (size_t)(row0 + ai * HALF + m * 16) * 1024 + col0;
#pragma unroll
                for (int bj = 0; bj < 2; ++bj) {
                    if (BASEF32) { bs[m][bj][0] = *(const f32x4*)((const float*)base + off + bj * HALF); bs[m][bj][1] = *(const f32x4*)((const float*)base + off + bj * HALF + 4); }
                    else { const u32x4 w = *(const u32x4*)((const bf16_t*)base + off + bj * HALF);
                        bs[m][bj][0] = (f32x4){lo_f(w.x), hi_f(w.x), lo_f(w.y), hi_f(w.y)}; bs[m][bj][1] = (f32x4){lo_f(w.z), hi_f(w.z), lo_f(w.w), hi_f(w.w)}; } } }
            asm volatile("" ::: "memory");
#pragma unroll
            for (int m = 0; m < 4; ++m) { const int row = row0 + ai * HALF + m * 16; const size_t off = (size_t)row * 1024 + col0; float ss = 0.f;
#pragma unroll
                for (int bj = 0; bj < 2; ++bj) { const f32x4 v0 = bs[m][bj][0] + acc[ai][bj][m][0], v1 = bs[m][bj][1] + acc[ai][bj][m][1];
                    u32x4 w; w.x = pk2(v0[0], v0[1]); w.y = pk2(v0[2], v0[3]); w.z = pk2(v1[0], v1[1]); w.w = pk2(v1[2], v1[3]); *(u32x4*)(out + off + bj * HALF) = w;
                    ss += ((v0.x * v0.x + v0.y * v0.y) + (v0.z * v0.z + v0.w * v0.w)) + ((v1.x * v1.x + v1.y * v1.y) + (v1.z * v1.z + v1.w * v1.w)); }
                ss += __shfl_xor(ss, 16); ss += __shfl_xor(ss, 32); if (fq == 0) rowss[(size_t)row * 16 + u.pn * 4 + wc] = ss; }
            asm volatile("" ::: "memory");
        }
    }
};
struct EpiGateBranch {
    static constexpr bool PERM = true;
    struct State { unsigned g8[2][2][4][2]; };
    bf16_t* mixed; const float* bgate; const float* rowss; LAS unsigned* glds;
    __device__ __forceinline__ void operator()(const f32x4 (&acc)[2][2][4][2], State& st, const Unit& u, int wr, int wc, int fr, int fq) const {
        asm volatile("" : "+v"(fr), "+v"(fq));
        const int rl0 = wr * 64 + fr, cl0 = wc * 32 + 8 * fq, n = u.pn >> 2, pd = u.pn & 3;
        LAS unsigned* gl = glds + (wr * 4 + wc) * 512 + (fq * 16 + fr) * 8;
        if (u.kind == 0) {
            f32x4 bv[2][2];
#pragma unroll
            for (int bj = 0; bj < 2; ++bj)
#pragma unroll
                for (int q = 0; q < 2; ++q) bv[bj][q] = *(const f32x4*)(bgate + u.pn * BM + cl0 + bj * HALF + 4 * q);
#pragma unroll
            for (int ai = 0; ai < 2; ++ai)
#pragma unroll
                for (int m = 0; m < 4; ++m) {
                    const float rinv = row_rinv(rowss, u.pm * BM + rl0 + ai * HALF + m * 16, fq);
#pragma unroll
                    for (int bj = 0; bj < 2; ++bj)
#pragma unroll
                        for (int q = 0; q < 2; ++q) { const f32x4 v = acc[ai][bj][m][q] * rinv + bv[bj][q]; unsigned w = 0u;
#pragma unroll
                            for (int e = 0; e < 4; ++e) w |= (unsigned)(sigmoidf_(v[e]) * 255.0f + 0.5f) << (8 * e);
                            if (ai == 1 && bj == 1) gl[m * 2 + q] = w; else st.g8[ai][bj][m][q] = w; } }
        } else {
#pragma unroll
            for (int ai = 0; ai < 2; ++ai) {
                u32x4 oo[4][2];
#pragma unroll
                for (int m = 0; m < 4; ++m) { const int rl = rl0 + ai * HALF + m * 16; const bf16_t* mp = mixed + (size_t)(u.pm * BM + rl) * 1024 + pd * 256 + cl0;
#pragma unroll
                    for (int bj = 0; bj < 2; ++bj) { oo[m][bj] = (u32x4){0u, 0u, 0u, 0u}; if (n > 0) oo[m][bj] = *(const u32x4*)(mp + bj * HALF); } }
                asm volatile("" ::: "memory");
#pragma unroll
                for (int m = 0; m < 4; ++m) { const int rl = rl0 + ai * HALF + m * 16; bf16_t* mp = mixed + (size_t)(u.pm * BM + rl) * 1024 + pd * 256 + cl0;
#pragma unroll
                    for (int bj = 0; bj < 2; ++bj) { const unsigned g0 = (ai == 1 && bj == 1) ? gl[m * 2] : st.g8[ai][bj][m][0], g1 = (ai == 1 && bj == 1) ? gl[m * 2 + 1] : st.g8[ai][bj][m][1]; const u32x4 o = oo[m][bj]; const f32x4 a0 = acc[ai][bj][m][0] * (1.0f / 255.0f), a1 = acc[ai][bj][m][1] * (1.0f / 255.0f);
                        float v[8];
                        v[0] = fmaf(a0[0], (float)(g0 & 255u), lo_f(o.x)); v[1] = fmaf(a0[1], (float)((g0 >> 8) & 255u), hi_f(o.x)); v[2] = fmaf(a0[2], (float)((g0 >> 16) & 255u), lo_f(o.y)); v[3] = fmaf(a0[3], (float)(g0 >> 24), hi_f(o.y));
                        v[4] = fmaf(a1[0], (float)(g1 & 255u), lo_f(o.z)); v[5] = fmaf(a1[1], (float)((g1 >> 8) & 255u), hi_f(o.z)); v[6] = fmaf(a1[2], (float)((g1 >> 16) & 255u), lo_f(o.w)); v[7] = fmaf(a1[3], (float)(g1 >> 24), hi_f(o.w));
                        u32x4 w; w.x = pk2(v[0], v[1]); w.y = pk2(v[2], v[3]); w.z = pk2(v[4], v[5]); w.w = pk2(v[6], v[7]);
                        *(u32x4*)(mp + bj * HALF) = w; } }
                asm volatile("" ::: "memory");
            }
        }
    }
};

template <class Epi, class Sched>
__device__ __forceinline__ void gemm_phase(LAS unsigned char* lds, const int lda, const int ldb, const Sched& S, const Epi& E) {
    const int tid = fresh_tid(), wid = __builtin_amdgcn_readfirstlane(tid >> 6), lane = tid & 63, wr = wid >> 2, wc = wid & 3, fr = lane & 15, fq = lane >> 4;
    unsigned voffA[2], voffB[2];
#pragma unroll
    for (int i = 0; i < 2; ++i) { int R, C; stage_rc(tid * 16 + i * 8192, R, C); const int Rb = Epi::PERM ? ((R & ~31) + perm32(R & 31)) : R;
        voffA[i] = (unsigned)(R * lda + C) * 2u; voffB[i] = (unsigned)(Rb * ldb + C) * 2u; }
    const size_t kstep = (size_t)(BK * 2);
    const size_t hstepA = (size_t)HALF * lda * 2, hstepB = (size_t)HALF * ldb * 2;
    const unsigned ldsw = (unsigned)wid * 1024u;
    const int aoff = lds_byte(wr * 64 + fr, fq * 8), boff = lds_byte(wc * 32 + fr, fq * 8);
#define PG8_SA(b, h) (((b) * 2 + (h)) * HTB)
#define PG8_SB(b, h) ((4 + (b) * 2 + (h)) * HTB)
#define PG8_STAGE(bufoff, gbase, voff) do { _Pragma("unroll") for (int _i = 0; _i < 2; ++_i) \
        __builtin_amdgcn_global_load_lds((const unsigned*)((const char*)(gbase) + (voff)[_i]), (LAS unsigned*)(lds + (bufoff) + ldsw + _i * 8192), 16, 0, 0); } while (0)
#define PG8_LDA(dst, b, h) do { _Pragma("unroll") for (int m = 0; m < 4; ++m) _Pragma("unroll") for (int k = 0; k < 2; ++k) dst[m][k] = *(const LAS bf16x8*)(lds + PG8_SA(b, h) + aoff + m * 2048 + k * 1024); } while (0)
#define PG8_LDB(dst, b, h) do { _Pragma("unroll") for (int n = 0; n < 2; ++n) _Pragma("unroll") for (int k = 0; k < 2; ++k) dst[n][k] = *(const LAS bf16x8*)(lds + PG8_SB(b, h) + boff + n * 2048 + k * 1024); } while (0)
#define PG8_MMA(ai, bj, At, Bt) do { __builtin_amdgcn_s_setprio(1); _Pragma("unroll") for (int m = 0; m < 4; ++m) _Pragma("unroll") for (int n = 0; n < 2; ++n) _Pragma("unroll") for (int k = 0; k < 2; ++k) \
        acc[ai][bj][m][n] = __builtin_amdgcn_mfma_f32_16x16x32_bf16(Bt[n][k], At[m][k], acc[ai][bj][m][n], 0, 0, 0); __builtin_amdgcn_s_setprio(0); } while (0)
#define PG8_WAIT_V(n) asm volatile("s_waitcnt vmcnt(" #n ")" ::: "memory")
#define PG8_WAIT_L(n) asm volatile("s_waitcnt lgkmcnt(" #n ")" ::: "memory")
#define PG8_BAR __builtin_amdgcn_s_barrier()
#define PG8_SCHED __builtin_amdgcn_sched_barrier(0)
    Unit cur, nxt; int ui = 0;
    if (!S.next(0, cur)) return;
    f32x4 acc[2][2][4][2];
#pragma unroll
    for (int a = 0; a < 2; ++a)
#pragma unroll
        for (int b = 0; b < 2; ++b)
#pragma unroll
            for (int m = 0; m < 4; ++m)
#pragma unroll
                for (int n = 0; n < 2; ++n) acc[a][b][m][n] = (f32x4){0.f, 0.f, 0.f, 0.f};
    bf16x8 At[4][2], B0[2][2], B1[2][2];
    typename Epi::State est;
    const char* cA = cur.a; const char* cB = cur.b;
    PG8_STAGE(PG8_SB(0, 0), cB, voffB); PG8_STAGE(PG8_SB(0, 1), cB + hstepB, voffB); PG8_STAGE(PG8_SA(0, 0), cA, voffA); PG8_STAGE(PG8_SA(0, 1), cA + hstepA, voffA);
    if (wr == 1) PG8_BAR;
    PG8_WAIT_V(2); PG8_BAR;
    PG8_STAGE(PG8_SB(1, 0), cB + kstep, voffB); PG8_STAGE(PG8_SA(1, 0), cA + kstep, voffA); PG8_STAGE(PG8_SB(1, 1), cB + hstepB + kstep, voffB);
    PG8_WAIT_V(6); PG8_BAR;
    for (;;) {
        const bool has_next = S.next(ui + 1, nxt);
        const char* nA = has_next ? nxt.a : cA; const char* nB = has_next ? nxt.b : cB;
        const int nt = cur.nt;
        for (int t = 0; t < nt; t += 2) {
            const bool last = (t == nt - 2);
            const char* a1 = cA + (size_t)(t + 1) * kstep;
            const char* a2 = last ? nA : cA + (size_t)(t + 2) * kstep; const char* b2 = last ? nB : cB + (size_t)(t + 2) * kstep;
            const char* a3 = a2 + kstep; const char* b3 = b2 + kstep;
            PG8_LDB(B0, 0, 0); PG8_LDB(B1, 0, 1); PG8_SCHED; PG8_LDA(At, 0, 0); PG8_STAGE(PG8_SA(1, 1), a1 + hstepA, voffA);
            PG8_WAIT_V(8); PG8_WAIT_L(0); PG8_BAR; PG8_MMA(0, 0, At, B0); PG8_MMA(0, 1, At, B1); PG8_BAR; PG8_SCHED;
            PG8_LDA(At, 0, 1); PG8_STAGE(PG8_SB(0, 0), b2, voffB); PG8_STAGE(PG8_SB(0, 1), b2 + hstepB, voffB); PG8_STAGE(PG8_SA(0, 0), a2, voffA);
            PG8_WAIT_V(8); PG8_WAIT_L(0); PG8_BAR; PG8_MMA(1, 0, At, B0); PG8_MMA(1, 1, At, B1); PG8_BAR; PG8_SCHED;
            PG8_LDB(B0, 1, 0); PG8_LDB(B1, 1, 1); PG8_SCHED; PG8_LDA(At, 1, 0); PG8_STAGE(PG8_SA(0, 1), a2 + hstepA, voffA);
            PG8_WAIT_V(8); PG8_WAIT_L(0); PG8_BAR; PG8_MMA(0, 0, At, B0); PG8_MMA(0, 1, At, B1); PG8_BAR; PG8_SCHED;
            PG8_LDA(At, 1, 1); PG8_STAGE(PG8_SB(1, 0), b3, voffB); PG8_STAGE(PG8_SB(1, 1), b3 + hstepB, voffB); PG8_STAGE(PG8_SA(1, 0), a3, voffA);
            PG8_WAIT_V(8); PG8_WAIT_L(0); PG8_BAR; PG8_MMA(1, 0, At, B0); PG8_MMA(1, 1, At, B1); PG8_BAR; PG8_SCHED;
        }
        if (wr == 0) PG8_BAR;
        E(acc, est, cur, wr, wc, fr, fq);
        if (!has_next) break;
#pragma unroll
        for (int a = 0; a < 2; ++a)
#pragma unroll
            for (int b = 0; b < 2; ++b)
#pragma unroll
                for (int m = 0; m < 4; ++m)
#pragma unroll
                    for (int n = 0; n < 2; ++n) acc[a][b][m][n] = (f32x4){0.f, 0.f, 0.f, 0.f};
        cur = nxt; cA = nA; cB = nB; ++ui;
        if (wr == 1) PG8_BAR;
    }
    PG8_WAIT_V(0);
    PG8_BAR;
#undef PG8_SA
#undef PG8_SB
#undef PG8_STAGE
#undef PG8_LDA
#undef PG8_LDB
#undef PG8_MMA
#undef PG8_WAIT_V
#undef PG8_WAIT_L
#undef PG8_BAR
#undef PG8_SCHED
}
}

namespace att {
constexpr int VP = 144;
typedef short v4i16_t __attribute__((ext_vector_type(4)));
__device__ __forceinline__ int crow(int i, int h) { return (i & 3) + 8 * (i >> 2) + 4 * h; }
__device__ __forceinline__ s16x4 vtr(const LAS unsigned char* p) { return __builtin_bit_cast(s16x4, __builtin_amdgcn_ds_read_tr16_b64_v4i16((LAS v4i16_t*)p)); }
#define MFMA32(a, b, c) __builtin_amdgcn_mfma_f32_32x32x16_bf16((a), (b), (c), 0, 0, 0)

template <int MODE>
__device__ __forceinline__ void unit(int layer, int b, int h, int qb, LAS unsigned char* lds) {
    const cargs_t ap = get_args();
    unsigned char* const ws_ = ap->ws;
    constexpr int DK = MODE == 1 ? 96 : 64, ND = DK / 16, KP = DK * 2 + 16, KBUF = 64 * KP, VBUF = 64 * VP;
    LAS unsigned char* Ks = lds; LAS unsigned char* Vs = lds + 2 * KBUF;
    LAS float* Fs = (LAS float*)(lds + 2 * KBUF + 2 * VBUF); LAS float* Tab = Fs + 128;
    const int tid = fresh_tid(), lane = tid & 63, wid = __builtin_amdgcn_readfirstlane(tid >> 6), r = lane & 31, hh = lane >> 5;
    const size_t tok0 = (size_t)b * SEQ;
    const int qw = qb * 256 + wid * 32, qc = qw >> 6;
    const bf16_t* PROJ = (const bf16_t*)(ws_ + WS_PROJ); const bf16_t* QKVB = (const bf16_t*)(ws_ + WS_QKVB); const bf16_t* KROT = (const bf16_t*)(ws_ + WS_KROT);
    const float* FCUM = (const float*)(ws_ + WS_FCUM) + (size_t)(b * 4 + h) * SEQ;
    bf16_t* BR = (bf16_t*)(ws_ + WS_BR);
    const bf16_t *Qp, *Kp, *Vp; int ldq, ldk;
    if (MODE == 0) { Qp = PROJ + C_AQ + h * 64; Kp = PROJ + C_AK + h * 64; Vp = PROJ + C_AV + h * 64; ldq = PLD; ldk = PLD; }
    else if (MODE == 2) { Qp = PROJ + C_CQ + h * 64; Kp = PROJ + C_CK + h * 64; Vp = PROJ + C_CV + h * 64; ldq = PLD; ldk = PLD; }
    else { Qp = QKVB + h * 96; Kp = QKVB + 384 + h * 128; Vp = Kp + 64; ldq = 1024; ldk = 1024; }
    const int t_lo = (MODE == 0) ? (qb * 4 - 8 > 0 ? qb * 4 - 8 : 0) : 0, t_hi = qb * 4 + 4;
    const float cs = (MODE == 1 ? 0.10206207261596577f : 0.125f) * LOG2E;

    u32x4 kregA, vregA, kr2A, kregB, vregB, kr2B; float fregA = 0.f, fregB = 0.f;
    const int srow = tid >> 3, sch = tid & 7;
#define ATT_LOAD(j, X) do { const size_t trow = tok0 + (size_t)(j) * 64; \
        kreg##X = *(const u32x4*)(Kp + (trow + srow) * ldk + sch * 8); vreg##X = *(const u32x4*)(Vp + (trow + srow) * ldk + sch * 8); \
        if (MODE == 1) { if (tid < 256) kr2##X = *(const u32x4*)(KROT + (trow + (tid >> 2)) * 32 + (tid & 3) * 8); } \
        if (MODE == 2) { if (tid < 64) freg##X = FCUM[(j) * 64 + tid]; } } while (0)
#define ATT_STORE(s, X) do { *(LAS u32x4*)(Ks + (s) * KBUF + srow * KP + sch * 16) = kreg##X; *(LAS u32x4*)(Vs + (s) * VBUF + srow * VP + sch * 16) = vreg##X; \
        if (MODE == 1) { if (tid < 256) *(LAS u32x4*)(Ks + (s) * KBUF + (tid >> 2) * KP + 128 + (tid & 3) * 16) = kr2##X; } \
        if (MODE == 2) { if (tid < 64) Fs[(s) * 64 + tid] = freg##X * LOG2E; } } while (0)

    ATT_LOAD(t_hi - 1, A);
    ATT_LOAD(t_hi - 2, B);
    if (MODE == 0) { if (tid < 257) Tab[tid] = ap->rel_bias[(size_t)(layer * 4 + h) * 257 + tid] * LOG2E; }
    bf16x8 qf[ND];
    { const bf16_t* qrow = Qp + (tok0 + qw + r) * ldq;
#pragma unroll
      for (int d0 = 0; d0 < ND; ++d0) qf[d0] = *(const bf16x8*)(qrow + d0 * 16 + hh * 8); }
    if (MODE == 1) {
        const float pos = (float)ap->pos[tok0 + qw + r];
#pragma unroll
        for (int j = 0; j < 8; ++j) {
            const float invf = exp2f(-(float)(8 * hh + j) * 0.8304820237218406f);
            const float ang = pos * invf, kk = rintf(ang * 0.15915494309189535f);
            float rem = fmaf(-kk, 6.2831854820251465f, ang); rem = fmaf(kk, 1.7484555e-7f, rem);
            const float sn = __sinf(rem), cn = __cosf(rem);
            const float x1 = bf2f((unsigned short)qf[4][j]), x2 = bf2f((unsigned short)qf[5][j]);
            const unsigned w = pk2(x1 * cn - x2 * sn, x2 * cn + x1 * sn);
            qf[4][j] = (short)(w & 0xffffu); qf[5][j] = (short)(w >> 16);
        }
    }
    float fq = 0.f;
    if (MODE == 2) fq = FCUM[qw + r] * LOG2E;
    float m_run = -INFINITY, l_run = 0.f;
    f32x16 o0, o1;
#pragma unroll
    for (int i = 0; i < 16; ++i) { o0[i] = 0.f; o1[i] = 0.f; }
    ATT_STORE(0, A);
    __syncthreads();
    const int i16 = lane & 15, vq = i16 >> 2, vp = i16 & 3, vblk = (lane >> 4) & 1;
    const int voff = (4 * hh + vq) * VP + vblk * 32 + vp * 8;

    auto compute = [&](const int j, const int s) __attribute__((always_inline)) {
        const bool active = (MODE == 0) ? (j <= qc && j >= qc - 8) : (j <= qc);
        if (active) {
            const LAS unsigned char* kb = Ks + s * KBUF + r * KP + hh * 16;
            f32x16 p0, p1;
#pragma unroll
            for (int i = 0; i < 16; ++i) { p0[i] = 0.f; p1[i] = 0.f; }
#pragma unroll
            for (int d0 = 0; d0 < ND; ++d0) {
                const bf16x8 kf0 = *(const LAS bf16x8*)(kb + d0 * 32), kf1 = *(const LAS bf16x8*)(kb + 32 * KP + d0 * 32);
                p0 = MFMA32(kf0, qf[d0], p0); p1 = MFMA32(kf1, qf[d0], p1);
            }
            if (MODE == 0) {
                const int delta = qc - j;
                if (delta >= 3) { const float cb = Tab[256];
#pragma unroll
                    for (int i = 0; i < 16; ++i) { p0[i] = fmaf(p0[i], cs, cb); p1[i] = fmaf(p1[i], cs, cb); }
                } else { const int brel = 64 * delta + (qw & 63) + r + 128;
#pragma unroll
                    for (int i = 0; i < 16; ++i) { const int kj = crow(i, hh); int i0 = brel - kj, i1 = brel - kj - 32;
                        i0 = i0 < 0 ? 0 : (i0 > 256 ? 256 : i0); i1 = i1 < 0 ? 0 : (i1 > 256 ? 256 : i1);
                        p0[i] = fmaf(p0[i], cs, Tab[i0]); p1[i] = fmaf(p1[i], cs, Tab[i1]); }
                }
            } else if (MODE == 1) {
#pragma unroll
                for (int i = 0; i < 16; ++i) { p0[i] *= cs; p1[i] *= cs; }
            } else {
                const LAS float* fs = Fs + s * 64 + 4 * hh;
#pragma unroll
                for (int g = 0; g < 4; ++g) { const f32x4 f0 = *(const LAS f32x4*)(fs + 8 * g), f1 = *(const LAS f32x4*)(fs + 32 + 8 * g);
#pragma unroll
                    for (int e = 0; e < 4; ++e) { p0[4 * g + e] = fmaf(p0[4 * g + e], cs, fq - f0[e]); p1[4 * g + e] = fmaf(p1[4 * g + e], cs, fq - f1[e]); } }
                if (j == qc) { const int qrel = (qw & 63) + r;
#pragma unroll
                    for (int i = 0; i < 16; ++i) { const int kj = crow(i, hh); if (kj > qrel) p0[i] = -INFINITY; if (kj + 32 > qrel) p1[i] = -INFINITY; } }
            }
            float mx = p0[0];
#pragma unroll
            for (int i = 1; i < 16; ++i) mx = fmaxf(mx, p0[i]);
#pragma unroll
            for (int i = 0; i < 16; ++i) mx = fmaxf(mx, p1[i]);
            { auto rr = __builtin_amdgcn_permlane32_swap(__float_as_uint(mx), __float_as_uint(mx), false, false); mx = fmaxf(__uint_as_float(rr[0]), __uint_as_float(rr[1])); }
            if (__all(mx < m_run - 40.f)) return;
            if (__any(mx > m_run)) {
                const float m_new = fmaxf(m_run, mx);
                const float alpha = __builtin_amdgcn_exp2f(m_run - m_new);
                m_run = m_new; l_run *= alpha;
#pragma unroll
                for (int i = 0; i < 16; ++i) { o0[i] *= alpha; o1[i] *= alpha; }
            }
            float sum = 0.f;
#pragma unroll
            for (int i = 0; i < 16; ++i) { p0[i] = __builtin_amdgcn_exp2f(p0[i] - m_run); p1[i] = __builtin_amdgcn_exp2f(p1[i] - m_run); sum += p0[i] + p1[i]; }
            l_run += sum;
            const LAS unsigned char* vb = Vs + s * VBUF + voff;
#pragma unroll
            for (int kbk = 0; kbk < 2; ++kbk)
#pragma unroll
                for (int st = 0; st < 2; ++st) {
                    const f32x16& pp = kbk ? p1 : p0;
                    u32x4 pw; pw.x = pk2(pp[8 * st + 0], pp[8 * st + 1]); pw.y = pk2(pp[8 * st + 2], pp[8 * st + 3]); pw.z = pk2(pp[8 * st + 4], pp[8 * st + 5]); pw.w = pk2(pp[8 * st + 6], pp[8 * st + 7]);
                    const bf16x8 pf = __builtin_bit_cast(bf16x8, pw);
                    const LAS unsigned char* vr = vb + (32 * kbk + 16 * st) * VP;
                    const s16x4 a_lo = vtr(vr), a_hi = vtr(vr + 8 * VP), b_lo = vtr(vr + 64), b_hi = vtr(vr + 8 * VP + 64);
                    const bf16x8 v0 = __builtin_shufflevector(a_lo, a_hi, 0, 1, 2, 3, 4, 5, 6, 7), v1 = __builtin_shufflevector(b_lo, b_hi, 0, 1, 2, 3, 4, 5, 6, 7);
                    o0 = MFMA32(v0, pf, o0); o1 = MFMA32(v1, pf, o1);
                }
        }
    };
    for (int j = t_hi - 1; j >= t_lo; j -= 2) {
        if (j - 2 >= t_lo) ATT_LOAD(j - 2, A);
        compute(j, 0);
        ATT_STORE(1, B);
        __syncthreads();
        if (j - 3 >= t_lo) ATT_LOAD(j - 3, B);
        compute(j - 1, 1);
        if (j - 2 >= t_lo) ATT_STORE(0, A);
        __syncthreads();
    }
    const float l_tot = l_run + __shfl_xor(l_run, 32);
    const float inv = 1.0f / l_tot;
    bf16_t* dst = BR + (tok0 + qw + r) * 1024 + (MODE == 0 ? 0 : (MODE == 1 ? 256 : 512)) + h * 64 + 4 * hh;
#pragma unroll
    for (int g = 0; g < 4; ++g) {
        u32x2 w0, w1;
        w0.x = pk2(o0[4 * g] * inv, o0[4 * g + 1] * inv); w0.y = pk2(o0[4 * g + 2] * inv, o0[4 * g + 3] * inv);
        w1.x = pk2(o1[4 * g] * inv, o1[4 * g + 1] * inv); w1.y = pk2(o1[4 * g + 2] * inv, o1[4 * g + 3] * inv);
        *(u32x2*)(dst + 8 * g) = w0; *(u32x2*)(dst + 32 + 8 * g) = w1;
    }
#undef ATT_LOAD
#undef ATT_STORE
}
}

__device__ __forceinline__ void transpose_item(const float* W, int N, int nblk, bf16_t* WT, int ldt, LAS float* scr, int item, int lane, const float* gk = nullptr) {
    const int kb = item / nblk, nb = item % nblk, k0 = 64 * kb, n0 = 32 * nb;
    const int nn = n0 + (lane & 31); const bool ok = nn < N;
    float tmp[32];
#pragma unroll
    for (int i = 0; i < 32; ++i) { const int kk = 2 * i + (lane >> 5); tmp[i] = ok ? W[(size_t)(k0 + kk) * N + nn] : 0.f; }
#pragma unroll
    for (int i = 0; i < 32; ++i) { const int kk = 2 * i + (lane >> 5); scr[kk * 33 + (lane & 31)] = tmp[i]; }
    LDS_WAIT(); asm volatile("" ::: "memory");
    const int c = lane & 7;
    f32x4 ga = {1.f, 1.f, 1.f, 1.f}, gb = ga;
    if (gk) { ga = *(const f32x4*)(gk + k0 + 8 * c); gb = *(const f32x4*)(gk + k0 + 8 * c + 4); }
#pragma unroll
    for (int j = 0; j < 4; ++j) { const int n = (lane >> 3) + 8 * j; const LAS float* s = scr + (8 * c) * 33 + n;
        u32x4 o; o.x = pk2(s[0 * 33] * ga.x, s[1 * 33] * ga.y); o.y = pk2(s[2 * 33] * ga.z, s[3 * 33] * ga.w); o.z = pk2(s[4 * 33] * gb.x, s[5 * 33] * gb.y); o.w = pk2(s[6 * 33] * gb.z, s[7 * 33] * gb.w);
        *(u32x4*)(WT + (size_t)(n0 + n) * ldt + k0 + 8 * c) = o; }
    LDS_WAIT(); asm volatile("" ::: "memory");
}
__device__ __forceinline__ void prenorm_row(const float* xrow, bf16_t* orow, float* rowss, int lane) {
    const f32x4* xr = (const f32x4*)xrow + lane;
    f32x4 v[4]; float s = 0.f;
#pragma unroll
    for (int j = 0; j < 4; ++j) { v[j] = xr[64 * j]; s += (v[j].x * v[j].x + v[j].y * v[j].y) + (v[j].z * v[j].z + v[j].w * v[j].w); }
    s = wave_sum(s); if (lane < 16) rowss[lane] = (lane == 0) ? s : 0.f;
#pragma unroll
    for (int j = 0; j < 4; ++j) { u32x2 w; w.x = pk2(v[j].x, v[j].y); w.y = pk2(v[j].z, v[j].w); ((u32x2*)orow)[lane + 64 * j] = w; }
}
__device__ __forceinline__ float logsig(float z) { return fminf(z, 0.f) - __logf(1.0f + __expf(-fabsf(z))); }


constexpr int I_G = 16 * 128, I_B = 4 * 32, I_O = 16 * 32, I_U = 16 * 128, I_D = 64 * 32, N_LATE_ITEMS = I_G + 4 * I_B + I_O + I_U + I_D;
__device__ __forceinline__ void late_weight_item(int l, int r, LAS float* scr, int lane) {
    const cargs_t ap = get_args(); unsigned char* const ws = ap->ws;
    if (r < I_G) { transpose_item(ap->w_gate + (size_t)l * 1024 * 4096, 4096, 128, (bf16_t*)(ws + WS_WGT), 1024, scr, r, lane, ap->g_mix + l * 1024); return; } r -= I_G;
    if (r < 4 * I_B) { const int n = r / I_B; transpose_item(ap->w_branch + (size_t)l * 4 * 256 * 1024 + (size_t)n * 256 * 1024, 1024, 32, (bf16_t*)(ws + WS_WBT) + (size_t)n * 1024 * 1024 + n * 256, 1024, scr, r % I_B, lane); return; } r -= 4 * I_B;
    if (r < I_O) { transpose_item(ap->w_o + (size_t)l * 1024 * 1024, 1024, 32, (bf16_t*)(ws + WS_WOT), 1024, scr, r, lane); return; } r -= I_O;
    if (r < I_U) { transpose_item(ap->w_up + (size_t)l * 1024 * 4096, 4096, 128, (bf16_t*)(ws + WS_W1T), 1024, scr, r, lane, ap->g_ffn + l * 1024); return; } r -= I_U;
    transpose_item(ap->w_down + (size_t)l * 4096 * 1024, 1024, 32, (bf16_t*)(ws + WS_W2T), 4096, scr, r, lane);
}
__device__ __forceinline__ void conv_tokens(int l, int t0, int lane) {
    const cargs_t ap = get_args(); unsigned char* const ws = ap->ws;
    const bf16_t* U = (const bf16_t*)(ws + WS_U); bf16_t* BR = (bf16_t*)(ws + WS_BR);
    const float* wdw = ap->w_dw + (size_t)l * 31 * 256; const f32x4 bdw = *(const f32x4*)(ap->b_dw + l * 256 + 4 * lane);
    const f32x4 gln = *(const f32x4*)(ap->g_conv_ln + l * 256 + 4 * lane), bln = *(const f32x4*)(ap->b_conv_ln + l * 256 + 4 * lane);
    const int ts0 = t0 & (SEQ - 1);
    const float* wl = wdw + 4 * lane; asm volatile("" : "+v"(wl));
    u32x2 ur[38];
#pragma unroll
    for (int i = 0; i < 38; ++i) { const int tt = ts0 - 30 + i; ur[i] = (u32x2){0u, 0u}; if (tt >= 0) ur[i] = *(const u32x2*)(U + (size_t)(t0 - 30 + i) * 256 + 4 * lane); }
    f32x4 acc[8];
#pragma unroll
    for (int j = 0; j < 8; ++j) acc[j] = bdw;
#pragma unroll
    for (int k = 0; k < 31; ++k) { const f32x4 w = *(const f32x4*)(wl + k * 256);
#pragma unroll
        for (int j = 0; j < 8; ++j) { const u32x2 u = ur[j + k];
            acc[j].x = fmaf(lo_f(u.x), w.x, acc[j].x); acc[j].y = fmaf(hi_f(u.x), w.y, acc[j].y); acc[j].z = fmaf(lo_f(u.y), w.z, acc[j].z); acc[j].w = fmaf(hi_f(u.y), w.w, acc[j].w); } }
#pragma unroll
    for (int j = 0; j < 8; ++j) {
        const float mean = wave_sum((acc[j].x + acc[j].y) + (acc[j].z + acc[j].w)) * (1.0f / 256.0f);
        const f32x4 d = acc[j] - mean;
        const float rstd = 1.0f / sqrtf(wave_sum((d.x * d.x + d.y * d.y) + (d.z * d.z + d.w * d.w)) * (1.0f / 256.0f) + EPS);
        const f32x4 y = d * rstd * gln + bln;
        u32x2 o; o.x = pk2(y.x * sigmoidf_(y.x), y.y * sigmoidf_(y.y)); o.y = pk2(y.z * sigmoidf_(y.z), y.w * sigmoidf_(y.w));
        *(u32x2*)(BR + (size_t)(t0 + j) * 1024 + 768 + 4 * lane) = o;
    }
}

__device__ __forceinline__ void win_item(int l, int r, LAS float* scr, int lane) {
    const cargs_t ap = get_args();
    transpose_item(ap->w_in + (size_t)l * 1024 * INC, INC, 80, (bf16_t*)(ap->ws + (l == 0 ? WS_WINT : WS_WINT1)), 1024, scr, r, lane, ap->g_mix + l * 1024);
}
__device__ __forceinline__ void wlat_chunk(int l, int c) {
    const cargs_t ap = get_args();
    const float* w_uq = ap->w_uq + (size_t)l * 256 * 384; const float* w_ukv = ap->w_ukv + (size_t)l * 128 * 512;
    const int n = c / 48, k0 = (c % 48) * 8; float v[8];
#pragma unroll
    for (int e = 0; e < 8; ++e) { const int k = k0 + e; v[e] = (n < 384 && k < 256) ? w_uq[(size_t)k * 384 + n] : ((n >= 384 && n < 896 && k >= 256) ? w_ukv[(size_t)(k - 256) * 512 + (n - 384)] : 0.f); }
    u32x4 o; o.x = pk2(v[0], v[1]); o.y = pk2(v[2], v[3]); o.z = pk2(v[4], v[5]); o.w = pk2(v[6], v[7]);
    *(u32x4*)((bf16_t*)(ap->ws + (l == 0 ? WS_WLT : WS_WLT1)) + (size_t)n * 384 + k0) = o;
}

#define XB_TMO      128
#define XB_XCNT(j)  (256  + 64 * (j))
#define XB_XSUB(j)  (1280 + 64 * (j))
#define XB_XGEN(j)  (2304 + 64 * (j))
#define XB_TOP      3328
#define XB_TOPGEN   3392
#define XCD_BAR_WORDS 3456
#define XB_SPIN_CAP (1u << 18)
__device__ __forceinline__ unsigned xb_ld(unsigned* p)              { return __hip_atomic_load(p, __ATOMIC_RELAXED, __HIP_MEMORY_SCOPE_AGENT); }
__device__ __forceinline__ unsigned xb_add(unsigned* p, unsigned v) { return __hip_atomic_fetch_add(p, v, __ATOMIC_RELAXED, __HIP_MEMORY_SCOPE_AGENT); }
__device__ __forceinline__ unsigned xb_xcc_id() { return (unsigned)__builtin_amdgcn_s_getreg((3 << 11) | 20) & 0xFu; }
#define XB_SPIN(cond, bar) do { unsigned _sp = 0; while (cond) { __builtin_amdgcn_s_sleep(1); \
    if ((++_sp & 255u) == 0u) { if (xb_ld(&(bar)[XB_TMO])) break; if (_sp > XB_SPIN_CAP) { atomicAdd(&(bar)[XB_TMO], 1u); break; } } } } while (0)
struct XcdBarrier { unsigned* bar; unsigned x; volatile LAS unsigned* st; };
__device__ __forceinline__ void xcd_barrier_complete(unsigned* bar, unsigned x, unsigned& nloc, unsigned& nx) {
    const unsigned G = gridDim.x * gridDim.y * gridDim.z;
    unsigned sum, cnt, mine, sp = 0u;
    for (;;) {
        sum = 0u; cnt = 0u; mine = 0u;
#pragma unroll
        for (unsigned j = 0; j < 16; ++j) { const unsigned c = xb_ld(&bar[XB_XCNT(j)]); sum += c; cnt += (c > 0u) ? 1u : 0u; mine = (j == x) ? c : mine; }
        if (sum == G) break;
        __builtin_amdgcn_s_sleep(1);
        if ((++sp & 255u) == 0u) { if (xb_ld(&bar[XB_TMO])) break; if (sp > XB_SPIN_CAP) { atomicAdd(&bar[XB_TMO], 1u); break; } }
    }
    nloc = mine > 0u ? mine : 1u; nx = cnt > 0u ? cnt : 1u;
}
__device__ __forceinline__ void xcd_barrier(const XcdBarrier& b) {
    asm volatile("s_waitcnt vmcnt(0)" ::: "memory");
    __syncthreads();
    if (threadIdx.x == 0) {
        unsigned* bar = b.bar;
        __builtin_amdgcn_s_waitcnt(0);
        unsigned nloc = b.st[0], nx = b.st[1];
        if (nloc == 0u) { xcd_barrier_complete(bar, b.x, nloc, nx); b.st[0] = nloc; b.st[1] = nx; }
        const unsigned old = xb_add(&bar[XB_XSUB(b.x)], 1u);
        const unsigned gen = old / nloc;
        if (old + 1u == (gen + 1u) * nloc) {
            __builtin_amdgcn_fence(__ATOMIC_RELEASE, "agent");
            asm volatile("s_waitcnt vmcnt(0)" ::: "memory");
            const unsigned og = xb_add(&bar[XB_TOP], 1u);
            const unsigned tg = og / nx;
            if (og + 1u == (tg + 1u) * nx) xb_add(&bar[XB_TOPGEN], 1u);
            else XB_SPIN(xb_ld(&bar[XB_TOPGEN]) == tg, bar);
            __builtin_amdgcn_fence(__ATOMIC_ACQUIRE, "agent");
            xb_add(&bar[XB_XGEN(b.x)], 1u);
            asm volatile("s_waitcnt vmcnt(0)" ::: "memory");
        } else {
            XB_SPIN(xb_ld(&bar[XB_XGEN(b.x)]) == gen, bar);
            __builtin_amdgcn_fence(__ATOMIC_ACQUIRE, "agent");
            asm volatile("s_waitcnt vmcnt(0)" ::: "memory");
        }
    }
    __syncthreads();
}
constexpr int CTL_BAR_WORD = 4096;
constexpr int LDS_MISC = 131072 + 128;
#define GRID_BAR() do { const cargs_t ap_ = get_args(); XcdBarrier b_; b_.bar = (unsigned*)(ap_->ws + WS_CTL) + CTL_BAR_WORD; b_.x = xb_xcc_id(); \
    b_.st = (volatile LAS unsigned*)(lds + LDS_MISC); xcd_barrier(b_); } while (0)

#define WSP(T, off) ((T*)(ws + (off)))
#define REP_P1 1
#define REP_P2 1
#define REP_P3 1
#define REP_P4 1
#define REP_P5 1
#define REP_P6 1
#define REP_P7 1
#define REP_P8 1
#define REP_P9 1
#define REP_P10 1
#define REP_SYNC 0
#define PHASE_BEGIN(R) _Pragma("unroll 1") for (int rep = 0; rep < (R); ++rep) {
#define PHASE_END GRID_BAR(); }
__global__ void __launch_bounds__(512, 2) fwd_megakernel(Args A_unused) {
    extern __shared__ __attribute__((aligned(16))) unsigned char lds_raw[];
    LAS unsigned char* lds = (LAS unsigned char*)lds_raw;
    {
        if (threadIdx.x < 8) ((LAS unsigned*)(lds + LDS_MISC))[threadIdx.x] = 0u;
        __syncthreads();
        const cargs_t ap = get_args();
        if (threadIdx.x == 0) (void)xb_add((unsigned*)(ap->ws + WS_CTL) + CTL_BAR_WORD + XB_XCNT(xb_xcc_id()), 1u);
    }
    cg::this_grid().sync();

#pragma unroll 1
    for (int l = 0; l < 2; ++l) {
        if (l == 0) {
        PHASE_BEGIN(REP_P1)
            const cargs_t ap = get_args(); unsigned char* const ws = ap->ws;
            const int tid = fresh_tid(), lane = tid & 63, wid = __builtin_amdgcn_readfirstlane(tid >> 6), G = gridDim.x, bx = blockIdx.x, gw = bx * 8 + wid, NGW = G * 8;
            LAS float* scr = (LAS float*)(lds + wid * 16384);
            for (int it = gw; it < 1280; it += NGW) win_item(0, it, scr, lane);
            for (int c = bx * 512 + tid; c < 1024 * 48; c += G * 512) wlat_chunk(0, c);
            const float* xin = ap->x; bf16_t* XN = WSP(bf16_t, WS_XN); float* rss = WSP(float, WS_ROWSS);
            for (int m = gw; m < TOK; m += NGW) prenorm_row(xin + (size_t)m * 1024, XN + (size_t)m * 1024, rss + (size_t)m * 16, lane);
        GRID_BAR(); }
        }
        PHASE_BEGIN(REP_P2)
            const cargs_t ap = get_args(); unsigned char* const ws = ap->ws;
            const char* hin = (l == 0) ? WSP(const char, WS_XN) : (const char*)ap->out;
            pg8::PlainOrder S{hin, (l == 0) ? WSP(const char, WS_WINT) : WSP(const char, WS_WINT1), 1024, 1024, 64, 10, 16, (int)gridDim.x, (int)blockIdx.x};
            const float* slots = WSP(const float, WS_ROWSS) + (size_t)(l * 2) * ROWSS_STRIDE;
            pg8::Unit u0; int pm0 = -1; if (S.next(0, u0)) { pm0 = u0.pm; fill_rinv_table(lds, slots, pm0); }
            pg8::EpiBf16<0, true> E{WSP(bf16_t, WS_PROJ), PLD, slots, pm0, (unsigned)(uintptr_t)(lds + LDS_RINV)};
            pg8::gemm_phase(lds, 1024, 1024, S, E);
        PHASE_END
        PHASE_BEGIN(REP_P3)
            const cargs_t ap = get_args(); unsigned char* const ws = ap->ws;
            const int tid = fresh_tid(), lane = tid & 63, wid = __builtin_amdgcn_readfirstlane(tid >> 6), G = gridDim.x, bx = blockIdx.x, gw = bx * 8 + wid, NGW = G * 8;
            const bf16_t* PROJ = WSP(const bf16_t, WS_PROJ);
            if (bx < 16) {
                const int b = bx >> 2, h = bx & 3; const float bf = ap->b_forget[l * 4 + h];
                const bf16_t* src = PROJ + ((size_t)b * SEQ + tid * 8) * PLD + C_CF + h;
                float v[8];
#pragma unroll
                for (int i = 0; i < 8; ++i) v[i] = bf2f(src[(size_t)i * PLD]);
#pragma unroll
                for (int i = 0; i < 8; ++i) { v[i] = logsig(v[i] + bf); if (i) v[i] += v[i - 1]; }
                float incl = v[7];
#pragma unroll
                for (int o = 1; o < 64; o <<= 1) { const float u = __shfl_up(incl, o); if (lane >= o) incl += u; }
                LAS float* wtot = (LAS float*)(lds + 131072 + 64);
                if (lane == 63) wtot[wid] = incl;
                __syncthreads();
                float off = incl - v[7];
                for (int w = 0; w < wid; ++w) off += wtot[w];
                float* dst = WSP(float, WS_FCUM) + (size_t)(b * 4 + h) * SEQ + tid * 8;
                f32x4 o0 = {v[0] + off, v[1] + off, v[2] + off, v[3] + off}, o1 = {v[4] + off, v[5] + off, v[6] + off, v[7] + off};
                *(f32x4*)dst = o0; *(f32x4*)(dst + 4) = o1;
            }
            const float* gq = ap->g_q_lat + l * 256; const float* gkv = ap->g_kv_lat + l * 128; const int* posp = ap->pos;
            bf16_t* LAT = WSP(bf16_t, WS_LAT); bf16_t* KROT = WSP(bf16_t, WS_KROT); bf16_t* U = WSP(bf16_t, WS_U);
            const f32x4 ggq = *(const f32x4*)(gq + 4 * lane); const float gk0 = gkv[2 * lane], gk1 = gkv[2 * lane + 1];
            const float invf = exp2f(-(float)(lane & 15) * 0.8304820237218406f);
            for (int t0 = gw * 4; t0 < TOK; t0 += NGW * 4) {
                u32x2 wq4[4], dv4[4], dg4[4]; unsigned wkv4[4]; float x14[4], x24[4], pos4[4];
#pragma unroll
                for (int j = 0; j < 4; ++j) { const bf16_t* row = PROJ + (size_t)(t0 + j) * PLD;
                    wq4[j] = *(const u32x2*)(row + C_BQL + 4 * lane); wkv4[j] = *(const unsigned*)(row + C_BKVL + 2 * lane);
                    dv4[j] = *(const u32x2*)(row + C_DV + 4 * lane); dg4[j] = *(const u32x2*)(row + C_DG + 4 * lane);
                    x14[j] = bf2f(row[C_BKR + (lane & 15)]); x24[j] = bf2f(row[C_BKR + 16 + (lane & 15)]); pos4[j] = (float)posp[t0 + j]; }
#pragma unroll
                for (int j = 0; j < 4; ++j) { const int t = t0 + j;
                    {
                        const u32x2 w = wq4[j]; const float a0 = lo_f(w.x), a1 = hi_f(w.x), a2 = lo_f(w.y), a3 = hi_f(w.y);
                        const float rinv = 1.0f / sqrtf(wave_sum(a0 * a0 + a1 * a1 + a2 * a2 + a3 * a3) * (1.0f / 256.0f) + EPS);
                        u32x2 o; o.x = pk2(a0 * rinv * ggq.x, a1 * rinv * ggq.y); o.y = pk2(a2 * rinv * ggq.z, a3 * rinv * ggq.w);
                        *(u32x2*)(LAT + (size_t)t * 384 + 4 * lane) = o;
                    }
                    {
                        const unsigned w = wkv4[j]; const float a0 = lo_f(w), a1 = hi_f(w);
                        const float rinv = 1.0f / sqrtf(wave_sum(a0 * a0 + a1 * a1) * (1.0f / 128.0f) + EPS);
                        *(unsigned*)(LAT + (size_t)t * 384 + 256 + 2 * lane) = pk2(a0 * rinv * gk0, a1 * rinv * gk1);
                    }
                    if (lane < 16) {
                        const float ang = pos4[j] * invf, kk = rintf(ang * 0.15915494309189535f);
                        float rem = fmaf(-kk, 6.2831854820251465f, ang); rem = fmaf(kk, 1.7484555e-7f, rem);
                        const float sn = __sinf(rem), cn = __cosf(rem);
                        const unsigned w = pk2(x14[j] * cn - x24[j] * sn, x24[j] * cn + x14[j] * sn);
                        KROT[(size_t)t * 32 + lane] = (bf16_t)(w & 0xffffu); KROT[(size_t)t * 32 + 16 + lane] = (bf16_t)(w >> 16);
                    }
                    {
                        const u32x2 v = dv4[j], gt = dg4[j];
                        u32x2 o; o.x = pk2(lo_f(v.x) * sigmoidf_(lo_f(gt.x)), hi_f(v.x) * sigmoidf_(hi_f(gt.x))); o.y = pk2(lo_f(v.y) * sigmoidf_(lo_f(gt.y)), hi_f(v.y) * sigmoidf_(hi_f(gt.y)));
                        *(u32x2*)(U + (size_t)t * 256 + 4 * lane) = o;
                    }
                }
            }
        PHASE_END
        PHASE_BEGIN(REP_P4)
            { const cargs_t ap = get_args(); unsigned char* const ws = ap->ws;
              pg8::PlainOrder S{WSP(const char, WS_LAT), (l == 0) ? WSP(const char, WS_WLT) : WSP(const char, WS_WLT1), 384, 384, 64, 4, 6, (int)gridDim.x, (int)blockIdx.x};
              pg8::EpiBf16<0, false> E{WSP(bf16_t, WS_QKVB), 1024, nullptr, -1, 0u};
              pg8::gemm_phase(lds, 384, 384, S, E); }
        PHASE_END
        PHASE_BEGIN(REP_P5)
            LAS int* wq = (LAS int*)(lds + 131072);
            for (;;) {
                __syncthreads();
                if (threadIdx.x == 0) { const cargs_t ap = get_args(); wq[0] = atomicAdd((int*)(ap->ws + WS_CTL) + 16 * (l * 8 + rep), 1); }
                __syncthreads();
                const int it = wq[0];
                if (it >= 768 + 256 + N_LATE_ITEMS / 16 + (l == 0 ? 80 + 96 : 0)) break;
                if (it >= 768) {
                    const int tidq = fresh_tid(), laneq = tidq & 63, widq = __builtin_amdgcn_readfirstlane(tidq >> 6);
                    if (it < 1024) conv_tokens(l, ((it - 768) * 8 + widq) * 8, laneq);
                    else if (it >= 1024 + N_LATE_ITEMS / 16) {
                        const int e = it - (1024 + N_LATE_ITEMS / 16);
                        if (e < 80) { LAS float* scr = (LAS float*)(lds + widq * 16384); win_item(l + 1, e * 16 + widq * 2, scr, laneq); win_item(l + 1, e * 16 + widq * 2 + 1, scr, laneq); }
                        else wlat_chunk(l + 1, (e - 80) * 512 + tidq);
                    }
                    else { LAS float* scr = (LAS float*)(lds + widq * 16384); const int r0 = (it - 1024) * 16 + widq * 2; late_weight_item(l, r0, scr, laneq); late_weight_item(l, r0 + 1, scr, laneq); }
                    continue;
                }
                int mode, bh, qb;
                if (it >= 384 && it < 640) { const int a = it - 384; mode = 0; bh = a & 15; qb = a >> 4; }
                else { const int k = it < 384 ? it : it - 256; const int lvl = k >> 5, w = k & 31; qb = 15 - lvl; mode = (w < 16) ? 1 : 2; bh = w & 15; }
                if (mode == 0) att::unit<0>(l, bh >> 2, bh & 3, qb, lds);
                else if (mode == 1) att::unit<1>(l, bh >> 2, bh & 3, qb, lds);
                else att::unit<2>(l, bh >> 2, bh & 3, qb, lds);
            }
        PHASE_END
        PHASE_BEGIN(REP_P6)
            const cargs_t ap = get_args(); unsigned char* const ws = ap->ws;
            const char* hin = (l == 0) ? WSP(const char, WS_XN) : (const char*)ap->out;
            pg8::GateBranchOrder S{hin, WSP(const char, WS_BR), WSP(const char, WS_WGT), WSP(const char, WS_WBT), (int)gridDim.x, (int)blockIdx.x};
            pg8::EpiGateBranch E{WSP(bf16_t, WS_MIXED), ap->b_gate + (size_t)l * 4096, WSP(const float, WS_ROWSS) + (size_t)(l * 2) * ROWSS_STRIDE, (LAS unsigned*)(lds + 131072 + 1024)};
            pg8::gemm_phase(lds, 1024, 1024, S, E);
        PHASE_END
        PHASE_BEGIN(REP_P7)
            const cargs_t ap = get_args(); unsigned char* const ws = ap->ws;
            pg8::PlainOrder S{WSP(const char, WS_MIXED), WSP(const char, WS_WOT), 1024, 1024, 64, 4, 16, (int)gridDim.x, (int)blockIdx.x};
            if (l == 0) { pg8::EpiRes<true> E{ap->x, WSP(bf16_t, WS_XA), WSP(float, WS_ROWSS) + (size_t)1 * ROWSS_STRIDE};
                pg8::gemm_phase(lds, 1024, 1024, S, E); }
            else { pg8::EpiRes<false> E{ap->out, WSP(bf16_t, WS_XA), WSP(float, WS_ROWSS) + (size_t)3 * ROWSS_STRIDE};
                pg8::gemm_phase(lds, 1024, 1024, S, E); }
        PHASE_END
        PHASE_BEGIN(REP_P9)
            const cargs_t ap = get_args(); unsigned char* const ws = ap->ws;
            pg8::PlainOrder S{WSP(const char, WS_XA), WSP(const char, WS_W1T), 1024, 1024, 64, 16, 16, (int)gridDim.x, (int)blockIdx.x};
            const float* slots = WSP(const float, WS_ROWSS) + (size_t)(l * 2 + 1) * ROWSS_STRIDE;
            pg8::Unit u0; int pm0 = -1; if (S.next(0, u0)) { pm0 = u0.pm; fill_rinv_table(lds, slots, pm0); }
            pg8::EpiBf16<2, true> E{WSP(bf16_t, WS_H), 4096, slots, pm0, (unsigned)(uintptr_t)(lds + LDS_RINV)};
            pg8::gemm_phase(lds, 1024, 1024, S, E);
        PHASE_END
        PHASE_BEGIN(REP_P10)
            const cargs_t ap = get_args(); unsigned char* const ws = ap->ws;
            pg8::PlainOrder S{WSP(const char, WS_H), WSP(const char, WS_W2T), 4096, 4096, 64, 4, 64, (int)gridDim.x, (int)blockIdx.x};
            if (l == 0) { pg8::EpiRes<false> E{WSP(const bf16_t, WS_XA), (bf16_t*)ap->out, WSP(float, WS_ROWSS) + (size_t)2 * ROWSS_STRIDE};
                pg8::gemm_phase(lds, 4096, 4096, S, E); }
            else { pg8::EpiRes<false> E{WSP(const bf16_t, WS_XA), WSP(bf16_t, WS_XN), WSP(float, WS_ROWSS) + (size_t)4 * ROWSS_STRIDE};
                pg8::gemm_phase(lds, 4096, 4096, S, E); }
        PHASE_END
    }
    _Pragma("unroll 1") for (int i = 0; i < REP_SYNC; ++i) GRID_BAR();
    {
        const cargs_t ap = get_args(); unsigned char* const ws = ap->ws;
        const int tid = fresh_tid(), lane = tid & 63, wid = __builtin_amdgcn_readfirstlane(tid >> 6), gw = blockIdx.x * 8 + wid, NGW = gridDim.x * 8;
        float* out = ap->out; const bf16_t* YF = WSP(const bf16_t, WS_XN); const f32x4* gf = (const f32x4*)ap->g_final + lane; const float* rss = WSP(const float, WS_ROWSS) + (size_t)4 * ROWSS_STRIDE;
        for (int m = gw; m < TOK; m += NGW) {
            const float rinv = __builtin_amdgcn_rsqf(wave_sum(lane < 16 ? rss[(size_t)m * 16 + lane] : 0.f) * (1.0f / 1024.0f) + EPS);
            const u32x2* yr = (const u32x2*)(YF + (size_t)m * 1024) + lane; f32x4* orow = (f32x4*)(out + (size_t)m * 1024) + lane;
            u32x2 w[4];
#pragma unroll
            for (int j = 0; j < 4; ++j) w[j] = yr[64 * j];
#pragma unroll
            for (int j = 0; j < 4; ++j) { const f32x4 g4 = gf[64 * j]; orow[64 * j] = (f32x4){lo_f(w[j].x) * rinv * g4.x, hi_f(w[j].x) * rinv * g4.y, lo_f(w[j].y) * rinv * g4.z, hi_f(w[j].y) * rinv * g4.w}; }
        }
    }
}

extern "C" void kernel_launch(void* const* d_in, const int* in_sizes, int n_in, void* d_out, int out_size, void* d_ws, size_t ws_size, hipStream_t stream) {
    static int grid = 0;
    if (grid == 0) {
        if (n_in != 22 || out_size != TOK * DM || ws_size < WS_END) { fprintf(stderr, "kernel_launch: unexpected shapes (n_in %d out %d ws %zu)\n", n_in, out_size, ws_size); grid = -1; return; }
        int dev = 0, cus = 0, per_cu = 0;
        if (hipGetDevice(&dev) != hipSuccess || hipDeviceGetAttribute(&cus, hipDeviceAttributeMultiprocessorCount, dev) != hipSuccess) { grid = -1; return; }
        if (hipFuncSetAttribute((const void*)fwd_megakernel, hipFuncAttributeMaxDynamicSharedMemorySize, LDS_BYTES) != hipSuccess) { fprintf(stderr, "hipFuncSetAttribute failed\n"); grid = -1; return; }
        if (hipOccupancyMaxActiveBlocksPerMultiprocessor(&per_cu, (const void*)fwd_megakernel, 512, LDS_BYTES) != hipSuccess || per_cu < 1) { fprintf(stderr, "occupancy query: %d blocks per CU\n", per_cu); grid = -1; return; }
        grid = cus;
    }
    if (grid < 0) return;
    (void)hipMemsetAsync((char*)d_ws + WS_CTL, 0, 65536, stream);
    Args a{};
    a.x = (const float*)d_in[0]; a.pos = (const int*)d_in[1]; a.g_mix = (const float*)d_in[2]; a.w_in = (const float*)d_in[3]; a.w_gate = (const float*)d_in[4]; a.b_gate = (const float*)d_in[5];
    a.rel_bias = (const float*)d_in[6]; a.g_q_lat = (const float*)d_in[7]; a.w_uq = (const float*)d_in[8]; a.g_kv_lat = (const float*)d_in[9]; a.w_ukv = (const float*)d_in[10];
    a.b_forget = (const float*)d_in[11]; a.w_dw = (const float*)d_in[12]; a.b_dw = (const float*)d_in[13]; a.g_conv_ln = (const float*)d_in[14]; a.b_conv_ln = (const float*)d_in[15];
    a.w_branch = (const float*)d_in[16]; a.w_o = (const float*)d_in[17]; a.g_ffn = (const float*)d_in[18]; a.w_up = (const float*)d_in[19]; a.w_down = (const float*)d_in[20]; a.g_final = (const float*)d_in[21];
    a.out = (float*)d_out; a.ws = (unsigned char*)d_ws;
    void* args[] = {&a};
    hipError_t e = hipLaunchCooperativeKernel((const void*)fwd_megakernel, dim3(grid), dim3(512), args, LDS_BYTES, stream);
    if (e != hipSuccess) fprintf(stderr, "cooperative launch failed: %s (grid %d)\n", hipGetErrorString(e), grid);
}
```

```cpp
#include <hip/hip_runtime.h>
#include <hip/hip_cooperative_groups.h>
#include <cstdio>
#include <cstdint>
namespace cg = cooperative_groups;

#define LAS __attribute__((address_space(3)))
typedef unsigned short bf16_t;
typedef short bf16x8 __attribute__((ext_vector_type(8)));
typedef short s16x4 __attribute__((ext_vector_type(4)));
typedef float f32x4 __attribute__((ext_vector_type(4)));
typedef float f32x16 __attribute__((ext_vector_type(16)));
typedef unsigned u32x4 __attribute__((ext_vector_type(4)));
typedef unsigned u32x2 __attribute__((ext_vector_type(2)));
typedef float f32x2_t __attribute__((ext_vector_type(2)));
typedef __bf16 bf16x2_t __attribute__((ext_vector_type(2)));

constexpr int NB = 4, SEQ = 4096, DM = 1024, TOK = NB * SEQ, DFF = 4096, INC = 2468, PLD = 2560;
constexpr int C_AQ = 0, C_AK = 256, C_AV = 512, C_BQL = 768, C_BKVL = 1024, C_BKR = 1152, C_CQ = 1184, C_CK = 1440, C_CV = 1696, C_CF = 1952, C_DV = 1956, C_DG = 2212;
constexpr float LOG2E = 1.4426950408889634f;
constexpr float EPS = 1e-6f;
constexpr size_t MiB = 1u << 20;
constexpr size_t WS_W1T = 4 * MiB, WS_W2T = 12 * MiB, WS_XN = 20 * MiB, WS_PROJ = 52 * MiB, WS_XA = 52 * MiB, WS_H = 116 * MiB;
constexpr size_t WS_QKVB = 132 * MiB, WS_MIXED = 132 * MiB, WS_BR = 164 * MiB, WS_LAT = 196 * MiB, WS_U = 208 * MiB;
constexpr size_t WS_WINT = 216 * MiB, WS_WGT = 221 * MiB, WS_WLT = 229 * MiB, WS_WBT = 230 * MiB, WS_WOT = 238 * MiB;
constexpr size_t WS_CTL = 244 * MiB, WS_FCUM = 244 * MiB + 256 * 1024, WS_KROT = 245 * MiB, WS_END = 256 * MiB;
constexpr size_t WS_WINT1 = 251 * MiB, WS_WLT1 = 0, WS_LATSS = 1 * MiB;
constexpr size_t WS_ROWSS = 246 * MiB, ROWSS_STRIDE = (size_t)TOK * 16;
constexpr int LDS_RINV = 131072 + 1024 + 16384;
constexpr int LDS_BYTES = LDS_RINV + 1024;

struct Args {
    const float* x; const int* pos; const float* g_mix; const float* w_in; const float* w_gate; const float* b_gate; const float* rel_bias;
    const float* g_q_lat; const float* w_uq; const float* g_kv_lat; const float* w_ukv; const float* b_forget; const float* w_dw; const float* b_dw;
    const float* g_conv_ln; const float* b_conv_ln; const float* w_branch; const float* w_o; const float* g_ffn; const float* w_up; const float* w_down; const float* g_final;
    float* out; unsigned char* ws;
};

typedef const __attribute__((address_space(4))) Args* cargs_t;
__device__ __forceinline__ cargs_t get_args() { cargs_t p = (cargs_t)__builtin_amdgcn_kernarg_segment_ptr(); asm volatile("" : "+s"(p)); return p; }
__device__ __forceinline__ int fresh_tid() { int t = threadIdx.x; asm volatile("" : "+v"(t)); return t; }
__device__ __forceinline__ float bf2f(unsigned short b) { return __uint_as_float((unsigned)b << 16); }
__device__ __forceinline__ unsigned pk2(float lo, float hi) { f32x2_t v = {lo, hi}; bf16x2_t b = __builtin_convertvector(v, bf16x2_t); return __builtin_bit_cast(unsigned, b); }
__device__ __forceinline__ float lo_f(unsigned w) { return __uint_as_float(w << 16); }
__device__ __forceinline__ float hi_f(unsigned w) { return __uint_as_float(w & 0xffff0000u); }
__device__ __forceinline__ float wave_sum(float v) {
#pragma unroll
    for (int o = 1; o < 64; o <<= 1) v += __shfl_xor(v, o);
    return v;
}
__device__ __forceinline__ float sigmoidf_(float x) { return 1.0f / (1.0f + __expf(-x)); }
#define LDS_WAIT() asm volatile("s_waitcnt lgkmcnt(0)" ::: "memory")
__device__ __forceinline__ float row_rinv(const float* slots, int row, int fq) {
    const f32x4 a = *(const f32x4*)(slots + (size_t)row * 16 + 4 * fq);
    float s = (a.x + a.y) + (a.z + a.w);
    s += __shfl_xor(s, 16); s += __shfl_xor(s, 32);
    return __builtin_amdgcn_rsqf(s * (1.0f / 1024.0f) + EPS);
}
__device__ __forceinline__ void fill_rinv_table(LAS unsigned char* lds, const float* slots, int pm) {
    const int t = fresh_tid();
    if (t < 256) { const f32x4* p = (const f32x4*)(slots + (size_t)(pm * 256 + t) * 16); const f32x4 a = p[0], b = p[1], c = p[2], d = p[3];
        const float s = (((a.x + a.y) + (a.z + a.w)) + ((b.x + b.y) + (b.z + b.w))) + (((c.x + c.y) + (c.z + c.w)) + ((d.x + d.y) + (d.z + d.w)));
        ((LAS float*)(lds + LDS_RINV))[t] = __builtin_amdgcn_rsqf(s * (1.0f / 1024.0f) + EPS); }
    __syncthreads();
}
__device__ __forceinline__ float lds_rinv_read(unsigned addr) { float r; asm volatile("ds_read_b32 %0, %1" : "=v"(r) : "v"(addr)); return r; }
namespace pg8 {
constexpr int BM = 256, BK = 64, HALF = 128, HTB = HALF * BK * 2, STAGE_BYTES = 8 * HTB, NXCD = 8, WGM = 8;
__host__ __device__ __forceinline__ int lds_byte(int r, int c) { const int st = (r >> 4) * 2 + (c >> 5), rr = r & 15, cc = c & 31, ob = rr * 64 + cc * 2; return st * 1024 + (ob ^ (((ob >> 9) & 1) << 5)); }
__host__ __device__ __forceinline__ void stage_rc(int b, int& R, int& C) { const int st = b / 1024, sb = b % 1024, swz = sb ^ (((sb >> 9) & 1) << 5); R = (st >> 1) * 16 + swz / 64; C = (st & 1) * 32 + (swz % 64) / 2; }
__host__ __device__ __forceinline__ int perm32(int rho) { const int n = rho >> 4, i = rho & 15; return 8 * (i >> 2) + 4 * n + (i & 3); }

struct Unit { int pm, pn, nt, kind; const char* a; const char* b; };

__device__ __forceinline__ bool tile_of(int L, int nM, int nN, int& pm, int& pn) {
    const int nwg = nM * nN; if (L >= nwg) return false;
    int wgid = L; { const int q = nwg / NXCD, r = nwg % NXCD, xcd = wgid % NXCD, off = wgid / NXCD; wgid = (xcd < r ? xcd * (q + 1) : r * (q + 1) + (xcd - r) * q) + off; }
    const int nig = WGM * nN, gid = wgid / nig, fm = gid * WGM, gsz = (nM - fm) < WGM ? (nM - fm) : WGM;
    pm = fm + ((wgid % nig) % gsz); pn = (wgid % nig) / gsz; return true;
}
struct PlainOrder {
    const char* A; const char* Bt; int lda, ldb, nM, nN, nt, G, c;
    __device__ __forceinline__ bool next(int i, Unit& u) const {
        int pm, pn; if (!tile_of(i * G + c, nM, nN, pm, pn)) return false;
        u.pm = pm; u.pn = pn; u.nt = nt; u.kind = 0; u.a = A + (size_t)pm * 256 * lda * 2; u.b = Bt + (size_t)pn * 256 * ldb * 2; return true;
    }
};
struct GateBranchOrder {
    const char* XN; const char* BR; const char* WgT; const char* WbT; int G, c;
    __device__ __forceinline__ bool next(int i, Unit& u) const {
        const int gi = i >> 3, j = i & 7; int pm, pd; if (!tile_of(gi * G + c, 64, 4, pm, pd)) return false;
        const int n = j >> 1, kind = j & 1; u.pm = pm; u.pn = n * 4 + pd; u.kind = kind;
        if (kind == 0) { u.nt = 16; u.a = XN + (size_t)pm * 256 * 1024 * 2; u.b = WgT + (size_t)u.pn * 256 * 1024 * 2; }
        else { u.nt = 4; u.a = BR + ((size_t)pm * 256 * 1024 + n * 256) * 2; u.b = WbT + ((size_t)u.pn * 256 * 1024 + n * 256) * 2; }
        return true;
    }
};

template <int ACT  , int RS  , bool LATSS = false  > struct EpiBf16 {
    static constexpr bool PERM = true; struct State {};
    bf16_t* O; int ldc; const float* rowss; int pm_tab; unsigned tab; float* latss;
    __device__ __forceinline__ void operator()(const f32x4 (&acc)[2][2][4][2], State&, const Unit& u, int wr, int wc, int fr, int fq) const {
        asm volatile("" : "+v"(fr), "+v"(fq));
        const int row0 = u.pm * BM + wr * 64 + fr, col0 = u.pn * BM + wc * 32 + 8 * fq;
        float rv[2][4];
        if (RS == 1) {
            if (u.pm == pm_tab) {
#pragma unroll
                for (int ai = 0; ai < 2; ++ai)
#pragma unroll
                    for (int m = 0; m < 4; ++m) rv[ai][m] = lds_rinv_read(tab + (unsigned)(wr * 64 + fr + ai * HALF + m * 16) * 4u);
                asm volatile("s_waitcnt lgkmcnt(0)" : "+v"(rv[0][0]), "+v"(rv[0][1]), "+v"(rv[0][2]), "+v"(rv[0][3]), "+v"(rv[1][0]), "+v"(rv[1][1]), "+v"(rv[1][2]), "+v"(rv[1][3]));
            } else {
#pragma unroll
                for (int ai = 0; ai < 2; ++ai)
#pragma unroll
                    for (int m = 0; m < 4; ++m) rv[ai][m] = row_rinv(rowss, row0 + ai * HALF + m * 16, fq);
            }
        }
#pragma unroll
        for (int ai = 0; ai < 2; ++ai)
#pragma unroll
            for (int m = 0; m < 4; ++m) { bf16_t* rowp = O + (size_t)(row0 + ai * HALF + m * 16) * ldc + col0;
                float rinv = 1.f; if (RS == 1) rinv = rv[ai][m];
                if (RS == 2) { const f32x4 a = *(const f32x4*)(latss + (size_t)(row0 + ai * HALF + m * 16) * 8 + (u.pn >= 2 ? 4 : 0));
                    rinv = __builtin_amdgcn_rsqf(((a.x + a.y) + (a.z + a.w)) * (u.pn >= 2 ? (1.0f / 128.0f) : (1.0f / 256.0f)) + EPS); }
                float lss = 0.f;
#pragma unroll
                for (int bj = 0; bj < 2; ++bj) { f32x4 v0 = acc[ai][bj][m][0], v1 = acc[ai][bj][m][1];
                    if (RS) { v0 = v0 * rinv; v1 = v1 * rinv; }
                    if (LATSS) { if (bj == 0 || u.pn == 3) lss += ((v0.x * v0.x + v0.y * v0.y) + (v0.z * v0.z + v0.w * v0.w)) + ((v1.x * v1.x + v1.y * v1.y) + (v1.z * v1.z + v1.w * v1.w)); }
                    if (ACT == 2) {
#pragma unroll
                        for (int e = 0; e < 4; ++e) { const float a0 = fmaxf(v0[e], 0.f), a1 = fmaxf(v1[e], 0.f); v0[e] = a0 * a0; v1[e] = a1 * a1; } }
                    u32x4 w; w.x = pk2(v0[0], v0[1]); w.y = pk2(v0[2], v0[3]); w.z = pk2(v1[0], v1[1]); w.w = pk2(v1[2], v1[3]);
                    *(u32x4*)(rowp + bj * HALF) = w; }
                if (LATSS) { if (u.pn == 3 || u.pn == 4) { lss += __shfl_xor(lss, 16); lss += __shfl_xor(lss, 32);
                    if (fq == 0) latss[(size_t)(row0 + ai * HALF + m * 16) * 8 + (u.pn == 4 ? 4 : 0) + wc] = lss; } } }
    }
};
template <bool BASEF32> struct EpiRes {
    static constexpr bool PERM = true; struct State {};
    const void* base; bf16_t* out; float* rowss;
    __device__ __forceinline__ void operator()(const f32x4 (&acc)[2][2][4][2], State&, const Unit& u, int wr, int wc, int fr, int fq) const {
        asm volatile("" : "+v"(fr), "+v"(fq));
        const int row0 = u.pm * BM + wr * 64 + fr, col0 = u.pn * BM + wc * 32 + 8 * fq;
#pragma unroll
        for (int ai = 0; ai < 2; ++ai) {
            f32x4 bs[4][2][2];
#pragma unroll
            for (int m = 0; m < 4; ++m) { const size_t off = (size_t)(row0 + ai * HALF + m * 16) * 1024 + col0;
#pragma unroll
                for (int bj = 0; bj < 2; ++bj) {
                    if (BASEF32) { bs[m][bj][0] = *(const f32x4*)((const float*)base + off + bj * HALF); bs[m][bj][1] = *(const f32x4*)((const float*)base + off + bj * HALF + 4); }
                    else { const u32x4 w = *(const u32x4*)((const bf16_t*)base + off + bj * HALF);
                        bs[m][bj][0] = (f32x4){lo_f(w.x), hi_f(w.x), lo_f(w.y), hi_f(w.y)}; bs[m][bj][1] = (f32x4){lo_f(w.z), hi_f(w.z), lo_f(w.w), hi_f(w.w)}; } } }
            asm volatile("" ::: "memory");
#pragma unroll
            for (int m = 0; m < 4; ++m) { const int row = row0 + ai * HALF + m * 16; const size_t off = (size_t)row * 1024 + col0; float ss = 0.f;
#pragma unroll
                for (int bj = 0; bj < 2; ++bj) { const f32x4 v0 = bs[m][bj][0] + acc[ai][bj][m][0], v1 = bs[m][bj][1] + acc[ai][bj][m][1];
                    u32x4 w; w.x = pk2(v0[0], v0[1]); w.y = pk2(v0[2], v0[3]); w.z = pk2(v1[0], v1[1]); w.w = pk2(v1[2], v1[3]); *(u32x4*)(out + off + bj * HALF) = w;
                    ss += ((v0.x * v0.x + v0.y * v0.y) + (v0.z * v0.z + v0.w * v0.w)) + ((v1.x * v1.x + v1.y * v1.y) + (v1.z * v1.z + v1.w * v1.w)); }
                ss += __shfl_xor(ss, 16); ss += __shfl_xor(ss, 32); if (fq == 0) rowss[(size_t)row * 16 + u.pn * 4 + wc] = ss; }
            asm volatile("" ::: "memory");
        }
    }
};
struct EpiGateBranch {
    static constexpr bool PERM = true;
    struct State { unsigned g8[2][2][4][2]; };
    bf16_t* mixed; const float* bgate; const float* rowss; LAS unsigned* glds;
    __device__ __forceinline__ void operator()(const f32x4 (&acc)[2][2][4][2], State& st, const Unit& u, int wr, int wc, int fr, int fq) const {
        asm volatile("" : "+v"(fr), "+v"(fq));
        const int rl0 = wr * 64 + fr, cl0 = wc * 32 + 8 * fq, n = u.pn >> 2, pd = u.pn & 3;
        LAS unsigned* gl = glds + (wr * 4 + wc) * 512 + (fq * 16 + fr) * 8;
        if (u.kind == 0) {
            f32x4 bv[2][2];
#pragma unroll
            for (int bj = 0; bj < 2; ++bj)
#pragma unroll
                for (int q = 0; q < 2; ++q) bv[bj][q] = *(const f32x4*)(bgate + u.pn * BM + cl0 + bj * HALF + 4 * q);
#pragma unroll
            for (int ai = 0; ai < 2; ++ai)
#pragma unroll
                for (int m = 0; m < 4; ++m) {
                    const float rinv = row_rinv(rowss, u.pm * BM + rl0 + ai * HALF + m * 16, fq);
#pragma unroll
                    for (int bj = 0; bj < 2; ++bj)
#pragma unroll
                        for (int q = 0; q < 2; ++q) { const f32x4 v = acc[ai][bj][m][q] * rinv + bv[bj][q]; unsigned w = 0u;
#pragma unroll
                            for (int e = 0; e < 4; ++e) w |= (unsigned)(sigmoidf_(v[e]) * 255.0f + 0.5f) << (8 * e);
                            if (ai == 1 && bj == 1) gl[m * 2 + q] = w; else st.g8[ai][bj][m][q] = w; } }
        } else {
#pragma unroll
            for (int ai = 0; ai < 2; ++ai) {
                u32x4 oo[4][2];
#pragma unroll
                for (int m = 0; m < 4; ++m) { const int rl = rl0 + ai * HALF + m * 16; const bf16_t* mp = mixed + (size_t)(u.pm * BM + rl) * 1024 + pd * 256 + cl0;
#pragma unroll
                    for (int bj = 0; bj < 2; ++bj) { oo[m][bj] = (u32x4){0u, 0u, 0u, 0u}; if (n > 0) oo[m][bj] = *(const u32x4*)(mp + bj * HALF); } }
                asm volatile("" ::: "memory");
#pragma unroll
                for (int m = 0; m < 4; ++m) { const int rl = rl0 + ai * HALF + m * 16; bf16_t* mp = mixed + (size_t)(u.pm * BM + rl) * 1024 + pd * 256 + cl0;
#pragma unroll
                    for (int bj = 0; bj < 2; ++bj) { const unsigned g0 = (ai == 1 && bj == 1) ? gl[m * 2] : st.g8[ai][bj][m][0], g1 = (ai == 1 && bj == 1) ? gl[m * 2 + 1] : st.g8[ai][bj][m][1]; const u32x4 o = oo[m][bj]; const f32x4 a0 = acc[ai][bj][m][0] * (1.0f / 255.0f), a1 = acc[ai][bj][m][1] * (1.0f / 255.0f);
                        float v[8];
                        v[0] = fmaf(a0[0], (float)(g0 & 255u), lo_f(o.x)); v[1] = fmaf(a0[1], (float)((g0 >> 8) & 255u), hi_f(o.x)); v[2] = fmaf(a0[2], (float)((g0 >> 16) & 255u), lo_f(o.y)); v[3] = fmaf(a0[3], (float)(g0 >> 24), hi_f(o.y));
                        v[4] = fmaf(a1[0], (float)(g1 & 255u), lo_f(o.z)); v[5] = fmaf(a1[1], (float)((g1 >> 8) & 255u), hi_f(o.z)); v[6] = fmaf(a1[2], (float)((g1 >> 16) & 255u), lo_f(o.w)); v[7] = fmaf(a1[3], (float)(g1 >> 24), hi_f(o.w));
                        u32x4 w; w.x = pk2(v[0], v[1]); w.y = pk2(v[2], v[3]); w.z = pk2(v[4], v[5]); w.w = pk2(v[6], v[7]);
                        *(u32x4*)(mp + bj * HALF) = w; } }
                asm volatile("" ::: "memory");
            }
        }
    }
};

template <class Epi, class Sched>
__device__ __forceinline__ void gemm_phase(LAS unsigned char* lds, const int lda, const int ldb, const Sched& S, const Epi& E) {
    const int tid = fresh_tid(), wid = __builtin_amdgcn_readfirstlane(tid >> 6), lane = tid & 63, wr = wid >> 2, wc = wid & 3, fr = lane & 15, fq = lane >> 4;
    unsigned voffA[2], voffB[2];
#pragma unroll
    for (int i = 0; i < 2; ++i) { int R, C; stage_rc(tid * 16 + i * 8192, R, C); const int Rb = Epi::PERM ? ((R & ~31) + perm32(R & 31)) : R;
        voffA[i] = (unsigned)(R * lda + C) * 2u; voffB[i] = (unsigned)(Rb * ldb + C) * 2u; }
    const size_t kstep = (size_t)(BK * 2);
    const size_t hstepA = (size_t)HALF * lda * 2, hstepB = (size_t)HALF * ldb * 2;
    const unsigned ldsw = (unsigned)wid * 1024u;
    const int aoff = lds_byte(wr * 64 + fr, fq * 8), boff = lds_byte(wc * 32 + fr, fq * 8);
#define PG8_SA(b, h) (((b) * 2 + (h)) * HTB)
#define PG8_SB(b, h) ((4 + (b) * 2 + (h)) * HTB)
#define PG8_STAGE(bufoff, gbase, voff) do { _Pragma("unroll") for (int _i = 0; _i < 2; ++_i) \
        __builtin_amdgcn_global_load_lds((const unsigned*)((const char*)(gbase) + (voff)[_i]), (LAS unsigned*)(lds + (bufoff) + ldsw + _i * 8192), 16, 0, 0); } while (0)
#define PG8_LDA(dst, b, h) do { _Pragma("unroll") for (int m = 0; m < 4; ++m) _Pragma("unroll") for (int k = 0; k < 2; ++k) dst[m][k] = *(const LAS bf16x8*)(lds + PG8_SA(b, h) + aoff + m * 2048 + k * 1024); } while (0)
#define PG8_LDB(dst, b, h) do { _Pragma("unroll") for (int n = 0; n < 2; ++n) _Pragma("unroll") for (int k = 0; k < 2; ++k) dst[n][k] = *(const LAS bf16x8*)(lds + PG8_SB(b, h) + boff + n * 2048 + k * 1024); } while (0)
#define PG8_MMA(ai, bj, At, Bt) do { __builtin_amdgcn_s_setprio(1); _Pragma("unroll") for (int m = 0; m < 4; ++m) _Pragma("unroll") for (int n = 0; n < 2; ++n) _Pragma("unroll") for (int k = 0; k < 2; ++k) \
        acc[ai][bj][m][n] = __builtin_amdgcn_mfma_f32_16x16x32_bf16(Bt[n][k], At[m][k], acc[ai][bj][m][n], 0, 0, 0); __builtin_amdgcn_s_setprio(0); } while (0)
#define PG8_WAIT_V(n) asm volatile("s_waitcnt vmcnt(" #n ")" ::: "memory")
#define PG8_WAIT_L(n) asm volatile("s_waitcnt lgkmcnt(" #n ")" ::: "memory")
#define PG8_BAR __builtin_amdgcn_s_barrier()
#define PG8_SCHED __builtin_amdgcn_sched_barrier(0)
    Unit cur, nxt; int ui = 0;
    if (!S.next(0, cur)) return;
    f32x4 acc[2][2][4][2];
#pragma unroll
    for (int a = 0; a < 2; ++a)
#pragma unroll
        for (int b = 0; b < 2; ++b)
#pragma unroll
            for (int m = 0; m < 4; ++m)
#pragma unroll
                for (int n = 0; n < 2; ++n) acc[a][b][m][n] = (f32x4){0.f, 0.f, 0.f, 0.f};
    bf16x8 At[4][2], B0[2][2], B1[2][2];
    typename Epi::State est;
    const char* cA = cur.a; const char* cB = cur.b;
    PG8_STAGE(PG8_SB(0, 0), cB, voffB); PG8_STAGE(PG8_SB(0, 1), cB + hstepB, voffB); PG8_STAGE(PG8_SA(0, 0), cA, voffA); PG8_STAGE(PG8_SA(0, 1), cA + hstepA, voffA);
    if (wr == 1) PG8_BAR;
    PG8_WAIT_V(2); PG8_BAR;
    PG8_STAGE(PG8_SB(1, 0), cB + kstep, voffB); PG8_STAGE(PG8_SA(1, 0), cA + kstep, voffA); PG8_STAGE(PG8_SB(1, 1), cB + hstepB + kstep, voffB);
    PG8_WAIT_V(6); PG8_BAR;
    for (;;) {
        const bool has_next = S.next(ui + 1, nxt);
        const char* nA = has_next ? nxt.a : cA; const char* nB = has_next ? nxt.b : cB;
        const int nt = cur.nt;
        for (int t = 0; t < nt; t += 2) {
            const bool last = (t == nt - 2);
            const char* a1 = cA + (size_t)(t + 1) * kstep;
            const char* a2 = last ? nA : cA + (size_t)(t + 2) * kstep; const char* b2 = last ? nB : cB + (size_t)(t + 2) * kstep;
            const char* a3 = a2 + kstep; const char* b3 = b2 + kstep;
            PG8_LDB(B0, 0, 0); PG8_LDB(B1, 0, 1); PG8_SCHED; PG8_LDA(At, 0, 0); PG8_STAGE(PG8_SA(1, 1), a1 + hstepA, voffA);
            PG8_WAIT_V(8); PG8_WAIT_L(0); PG8_BAR; PG8_MMA(0, 0, At, B0); PG8_MMA(0, 1, At, B1); PG8_BAR; PG8_SCHED;
            PG8_LDA(At, 0, 1); PG8_STAGE(PG8_SB(0, 0), b2, voffB); PG8_STAGE(PG8_SB(0, 1), b2 + hstepB, voffB); PG8_STAGE(PG8_SA(0, 0), a2, voffA);
            PG8_WAIT_V(8); PG8_WAIT_L(0); PG8_BAR; PG8_MMA(1, 0, At, B0); PG8_MMA(1, 1, At, B1); PG8_BAR; PG8_SCHED;
            PG8_LDB(B0, 1, 0); PG8_LDB(B1, 1, 1); PG8_SCHED; PG8_LDA(At, 1, 0); PG8_STAGE(PG8_SA(0, 1), a2 + hstepA, voffA);
            PG8_WAIT_V(8); PG8_WAIT_L(0); PG8_BAR; PG8_MMA(0, 0, At, B0); PG8_MMA(0, 1, At, B1); PG8_BAR; PG8_SCHED;
            PG8_LDA(At, 1, 1); PG8_STAGE(PG8_SB(1, 0), b3, voffB); PG8_STAGE(PG8_SB(1, 1), b3 + hstepB, voffB); PG8_STAGE(PG8_SA(1, 0), a3, voffA);
            PG8_WAIT_V(8); PG8_WAIT_L(0); PG8_BAR; PG8_MMA(1, 0, At, B0); PG8_MMA(1, 1, At, B1); PG8_BAR; PG8_SCHED;
        }
        if (wr == 0) PG8_BAR;
        E(acc, est, cur, wr, wc, fr, fq);
        if (!has_next) break;
#pragma unroll
        for (int a = 0; a < 2; ++a)
#pragma unroll
            for (int b = 0; b < 2; ++b)
#pragma unroll
                for (int m = 0; m < 4; ++m)
#pragma unroll
                    for (int n = 0; n < 2; ++n) acc[a][b][m][n] = (f32x4){0.f, 0.f, 0.f, 0.f};
        cur = nxt; cA = nA; cB = nB; ++ui;
        if (wr == 1) PG8_BAR;
    }
    PG8_WAIT_V(0);
    PG8_BAR;
#undef PG8_SA
#undef PG8_SB
#undef PG8_STAGE
#undef PG8_LDA
#undef PG8_LDB
#undef PG8_MMA
#undef PG8_WAIT_V
#undef PG8_WAIT_L
#undef PG8_BAR
#undef PG8_SCHED
}
}

namespace att {
constexpr int VP = 144;
typedef short v4i16_t __attribute__((ext_vector_type(4)));
__device__ __forceinline__ int crow(int i, int h) { return (i & 3) + 8 * (i >> 2) + 4 * h; }
__device__ __forceinline__ s16x4 vtr(const LAS unsigned char* p) { return __builtin_bit_cast(s16x4, __builtin_amdgcn_ds_read_tr16_b64_v4i16((LAS v4i16_t*)p)); }
#define MFMA32(a, b, c) __builtin_amdgcn_mfma_f32_32x32x16_bf16((a), (b), (c), 0, 0, 0)

template <int MODE>
__device__ __forceinline__ void unit(int layer, int b, int h, int qb, LAS unsigned char* lds) {
    const cargs_t ap = get_args();
    unsigned char* const ws_ = ap->ws;
    constexpr int DK = MODE == 1 ? 96 : 64, ND = DK / 16, KP = DK * 2 + 16, KBUF = 64 * KP, VBUF = 64 * VP;
    LAS unsigned char* Ks = lds; LAS unsigned char* Vs = lds + 2 * KBUF;
    LAS float* Fs = (LAS float*)(lds + 2 * KBUF + 2 * VBUF); LAS float* Tab = Fs + 128;
    const int tid = fresh_tid(), lane = tid & 63, wid = __builtin_amdgcn_readfirstlane(tid >> 6), r = lane & 31, hh = lane >> 5;
    const size_t tok0 = (size_t)b * SEQ;
    const int qw = qb * 256 + wid * 32, qc = qw >> 6;
    const bf16_t* PROJ = (const bf16_t*)(ws_ + WS_PROJ); const bf16_t* QKVB = (const bf16_t*)(ws_ + WS_QKVB); const bf16_t* KROT = (const bf16_t*)(ws_ + WS_KROT);
    const float* FCUM = (const float*)(ws_ + WS_FCUM) + (size_t)(b * 4 + h) * SEQ;
    bf16_t* BR = (bf16_t*)(ws_ + WS_BR);
    const bf16_t *Qp, *Kp, *Vp; int ldq, ldk;
    if (MODE == 0) { Qp = PROJ + C_AQ + h * 64; Kp = PROJ + C_AK + h * 64; Vp = PROJ + C_AV + h * 64; ldq = PLD; ldk = PLD; }
    else if (MODE == 2) { Qp = PROJ + C_CQ + h * 64; Kp = PROJ + C_CK + h * 64; Vp = PROJ + C_CV + h * 64; ldq = PLD; ldk = PLD; }
    else { Qp = QKVB + h * 96; Kp = QKVB + 512 + h * 128; Vp = Kp + 64; ldq = 1024; ldk = 1024; }
    const int t_lo = (MODE == 0) ? (qb * 4 - 8 > 0 ? qb * 4 - 8 : 0) : 0, t_hi = qb * 4 + 4;
    const float cs = (MODE == 1 ? 0.10206207261596577f : 0.125f) * LOG2E;

    u32x4 kregA, vregA, kr2A, kregB, vregB, kr2B; float fregA = 0.f, fregB = 0.f;
    const int srow = tid >> 3, sch = tid & 7;
#define ATT_LOAD(j, X) do { const size_t trow = tok0 + (size_t)(j) * 64; \
        kreg##X = *(const u32x4*)(Kp + (trow + srow) * ldk + sch * 8); vreg##X = *(const u32x4*)(Vp + (trow + srow) * ldk + sch * 8); \
        if (MODE == 1) { if (tid < 256) kr2##X = *(const u32x4*)(KROT + (trow + (tid >> 2)) * 32 + (tid & 3) * 8); } \
        if (MODE == 2) { if (tid < 64) freg##X = FCUM[(j) * 64 + tid]; } } while (0)
#define ATT_STORE(s, X) do { *(LAS u32x4*)(Ks + (s) * KBUF + srow * KP + sch * 16) = kreg##X; *(LAS u32x4*)(Vs + (s) * VBUF + srow * VP + sch * 16) = vreg##X; \
        if (MODE == 1) { if (tid < 256) *(LAS u32x4*)(Ks + (s) * KBUF + (tid >> 2) * KP + 128 + (tid & 3) * 16) = kr2##X; } \
        if (MODE == 2) { if (tid < 64) Fs[(s) * 64 + tid] = freg##X * LOG2E; } } while (0)

    ATT_LOAD(t_hi - 1, A);
    ATT_LOAD(t_hi - 2, B);
    if (MODE == 0) { if (tid < 257) Tab[tid] = ap->rel_bias[(size_t)(layer * 4 + h) * 257 + tid] * LOG2E; }
    bf16x8 qf[ND];
    { const bf16_t* qrow = Qp + (tok0 + qw + r) * ldq;
#pragma unroll
      for (int d0 = 0; d0 < ND; ++d0) qf[d0] = *(const bf16x8*)(qrow + d0 * 16 + hh * 8); }
    if (MODE == 1) {
        const float pos = (float)ap->pos[tok0 + qw + r];
#pragma unroll
        for (int j = 0; j < 8; ++j) {
            const float invf = exp2f(-(float)(8 * hh + j) * 0.8304820237218406f);
            const float ang = pos * invf, kk = rintf(ang * 0.15915494309189535f);
            float rem = fmaf(-kk, 6.2831854820251465f, ang); rem = fmaf(kk, 1.7484555e-7f, rem);
            const float sn = __sinf(rem), cn = __cosf(rem);
            const float x1 = bf2f((unsigned short)qf[4][j]), x2 = bf2f((unsigned short)qf[5][j]);
            const unsigned w = pk2(x1 * cn - x2 * sn, x2 * cn + x1 * sn);
            qf[4][j] = (short)(w & 0xffffu); qf[5][j] = (short)(w >> 16);
        }
    }
    float fq = 0.f;
    if (MODE == 2) fq = FCUM[qw + r] * LOG2E;
    float m_run = -INFINITY, l_run = 0.f;
    f32x16 o0, o1;
#pragma unroll
    for (int i = 0; i < 16; ++i) { o0[i] = 0.f; o1[i] = 0.f; }
    ATT_STORE(0, A);
    __syncthreads();
    const int i16 = lane & 15, vq = i16 >> 2, vp = i16 & 3, vblk = (lane >> 4) & 1;
    const int voff = (4 * hh + vq) * VP + vblk * 32 + vp * 8;

    auto compute = [&](const int j, const int s) __attribute__((always_inline)) {
        const bool active = (MODE == 0) ? (j <= qc && j >= qc - 8) : (j <= qc);
        if (active) {
            const LAS unsigned char* kb = Ks + s * KBUF + r * KP + hh * 16;
            f32x16 p0, p1;
#pragma unroll
            for (int i = 0; i < 16; ++i) { p0[i] = 0.f; p1[i] = 0.f; }
#pragma unroll
            for (int d0 = 0; d0 < ND; ++d0) {
                const bf16x8 kf0 = *(const LAS bf16x8*)(kb + d0 * 32), kf1 = *(const LAS bf16x8*)(kb + 32 * KP + d0 * 32);
                p0 = MFMA32(kf0, qf[d0], p0); p1 = MFMA32(kf1, qf[d0], p1);
            }
            if (MODE == 0) {
                const int delta = qc - j;
                if (delta >= 3) { const float cb = Tab[256];
#pragma unroll
                    for (int i = 0; i < 16; ++i) { p0[i] = fmaf(p0[i], cs, cb); p1[i] = fmaf(p1[i], cs, cb); }
                } else { const int brel = 64 * delta + (qw & 63) + r + 128;
#pragma unroll
                    for (int i = 0; i < 16; ++i) { const int kj = crow(i, hh); int i0 = brel - kj, i1 = brel - kj - 32;
                        i0 = i0 < 0 ? 0 : (i0 > 256 ? 256 : i0); i1 = i1 < 0 ? 0 : (i1 > 256 ? 256 : i1);
                        p0[i] = fmaf(p0[i], cs, Tab[i0]); p1[i] = fmaf(p1[i], cs, Tab[i1]); }
                }
            } else if (MODE == 1) {
#pragma unroll
                for (int i = 0; i < 16; ++i) { p0[i] *= cs; p1[i] *= cs; }
            } else {
                const LAS float* fs = Fs + s * 64 + 4 * hh;
#pragma unroll
                for (int g = 0; g < 4; ++g) { const f32x4 f0 = *(const LAS f32x4*)(fs + 8 * g), f1 = *(const LAS f32x4*)(fs + 32 + 8 * g);
#pragma unroll
                    for (int e = 0; e < 4; ++e) { p0[4 * g + e] = fmaf(p0[4 * g + e], cs, fq - f0[e]); p1[4 * g + e] = fmaf(p1[4 * g + e], cs, fq - f1[e]); } }
                if (j == qc) { const int qrel = (qw & 63) + r;
#pragma unroll
                    for (int i = 0; i < 16; ++i) { const int kj = crow(i, hh); if (kj > qrel) p0[i] = -INFINITY; if (kj + 32 > qrel) p1[i] = -INFINITY; } }
            }
            float mx = p0[0];
#pragma unroll
            for (int i = 1; i < 16; ++i) mx = fmaxf(mx, p0[i]);
#pragma unroll
            for (int i = 0; i < 16; ++i) mx = fmaxf(mx, p1[i]);
            { auto rr = __builtin_amdgcn_permlane32_swap(__float_as_uint(mx), __float_as_uint(mx), false, false); mx = fmaxf(__uint_as_float(rr[0]), __uint_as_float(rr[1])); }
            if (__all(mx < m_run - 40.f)) return;
            if (__any(mx > m_run)) {
                const float m_new = fmaxf(m_run, mx);
                const float alpha = __builtin_amdgcn_exp2f(m_run - m_new);
                m_run = m_new; l_run *= alpha;
#pragma unroll
                for (int i = 0; i < 16; ++i) { o0[i] *= alpha; o1[i] *= alpha; }
            }
            float sum = 0.f;
#pragma unroll
            for (int i = 0; i < 16; ++i) { p0[i] = __builtin_amdgcn_exp2f(p0[i] - m_run); p1[i] = __builtin_amdgcn_exp2f(p1[i] - m_run); sum += p0[i] + p1[i]; }
            l_run += sum;
            const LAS unsigned char* vb = Vs + s * VBUF + voff;
#pragma unroll
            for (int kbk = 0; kbk < 2; ++kbk)
#pragma unroll
                for (int st = 0; st < 2; ++st) {
                    const f32x16& pp = kbk ? p1 : p0;
                    u32x4 pw; pw.x = pk2(pp[8 * st + 0], pp[8 * st + 1]); pw.y = pk2(pp[8 * st + 2], pp[8 * st + 3]); pw.z = pk2(pp[8 * st + 4], pp[8 * st + 5]); pw.w = pk2(pp[8 * st + 6], pp[8 * st + 7]);
                    const bf16x8 pf = __builtin_bit_cast(bf16x8, pw);
                    const LAS unsigned char* vr = vb + (32 * kbk + 16 * st) * VP;
                    const s16x4 a_lo = vtr(vr), a_hi = vtr(vr + 8 * VP), b_lo = vtr(vr + 64), b_hi = vtr(vr + 8 * VP + 64);
                    const bf16x8 v0 = __builtin_shufflevector(a_lo, a_hi, 0, 1, 2, 3, 4, 5, 6, 7), v1 = __builtin_shufflevector(b_lo, b_hi, 0, 1, 2, 3, 4, 5, 6, 7);
                    o0 = MFMA32(v0, pf, o0); o1 = MFMA32(v1, pf, o1);
                }
        }
    };
    for (int j = t_hi - 1; j >= t_lo; j -= 2) {
        if (j - 2 >= t_lo) ATT_LOAD(j - 2, A);
        compute(j, 0);
        ATT_STORE(1, B);
        __syncthreads();
        if (j - 3 >= t_lo) ATT_LOAD(j - 3, B);
        compute(j - 1, 1);
        if (j - 2 >= t_lo) ATT_STORE(0, A);
        __syncthreads();
    }
    const float l_tot = l_run + __shfl_xor(l_run, 32);
    const float inv = 1.0f / l_tot;
    bf16_t* dst = BR + (tok0 + qw + r) * 1024 + (MODE == 0 ? 0 : (MODE == 1 ? 256 : 512)) + h * 64 + 4 * hh;
#pragma unroll
    for (int g = 0; g < 4; ++g) {
        u32x2 w0, w1;
        w0.x = pk2(o0[4 * g] * inv, o0[4 * g + 1] * inv); w0.y = pk2(o0[4 * g + 2] * inv, o0[4 * g + 3] * inv);
        w1.x = pk2(o1[4 * g] * inv, o1[4 * g + 1] * inv); w1.y = pk2(o1[4 * g + 2] * inv, o1[4 * g + 3] * inv);
        *(u32x2*)(dst + 8 * g) = w0; *(u32x2*)(dst + 32 + 8 * g) = w1;
    }
#undef ATT_LOAD
#undef ATT_STORE
}
}

__device__ __forceinline__ void transpose_item(const float* W, int N, int nblk, bf16_t* WT, int ldt, LAS float* scr, int item, int lane, const float* gk = nullptr) {
    const int kb = item / nblk, nb = item % nblk, k0 = 64 * kb, n0 = 32 * nb;
    const int nn = n0 + (lane & 31); const bool ok = nn < N;
    float tmp[32];
#pragma unroll
    for (int i = 0; i < 32; ++i) { const int kk = 2 * i + (lane >> 5); tmp[i] = ok ? W[(size_t)(k0 + kk) * N + nn] : 0.f; }
#pragma unroll
    for (int i = 0; i < 32; ++i) { const int kk = 2 * i + (lane >> 5); scr[kk * 33 + (lane & 31)] = tmp[i]; }
    LDS_WAIT(); asm volatile("" ::: "memory");
    const int c = lane & 7;
    f32x4 ga = {1.f, 1.f, 1.f, 1.f}, gb = ga;
    if (gk) { ga = *(const f32x4*)(gk + k0 + 8 * c); gb = *(const f32x4*)(gk + k0 + 8 * c + 4); }
#pragma unroll
    for (int j = 0; j < 4; ++j) { const int n = (lane >> 3) + 8 * j; const LAS float* s = scr + (8 * c) * 33 + n;
        u32x4 o; o.x = pk2(s[0 * 33] * ga.x, s[1 * 33] * ga.y); o.y = pk2(s[2 * 33] * ga.z, s[3 * 33] * ga.w); o.z = pk2(s[4 * 33] * gb.x, s[5 * 33] * gb.y); o.w = pk2(s[6 * 33] * gb.z, s[7 * 33] * gb.w);
        *(u32x4*)(WT + (size_t)(n0 + n) * ldt + k0 + 8 * c) = o; }
    LDS_WAIT(); asm volatile("" ::: "memory");
}
__device__ __forceinline__ void prenorm_row(const float* xrow, bf16_t* orow, float* rowss, int lane) {
    const f32x4* xr = (const f32x4*)xrow + lane;
    f32x4 v[4]; float s = 0.f;
#pragma unroll
    for (int j = 0; j < 4; ++j) { v[j] = xr[64 * j]; s += (v[j].x * v[j].x + v[j].y * v[j].y) + (v[j].z * v[j].z + v[j].w * v[j].w); }
    s = wave_sum(s); if (lane < 16) rowss[lane] = (lane == 0) ? s : 0.f;
#pragma unroll
    for (int j = 0; j < 4; ++j) { u32x2 w; w.x = pk2(v[j].x, v[j].y); w.y = pk2(v[j].z, v[j].w); ((u32x2*)orow)[lane + 64 * j] = w; }
}
__device__ __forceinline__ float logsig(float z) { return fminf(z, 0.f) - __logf(1.0f + __expf(-fabsf(z))); }


constexpr int I_G = 16 * 128, I_B = 4 * 32, I_O = 16 * 32, I_U = 16 * 128, I_D = 64 * 32, N_LATE_ITEMS = I_G + 4 * I_B + I_O + I_U + I_D;
__device__ __forceinline__ void late_weight_item(int l, int r, LAS float* scr, int lane) {
    const cargs_t ap = get_args(); unsigned char* const ws = ap->ws;
    if (r < I_G) { transpose_item(ap->w_gate + (size_t)l * 1024 * 4096, 4096, 128, (bf16_t*)(ws + WS_WGT), 1024, scr, r, lane, ap->g_mix + l * 1024); return; } r -= I_G;
    if (r < 4 * I_B) { const int n = r / I_B; transpose_item(ap->w_branch + (size_t)l * 4 * 256 * 1024 + (size_t)n * 256 * 1024, 1024, 32, (bf16_t*)(ws + WS_WBT) + (size_t)n * 1024 * 1024 + n * 256, 1024, scr, r % I_B, lane); return; } r -= 4 * I_B;
    if (r < I_O) { transpose_item(ap->w_o + (size_t)l * 1024 * 1024, 1024, 32, (bf16_t*)(ws + WS_WOT), 1024, scr, r, lane); return; } r -= I_O;
    if (r < I_U) { transpose_item(ap->w_up + (size_t)l * 1024 * 4096, 4096, 128, (bf16_t*)(ws + WS_W1T), 1024, scr, r, lane, ap->g_ffn + l * 1024); return; } r -= I_U;
    transpose_item(ap->w_down + (size_t)l * 4096 * 1024, 1024, 32, (bf16_t*)(ws + WS_W2T), 4096, scr, r, lane);
}
__device__ __forceinline__ void conv_tokens(int l, int t0, int lane) {
    const cargs_t ap = get_args(); unsigned char* const ws = ap->ws;
    const bf16_t* U = (const bf16_t*)(ws + WS_U); bf16_t* BR = (bf16_t*)(ws + WS_BR);
    const float* wdw = ap->w_dw + (size_t)l * 31 * 256; const f32x4 bdw = *(const f32x4*)(ap->b_dw + l * 256 + 4 * lane);
    const f32x4 gln = *(const f32x4*)(ap->g_conv_ln + l * 256 + 4 * lane), bln = *(const f32x4*)(ap->b_conv_ln + l * 256 + 4 * lane);
    const int ts0 = t0 & (SEQ - 1);
    const float* wl = wdw + 4 * lane; asm volatile("" : "+v"(wl));
    u32x2 ur[38];
#pragma unroll
    for (int i = 0; i < 38; ++i) { const int tt = ts0 - 30 + i; ur[i] = (u32x2){0u, 0u}; if (tt >= 0) ur[i] = *(const u32x2*)(U + (size_t)(t0 - 30 + i) * 256 + 4 * lane); }
    f32x4 acc[8];
#pragma unroll
    for (int j = 0; j < 8; ++j) acc[j] = bdw;
#pragma unroll
    for (int k = 0; k < 31; ++k) { const f32x4 w = *(const f32x4*)(wl + k * 256);
#pragma unroll
        for (int j = 0; j < 8; ++j) { const u32x2 u = ur[j + k];
            acc[j].x = fmaf(lo_f(u.x), w.x, acc[j].x); acc[j].y = fmaf(hi_f(u.x), w.y, acc[j].y); acc[j].z = fmaf(lo_f(u.y), w.z, acc[j].z); acc[j].w = fmaf(hi_f(u.y), w.w, acc[j].w); } }
#pragma unroll
    for (int j = 0; j < 8; ++j) {
        const float mean = wave_sum((acc[j].x + acc[j].y) + (acc[j].z + acc[j].w)) * (1.0f / 256.0f);
        const f32x4 d = acc[j] - mean;
        const float rstd = 1.0f / sqrtf(wave_sum((d.x * d.x + d.y * d.y) + (d.z * d.z + d.w * d.w)) * (1.0f / 256.0f) + EPS);
        const f32x4 y = d * rstd * gln + bln;
        u32x2 o; o.x = pk2(y.x * sigmoidf_(y.x), y.y * sigmoidf_(y.y)); o.y = pk2(y.z * sigmoidf_(y.z), y.w * sigmoidf_(y.w));
        *(u32x2*)(BR + (size_t)(t0 + j) * 1024 + 768 + 4 * lane) = o;
    }
}

__device__ __forceinline__ void win_item(int l, int r, LAS float* scr, int lane) {
    const cargs_t ap = get_args();
    transpose_item(ap->w_in + (size_t)l * 1024 * INC, INC, 80, (bf16_t*)(ap->ws + (l == 0 ? WS_WINT : WS_WINT1)), 1024, scr, r, lane, ap->g_mix + l * 1024);
}
__device__ __forceinline__ void wlat_chunk(int l, int c) {
    const cargs_t ap = get_args();
    const float* w_uq = ap->w_uq + (size_t)l * 256 * 384; const float* w_ukv = ap->w_ukv + (size_t)l * 128 * 512; const float* gq = ap->g_q_lat + l * 256; const float* gkv = ap->g_kv_lat + l * 128;
    const int n = c / 48, k0 = (c % 48) * 8; float v[8];
#pragma unroll
    for (int e = 0; e < 8; ++e) { const int k = k0 + e; v[e] = (n < 384 && k < 256) ? gq[k] * w_uq[(size_t)k * 384 + n] : ((n >= 512 && k >= 256) ? gkv[k - 256] * w_ukv[(size_t)(k - 256) * 512 + (n - 512)] : 0.f); }
    u32x4 o; o.x = pk2(v[0], v[1]); o.y = pk2(v[2], v[3]); o.z = pk2(v[4], v[5]); o.w = pk2(v[6], v[7]);
    *(u32x4*)((bf16_t*)(ap->ws + (l == 0 ? WS_WLT : WS_WLT1)) + (size_t)n * 384 + k0) = o;
}

#define XB_TMO      128
#define XB_XCNT(j)  (256  + 64 * (j))
#define XB_XSUB(j)  (1280 + 64 * (j))
#define XB_XGEN(j)  (2304 + 64 * (j))
#define XB_TOP      3328
#define XB_TOPGEN   3392
#define XCD_BAR_WORDS 3456
#define XB_SPIN_CAP (1u << 18)
__device__ __forceinline__ unsigned xb_ld(unsigned* p)              { return __hip_atomic_load(p, __ATOMIC_RELAXED, __HIP_MEMORY_SCOPE_AGENT); }
__device__ __forceinline__ unsigned xb_add(unsigned* p, unsigned v) { return __hip_atomic_fetch_add(p, v, __ATOMIC_RELAXED, __HIP_MEMORY_SCOPE_AGENT); }
__device__ __forceinline__ unsigned xb_xcc_id() { return (unsigned)__builtin_amdgcn_s_getreg((3 << 11) | 20) & 0xFu; }
#define XB_SPIN(cond, bar) do { unsigned _sp = 0; while (cond) { __builtin_amdgcn_s_sleep(1); \
    if ((++_sp & 255u) == 0u) { if (xb_ld(&(bar)[XB_TMO])) break; if (_sp > XB_SPIN_CAP) { atomicAdd(&(bar)[XB_TMO], 1u); break; } } } } while (0)
struct XcdBarrier { unsigned* bar; unsigned x; volatile LAS unsigned* st; };
__device__ __forceinline__ void xcd_barrier_complete(unsigned* bar, unsigned x, unsigned& nloc, unsigned& nx) {
    const unsigned G = gridDim.x * gridDim.y * gridDim.z;
    unsigned sum, cnt, mine, sp = 0u;
    for (;;) {
        sum = 0u; cnt = 0u; mine = 0u;
#pragma unroll
        for (unsigned j = 0; j < 16; ++j) { const unsigned c = xb_ld(&bar[XB_XCNT(j)]); sum += c; cnt += (c > 0u) ? 1u : 0u; mine = (j == x) ? c : mine; }
        if (sum == G) break;
        __builtin_amdgcn_s_sleep(1);
        if ((++sp & 255u) == 0u) { if (xb_ld(&bar[XB_TMO])) break; if (sp > XB_SPIN_CAP) { atomicAdd(&bar[XB_TMO], 1u); break; } }
    }
    nloc = mine > 0u ? mine : 1u; nx = cnt > 0u ? cnt : 1u;
}
__device__ __forceinline__ void xcd_barrier(const XcdBarrier& b) {
    asm volatile("s_waitcnt vmcnt(0)" ::: "memory");
    __syncthreads();
    if (threadIdx.x == 0) {
        unsigned* bar = b.bar;
        __builtin_amdgcn_s_waitcnt(0);
        unsigned nloc = b.st[0], nx = b.st[1];
        if (nloc == 0u) { xcd_barrier_complete(bar, b.x, nloc, nx); b.st[0] = nloc; b.st[1] = nx; }
        const unsigned old = xb_add(&bar[XB_XSUB(b.x)], 1u);
        const unsigned gen = old / nloc;
        if (old + 1u == (gen + 1u) * nloc) {
            __builtin_amdgcn_fence(__ATOMIC_RELEASE, "agent");
            asm volatile("s_waitcnt vmcnt(0)" ::: "memory");
            const unsigned og = xb_add(&bar[XB_TOP], 1u);
            const unsigned tg = og / nx;
            if (og + 1u == (tg + 1u) * nx) xb_add(&bar[XB_TOPGEN], 1u);
            else XB_SPIN(xb_ld(&bar[XB_TOPGEN]) == tg, bar);
            __builtin_amdgcn_fence(__ATOMIC_ACQUIRE, "agent");
            xb_add(&bar[XB_XGEN(b.x)], 1u);
            asm volatile("s_waitcnt vmcnt(0)" ::: "memory");
        } else {
            XB_SPIN(xb_ld(&bar[XB_XGEN(b.x)]) == gen, bar);
            __builtin_amdgcn_fence(__ATOMIC_ACQUIRE, "agent");
            asm volatile("s_waitcnt vmcnt(0)" ::: "memory");
        }
    }
    __syncthreads();
}
constexpr int CTL_BAR_WORD = 4096;
constexpr int LDS_MISC = 131072 + 128;
#define GRID_BAR() do { const cargs_t ap_ = get_args(); XcdBarrier b_; b_.bar = (unsigned*)(ap_->ws + WS_CTL) + CTL_BAR_WORD; b_.x = xb_xcc_id(); \
    b_.st = (volatile LAS unsigned*)(lds + LDS_MISC); xcd_barrier(b_); } while (0)

#define WSP(T, off) ((T*)(ws + (off)))
#define REP_P1 1
#define REP_P2 1
#define REP_P3 1
#define REP_P4 1
#define REP_P5 1
#define REP_P6 1
#define REP_P7 1
#define REP_P8 1
#define REP_P9 1
#define REP_P10 1
#define REP_SYNC 0
#define PHASE_BEGIN(R) _Pragma("unroll 1") for (int rep = 0; rep < (R); ++rep) {
#define PHASE_END GRID_BAR(); }
__global__ void __launch_bounds__(512, 2) fwd_megakernel(Args A_unused) {
    extern __shared__ __attribute__((aligned(16))) unsigned char lds_raw[];
    LAS unsigned char* lds = (LAS unsigned char*)lds_raw;
    {
        if (threadIdx.x < 8) ((LAS unsigned*)(lds + LDS_MISC))[threadIdx.x] = 0u;
        __syncthreads();
        const cargs_t ap = get_args();
        if (threadIdx.x == 0) (void)xb_add((unsigned*)(ap->ws + WS_CTL) + CTL_BAR_WORD + XB_XCNT(xb_xcc_id()), 1u);
    }
    cg::this_grid().sync();

#pragma unroll 1
    for (int l = 0; l < 2; ++l) {
        if (l == 0) {
        PHASE_BEGIN(REP_P1)
            const cargs_t ap = get_args(); unsigned char* const ws = ap->ws;
            const int tid = fresh_tid(), lane = tid & 63, wid = __builtin_amdgcn_readfirstlane(tid >> 6), G = gridDim.x, bx = blockIdx.x, gw = bx * 8 + wid, NGW = G * 8;
            LAS float* scr = (LAS float*)(lds + wid * 16384);
            for (int it = gw; it < 1280; it += NGW) win_item(0, it, scr, lane);
            for (int c = bx * 512 + tid; c < 1024 * 48; c += G * 512) wlat_chunk(0, c);
            const float* xin = ap->x; bf16_t* XN = WSP(bf16_t, WS_XN); float* rss = WSP(float, WS_ROWSS);
            for (int m = gw; m < TOK; m += NGW) prenorm_row(xin + (size_t)m * 1024, XN + (size_t)m * 1024, rss + (size_t)m * 16, lane);
        GRID_BAR(); }
        }
        PHASE_BEGIN(REP_P2)
            const cargs_t ap = get_args(); unsigned char* const ws = ap->ws;
            const char* hin = (l == 0) ? WSP(const char, WS_XN) : (const char*)ap->out;
            pg8::PlainOrder S{hin, (l == 0) ? WSP(const char, WS_WINT) : WSP(const char, WS_WINT1), 1024, 1024, 64, 10, 16, (int)gridDim.x, (int)blockIdx.x};
            const float* slots = WSP(const float, WS_ROWSS) + (size_t)(l * 2) * ROWSS_STRIDE;
            pg8::Unit u0; int pm0 = -1; if (S.next(0, u0)) { pm0 = u0.pm; fill_rinv_table(lds, slots, pm0); }
            pg8::EpiBf16<0, 1, true> E{WSP(bf16_t, WS_PROJ), PLD, slots, pm0, (unsigned)(uintptr_t)(lds + LDS_RINV), WSP(float, WS_LATSS)};
            pg8::gemm_phase(lds, 1024, 1024, S, E);
        PHASE_END
        PHASE_BEGIN(REP_P3)
            const cargs_t ap = get_args(); unsigned char* const ws = ap->ws;
            const int tid = fresh_tid(), lane = tid & 63, wid = __builtin_amdgcn_readfirstlane(tid >> 6), G = gridDim.x, bx = blockIdx.x, gw = bx * 8 + wid, NGW = G * 8;
            const bf16_t* PROJ = WSP(const bf16_t, WS_PROJ);
            if (bx < 16) {
                const int b = bx >> 2, h = bx & 3; const float bf = ap->b_forget[l * 4 + h];
                const bf16_t* src = PROJ + ((size_t)b * SEQ + tid * 8) * PLD + C_CF + h;
                float v[8];
#pragma unroll
                for (int i = 0; i < 8; ++i) v[i] = bf2f(src[(size_t)i * PLD]);
#pragma unroll
                for (int i = 0; i < 8; ++i) { v[i] = logsig(v[i] + bf); if (i) v[i] += v[i - 1]; }
                float incl = v[7];
#pragma unroll
                for (int o = 1; o < 64; o <<= 1) { const float u = __shfl_up(incl, o); if (lane >= o) incl += u; }
                LAS float* wtot = (LAS float*)(lds + 131072 + 64);
                if (lane == 63) wtot[wid] = incl;
                __syncthreads();
                float off = incl - v[7];
                for (int w = 0; w < wid; ++w) off += wtot[w];
                float* dst = WSP(float, WS_FCUM) + (size_t)(b * 4 + h) * SEQ + tid * 8;
                f32x4 o0 = {v[0] + off, v[1] + off, v[2] + off, v[3] + off}, o1 = {v[4] + off, v[5] + off, v[6] + off, v[7] + off};
                *(f32x4*)dst = o0; *(f32x4*)(dst + 4) = o1;
            }
            const int* posp = ap->pos;
            bf16_t* KROT = WSP(bf16_t, WS_KROT); bf16_t* U = WSP(bf16_t, WS_U);
            const float invf = exp2f(-(float)(lane & 15) * 0.8304820237218406f);
            for (int t0 = gw * 4; t0 < TOK; t0 += NGW * 4) {
                u32x2 dv4[4], dg4[4]; float x14[4], x24[4], pos4[4];
#pragma unroll
                for (int j = 0; j < 4; ++j) { const bf16_t* row = PROJ + (size_t)(t0 + j) * PLD;
                    dv4[j] = *(const u32x2*)(row + C_DV + 4 * lane); dg4[j] = *(const u32x2*)(row + C_DG + 4 * lane);
                    x14[j] = bf2f(row[C_BKR + (lane & 15)]); x24[j] = bf2f(row[C_BKR + 16 + (lane & 15)]); pos4[j] = (float)posp[t0 + j]; }
#pragma unroll
                for (int j = 0; j < 4; ++j) { const int t = t0 + j;
                    if (lane < 16) {
                        const float ang = pos4[j] * invf, kk = rintf(ang * 0.15915494309189535f);
                        float rem = fmaf(-kk, 6.2831854820251465f, ang); rem = fmaf(kk, 1.7484555e-7f, rem);
                        const float sn = __sinf(rem), cn = __cosf(rem);
                        const unsigned w = pk2(x14[j] * cn - x24[j] * sn, x24[j] * cn + x14[j] * sn);
                        KROT[(size_t)t * 32 + lane] = (bf16_t)(w & 0xffffu); KROT[(size_t)t * 32 + 16 + lane] = (bf16_t)(w >> 16);
                    }
                    {
                        const u32x2 v = dv4[j], gt = dg4[j];
                        u32x2 o; o.x = pk2(lo_f(v.x) * sigmoidf_(lo_f(gt.x)), hi_f(v.x) * sigmoidf_(hi_f(gt.x))); o.y = pk2(lo_f(v.y) * sigmoidf_(lo_f(gt.y)), hi_f(v.y) * sigmoidf_(hi_f(gt.y)));
                        *(u32x2*)(U + (size_t)t * 256 + 4 * lane) = o;
                    }
                }
            }
            { const cargs_t ap2 = get_args(); unsigned char* const ws = ap2->ws;
              pg8::PlainOrder S{WSP(const char, WS_PROJ) + C_BQL * 2, (l == 0) ? WSP(const char, WS_WLT) : WSP(const char, WS_WLT1), PLD, 384, 64, 4, 6, (int)gridDim.x, (int)blockIdx.x};
              pg8::EpiBf16<0, 2> E{WSP(bf16_t, WS_QKVB), 1024, nullptr, -1, 0u, WSP(float, WS_LATSS)};
              pg8::gemm_phase(lds, PLD, 384, S, E); }
        PHASE_END
        PHASE_BEGIN(REP_P5)
            LAS int* wq = (LAS int*)(lds + 131072);
            for (;;) {
                __syncthreads();
                if (threadIdx.x == 0) { const cargs_t ap = get_args(); wq[0] = atomicAdd((int*)(ap->ws + WS_CTL) + 16 * (l * 8 + rep), 1); }
                __syncthreads();
                const int it = wq[0];
                if (it >= 768 + 256 + N_LATE_ITEMS / 16 + (l == 0 ? 80 + 96 : 0)) break;
                if (it >= 768) {
                    const int tidq = fresh_tid(), laneq = tidq & 63, widq = __builtin_amdgcn_readfirstlane(tidq >> 6);
                    if (it < 1024) conv_tokens(l, ((it - 768) * 8 + widq) * 8, laneq);
                    else if (it >= 1024 + N_LATE_ITEMS / 16) {
                        const int e = it - (1024 + N_LATE_ITEMS / 16);
                        if (e < 80) { LAS float* scr = (LAS float*)(lds + widq * 16384); win_item(l + 1, e * 16 + widq * 2, scr, laneq); win_item(l + 1, e * 16 + widq * 2 + 1, scr, laneq); }
                        else wlat_chunk(l + 1, (e - 80) * 512 + tidq);
                    }
                    else { LAS float* scr = (LAS float*)(lds + widq * 16384); const int r0 = (it - 1024) * 16 + widq * 2; late_weight_item(l, r0, scr, laneq); late_weight_item(l, r0 + 1, scr, laneq); }
                    continue;
                }
                int mode, bh, qb;
                if (it >= 384 && it < 640) { const int a = it - 384; mode = 0; bh = a & 15; qb = a >> 4; }
                else { const int k = it < 384 ? it : it - 256; const int lvl = k >> 5, w = k & 31; qb = 15 - lvl; mode = (w < 16) ? 1 : 2; bh = w & 15; }
                if (mode == 0) att::unit<0>(l, bh >> 2, bh & 3, qb, lds);
                else if (mode == 1) att::unit<1>(l, bh >> 2, bh & 3, qb, lds);
                else att::unit<2>(l, bh >> 2, bh & 3, qb, lds);
            }
        PHASE_END
        PHASE_BEGIN(REP_P6)
            const cargs_t ap = get_args(); unsigned char* const ws = ap->ws;
            const char* hin = (l == 0) ? WSP(const char, WS_XN) : (const char*)ap->out;
            pg8::GateBranchOrder S{hin, WSP(const char, WS_BR), WSP(const char, WS_WGT), WSP(const char, WS_WBT), (int)gridDim.x, (int)blockIdx.x};
            pg8::EpiGateBranch E{WSP(bf16_t, WS_MIXED), ap->b_gate + (size_t)l * 4096, WSP(const float, WS_ROWSS) + (size_t)(l * 2) * ROWSS_STRIDE, (LAS unsigned*)(lds + 131072 + 1024)};
            pg8::gemm_phase(lds, 1024, 1024, S, E);
        PHASE_END
        PHASE_BEGIN(REP_P7)
            const cargs_t ap = get_args(); unsigned char* const ws = ap->ws;
            pg8::PlainOrder S{WSP(const char, WS_MIXED), WSP(const char, WS_WOT), 1024, 1024, 64, 4, 16, (int)gridDim.x, (int)blockIdx.x};
            if (l == 0) { pg8::EpiRes<true> E{ap->x, WSP(bf16_t, WS_XA), WSP(float, WS_ROWSS) + (size_t)1 * ROWSS_STRIDE};
                pg8::gemm_phase(lds, 1024, 1024, S, E); }
            else { pg8::EpiRes<false> E{ap->out, WSP(bf16_t, WS_XA), WSP(float, WS_ROWSS) + (size_t)3 * ROWSS_STRIDE};
                pg8::gemm_phase(lds, 1024, 1024, S, E); }
        PHASE_END
        PHASE_BEGIN(REP_P9)
            const cargs_t ap = get_args(); unsigned char* const ws = ap->ws;
            pg8::PlainOrder S{WSP(const char, WS_XA), WSP(const char, WS_W1T), 1024, 1024, 64, 16, 16, (int)gridDim.x, (int)blockIdx.x};
            const float* slots = WSP(const float, WS_ROWSS) + (size_t)(l * 2 + 1) * ROWSS_STRIDE;
            pg8::Unit u0; int pm0 = -1; if (S.next(0, u0)) { pm0 = u0.pm; fill_rinv_table(lds, slots, pm0); }
            pg8::EpiBf16<2, 1> E{WSP(bf16_t, WS_H), 4096, slots, pm0, (unsigned)(uintptr_t)(lds + LDS_RINV), nullptr};
            pg8::gemm_phase(lds, 1024, 1024, S, E);
        PHASE_END
        PHASE_BEGIN(REP_P10)
            const cargs_t ap = get_args(); unsigned char* const ws = ap->ws;
            pg8::PlainOrder S{WSP(const char, WS_H), WSP(const char, WS_W2T), 4096, 4096, 64, 4, 64, (int)gridDim.x, (int)blockIdx.x};
            if (l == 0) { pg8::EpiRes<false> E{WSP(const bf16_t, WS_XA), (bf16_t*)ap->out, WSP(float, WS_ROWSS) + (size_t)2 * ROWSS_STRIDE};
                pg8::gemm_phase(lds, 4096, 4096, S, E); }
            else { pg8::EpiRes<false> E{WSP(const bf16_t, WS_XA), WSP(bf16_t, WS_XN), WSP(float, WS_ROWSS) + (size_t)4 * ROWSS_STRIDE};
                pg8::gemm_phase(lds, 4096, 4096, S, E); }
        PHASE_END
    }
    _Pragma("unroll 1") for (int i = 0; i < REP_SYNC; ++i) GRID_BAR();
    {
        const cargs_t ap = get_args(); unsigned char* const ws = ap->ws;
        const int tid = fresh_tid(), lane = tid & 63, wid = __builtin_amdgcn_readfirstlane(tid >> 6), gw = blockIdx.x * 8 + wid, NGW = gridDim.x * 8;
        float* out = ap->out; const bf16_t* YF = WSP(const bf16_t, WS_XN); const f32x4* gf = (const f32x4*)ap->g_final + lane; const float* rss = WSP(const float, WS_ROWSS) + (size_t)4 * ROWSS_STRIDE;
        for (int m = gw; m < TOK; m += NGW) {
            const float rinv = __builtin_amdgcn_rsqf(wave_sum(lane < 16 ? rss[(size_t)m * 16 + lane] : 0.f) * (1.0f / 1024.0f) + EPS);
            const u32x2* yr = (const u32x2*)(YF + (size_t)m * 1024) + lane; f32x4* orow = (f32x4*)(out + (size_t)m * 1024) + lane;
            u32x2 w[4];
#pragma unroll
            for (int j = 0; j < 4; ++j) w[j] = yr[64 * j];
#pragma unroll
            for (int j = 0; j < 4; ++j) { const f32x4 g4 = gf[64 * j]; orow[64 * j] = (f32x4){lo_f(w[j].x) * rinv * g4.x, hi_f(w[j].x) * rinv * g4.y, lo_f(w[j].y) * rinv * g4.z, hi_f(w[j].y) * rinv * g4.w}; }
        }
    }
}

extern "C" void kernel_launch(void* const* d_in, const int* in_sizes, int n_in, void* d_out, int out_size, void* d_ws, size_t ws_size, hipStream_t stream) {
    static int grid = 0;
    if (grid == 0) {
        if (n_in != 22 || out_size != TOK * DM || ws_size < WS_END) { fprintf(stderr, "kernel_launch: unexpected shapes (n_in %d out %d ws %zu)\n", n_in, out_size, ws_size); grid = -1; return; }
        int dev = 0, cus = 0, per_cu = 0;
        if (hipGetDevice(&dev) != hipSuccess || hipDeviceGetAttribute(&cus, hipDeviceAttributeMultiprocessorCount, dev) != hipSuccess) { grid = -1; return; }
        if (hipFuncSetAttribute((const void*)fwd_megakernel, hipFuncAttributeMaxDynamicSharedMemorySize, LDS_BYTES) != hipSuccess) { fprintf(stderr, "hipFuncSetAttribute failed\n"); grid = -1; return; }
        if (hipOccupancyMaxActiveBlocksPerMultiprocessor(&per_cu, (const void*)fwd_megakernel, 512, LDS_BYTES) != hipSuccess || per_cu < 1) { fprintf(stderr, "occupancy query: %d blocks per CU\n", per_cu); grid = -1; return; }
        grid = cus;
    }
    if (grid < 0) return;
    (void)hipMemsetAsync((char*)d_ws + WS_CTL, 0, 65536, stream);
    Args a{};
    a.x = (const float*)d_in[0]; a.pos = (const int*)d_in[1]; a.g_mix = (const float*)d_in[2]; a.w_in = (const float*)d_in[3]; a.w_gate = (const float*)d_in[4]; a.b_gate = (const float*)d_in[5];
    a.rel_bias = (const float*)d_in[6]; a.g_q_lat = (const float*)d_in[7]; a.w_uq = (const float*)d_in[8]; a.g_kv_lat = (const float*)d_in[9]; a.w_ukv = (const float*)d_in[10];
    a.b_forget = (const float*)d_in[11]; a.w_dw = (const float*)d_in[12]; a.b_dw = (const float*)d_in[13]; a.g_conv_ln = (const float*)d_in[14]; a.b_conv_ln = (const float*)d_in[15];
    a.w_branch = (const float*)d_in[16]; a.w_o = (const float*)d_in[17]; a.g_ffn = (const float*)d_in[18]; a.w_up = (const float*)d_in[19]; a.w_down = (const float*)d_in[20]; a.g_final = (const float*)d_in[21];
    a.out = (float*)d_out; a.ws = (unsigned char*)d_ws;
    void* args[] = {&a};
    hipError_t e = hipLaunchCooperativeKernel((const void*)fwd_megakernel, dim3(grid), dim3(512), args, LDS_BYTES, stream);
    if (e != hipSuccess) fprintf(stderr, "cooperative launch failed: %s (grid %d)\n", hipGetErrorString(e), grid);
}
```

```cpp
#include <hip/hip_runtime.h>
#include <hip/hip_cooperative_groups.h>
#include <cstdio>
#include <cstdint>
namespace cg = cooperative_groups;

#define LAS __attribute__((address_space(3)))
typedef unsigned short bf16_t;
typedef short bf16x8 __attribute__((ext_vector_type(8)));
typedef short s16x4 __attribute__((ext_vector_type(4)));
typedef float f32x4 __attribute__((ext_vector_type(4)));
typedef float f32x16 __attribute__((ext_vector_type(16)));
typedef unsigned u32x4 __attribute__((ext_vector_type(4)));
typedef unsigned u32x2 __attribute__((ext_vector_type(2)));
typedef float f32x2_t __attribute__((ext_vector_type(2)));
typedef __bf16 bf16x2_t __attribute__((ext_vector_type(2)));

constexpr int NB = 4, SEQ = 4096, DM = 1024, TOK = NB * SEQ, DFF = 4096, INC = 2468, PLD = 2560;
constexpr int C_AQ = 0, C_AK = 256, C_AV = 512, C_BQL = 768, C_BKVL = 1024, C_BKR = 1152, C_CQ = 1184, C_CK = 1440, C_CV = 1696, C_CF = 1952, C_DV = 1956, C_DG = 2212;
constexpr float LOG2E = 1.4426950408889634f;
constexpr float EPS = 1e-6f;
constexpr size_t MiB = 1u << 20;
constexpr size_t WS_W1T = 4 * MiB, WS_W2T = 12 * MiB, WS_XN = 20 * MiB, WS_PROJ = 52 * MiB, WS_XA = 52 * MiB, WS_H = 116 * MiB;
constexpr size_t WS_QKVB = 132 * MiB, WS_MIXED = 132 * MiB, WS_BR = 164 * MiB, WS_LAT = 196 * MiB, WS_U = 208 * MiB;
constexpr size_t WS_WINT = 216 * MiB, WS_WGT = 221 * MiB, WS_WLT = 229 * MiB, WS_WBT = 230 * MiB, WS_WOT = 238 * MiB;
constexpr size_t WS_CTL = 244 * MiB, WS_FCUM = 244 * MiB + 256 * 1024, WS_KROT = 245 * MiB, WS_END = 256 * MiB;
constexpr size_t WS_WINT1 = 251 * MiB, WS_WLT1 = 0, WS_LATSS = 1 * MiB;
constexpr size_t WS_ROWSS = 246 * MiB, ROWSS_STRIDE = (size_t)TOK * 16;
constexpr int LDS_RINV = 131072 + 1024 + 16384;
constexpr int LDS_BYTES = LDS_RINV + 1024;

struct Args {
    const float* x; const int* pos; const float* g_mix; const float* w_in; const float* w_gate; const float* b_gate; const float* rel_bias;
    const float* g_q_lat; const float* w_uq; const float* g_kv_lat; const float* w_ukv; const float* b_forget; const float* w_dw; const float* b_dw;
    const float* g_conv_ln; const float* b_conv_ln; const float* w_branch; const float* w_o; const float* g_ffn; const float* w_up; const float* w_down; const float* g_final;
    float* out; unsigned char* ws;
};

typedef const __attribute__((address_space(4))) Args* cargs_t;
__device__ __forceinline__ cargs_t get_args() { cargs_t p = (cargs_t)__builtin_amdgcn_kernarg_segment_ptr(); asm volatile("" : "+s"(p)); return p; }
__device__ __forceinline__ int fresh_tid() { int t = threadIdx.x; asm volatile("" : "+v"(t)); return t; }
__device__ __forceinline__ float bf2f(unsigned short b) { return __uint_as_float((unsigned)b << 16); }
__device__ __forceinline__ unsigned pk2(float lo, float hi) { f32x2_t v = {lo, hi}; bf16x2_t b = __builtin_convertvector(v, bf16x2_t); return __builtin_bit_cast(unsigned, b); }
__device__ __forceinline__ float lo_f(unsigned w) { return __uint_as_float(w << 16); }
__device__ __forceinline__ float hi_f(unsigned w) { return __uint_as_float(w & 0xffff0000u); }
__device__ __forceinline__ float wave_sum(float v) {
#pragma unroll
    for (int o = 1; o < 64; o <<= 1) v += __shfl_xor(v, o);
    return v;
}
__device__ __forceinline__ float sigmoidf_(float x) { return 1.0f / (1.0f + __expf(-x)); }
#define LDS_WAIT() asm volatile("s_waitcnt lgkmcnt(0)" ::: "memory")
__device__ __forceinline__ float row_rinv(const float* slots, int row, int fq) {
    const f32x4 a = *(const f32x4*)(slots + (size_t)row * 16 + 4 * fq);
    float s = (a.x + a.y) + (a.z + a.w);
    s += __shfl_xor(s, 16); s += __shfl_xor(s, 32);
    return __builtin_amdgcn_rsqf(s * (1.0f / 1024.0f) + EPS);
}
__device__ __forceinline__ void fill_rinv_table(LAS unsigned char* lds, const float* slots, int pm) {
    const int t = fresh_tid();
    if (t < 256) { const f32x4* p = (const f32x4*)(slots + (size_t)(pm * 256 + t) * 16); const f32x4 a = p[0], b = p[1], c = p[2], d = p[3];
        const float s = (((a.x + a.y) + (a.z + a.w)) + ((b.x + b.y) + (b.z + b.w))) + (((c.x + c.y) + (c.z + c.w)) + ((d.x + d.y) + (d.z + d.w)));
        ((LAS float*)(lds + LDS_RINV))[t] = __builtin_amdgcn_rsqf(s * (1.0f / 1024.0f) + EPS); }
    __syncthreads();
}
__device__ __forceinline__ float lds_rinv_read(unsigned addr) { float r; asm volatile("ds_read_b32 %0, %1" : "=v"(r) : "v"(addr)); return r; }
namespace pg8 {
constexpr int BM = 256, BK = 64, HALF = 128, HTB = HALF * BK * 2, STAGE_BYTES = 8 * HTB, NXCD = 8, WGM = 8;
__host__ __device__ __forceinline__ int lds_byte(int r, int c) { const int st = (r >> 4) * 2 + (c >> 5), rr = r & 15, cc = c & 31, ob = rr * 64 + cc * 2; return st * 1024 + (ob ^ (((ob >> 9) & 1) << 5)); }
__host__ __device__ __forceinline__ void stage_rc(int b, int& R, int& C) { const int st = b / 1024, sb = b % 1024, swz = sb ^ (((sb >> 9) & 1) << 5); R = (st >> 1) * 16 + swz / 64; C = (st & 1) * 32 + (swz % 64) / 2; }
__host__ __device__ __forceinline__ int perm32(int rho) { const int n = rho >> 4, i = rho & 15; return 8 * (i >> 2) + 4 * n + (i & 3); }

struct Unit { int pm, pn, nt, kind; const char* a; const char* b; };

__device__ __forceinline__ bool tile_of(int L, int nM, int nN, int& pm, int& pn) {
    const int nwg = nM * nN; if (L >= nwg) return false;
    int wgid = L; { const int q = nwg / NXCD, r = nwg % NXCD, xcd = wgid % NXCD, off = wgid / NXCD; wgid = (xcd < r ? xcd * (q + 1) : r * (q + 1) + (xcd - r) * q) + off; }
    const int nig = WGM * nN, gid = wgid / nig, fm = gid * WGM, gsz = (nM - fm) < WGM ? (nM - fm) : WGM;
    pm = fm + ((wgid % nig) % gsz); pn = (wgid % nig) / gsz; return true;
}
struct PlainOrder {
    const char* A; const char* Bt; int lda, ldb, nM, nN, nt, G, c;
    __device__ __forceinline__ bool next(int i, Unit& u) const {
        int pm, pn; if (!tile_of(i * G + c, nM, nN, pm, pn)) return false;
        u.pm = pm; u.pn = pn; u.nt = nt; u.kind = 0; u.a = A + (size_t)pm * 256 * lda * 2; u.b = Bt + (size_t)pn * 256 * ldb * 2; return true;
    }
};
struct GateBranchOrder {
    const char* XN; const char* BR; const char* WgT; const char* WbT; int G, c;
    __device__ __forceinline__ bool next(int i, Unit& u) const {
        const int gi = i >> 3, j = i & 7; int pm, pd; if (!tile_of(gi * G + c, 64, 4, pm, pd)) return false;
        const int n = j >> 1, kind = j & 1; u.pm = pm; u.pn = n * 4 + pd; u.kind = kind;
        if (kind == 0) { u.nt = 16; u.a = XN + (size_t)pm * 256 * 1024 * 2; u.b = WgT + (size_t)u.pn * 256 * 1024 * 2; }
        else { u.nt = 4; u.a = BR + ((size_t)pm * 256 * 1024 + n * 256) * 2; u.b = WbT + ((size_t)u.pn * 256 * 1024 + n * 256) * 2; }
        return true;
    }
};

template <int ACT  , int RS  , bool LATSS = false  > struct EpiBf16 {
    static constexpr bool PERM = true; struct State {};
    bf16_t* O; int ldc; const float* rowss; int pm_tab; unsigned tab; float* latss;
    __device__ __forceinline__ void operator()(const f32x4 (&acc)[2][2][4][2], State&, const Unit& u, int wr, int wc, int fr, int fq) const {
        asm volatile("" : "+v"(fr), "+v"(fq));
        const int row0 = u.pm * BM + wr * 64 + fr, col0 = u.pn * BM + wc * 32 + 8 * fq;
        float rv[2][4];
        if (RS == 1) {
            if (u.pm == pm_tab) {
#pragma unroll
                for (int ai = 0; ai < 2; ++ai)
#pragma unroll
                    for (int m = 0; m < 4; ++m) rv[ai][m] = lds_rinv_read(tab + (unsigned)(wr * 64 + fr + ai * HALF + m * 16) * 4u);
                asm volatile("s_waitcnt lgkmcnt(0)" : "+v"(rv[0][0]), "+v"(rv[0][1]), "+v"(rv[0][2]), "+v"(rv[0][3]), "+v"(rv[1][0]), "+v"(rv[1][1]), "+v"(rv[1][2]), "+v"(rv[1][3]));
            } else {
#pragma unroll
                for (int ai = 0; ai < 2; ++ai)
#pragma unroll
                    for (int m = 0; m < 4; ++m) rv[ai][m] = row_rinv(rowss, row0 + ai * HALF + m * 16, fq);
            }
        }
#pragma unroll
        for (int ai = 0; ai < 2; ++ai)
#pragma unroll
            for (int m = 0; m < 4; ++m) { bf16_t* rowp = O + (size_t)(row0 + ai * HALF + m * 16) * ldc + col0;
                float rinv = 1.f; if (RS == 1) rinv = rv[ai][m];
                if (RS == 2) { const f32x4 a = *(const f32x4*)(latss + (size_t)(row0 + ai * HALF + m * 16) * 8 + (u.pn >= 2 ? 4 : 0));
                    rinv = __builtin_amdgcn_rsqf(((a.x + a.y) + (a.z + a.w)) * (u.pn >= 2 ? (1.0f / 128.0f) : (1.0f / 256.0f)) + EPS); }
                float lss = 0.f;
#pragma unroll
                for (int bj = 0; bj < 2; ++bj) { f32x4 v0 = acc[ai][bj][m][0], v1 = acc[ai][bj][m][1];
                    if (RS) { v0 = v0 * rinv; v1 = v1 * rinv; }
                    if (LATSS) { if (bj == 0 || u.pn == 3) lss += ((v0.x * v0.x + v0.y * v0.y) + (v0.z * v0.z + v0.w * v0.w)) + ((v1.x * v1.x + v1.y * v1.y) + (v1.z * v1.z + v1.w * v1.w)); }
                    if (ACT == 2) {
#pragma unroll
                        for (int e = 0; e < 4; ++e) { const float a0 = fmaxf(v0[e], 0.f), a1 = fmaxf(v1[e], 0.f); v0[e] = a0 * a0; v1[e] = a1 * a1; } }
                    u32x4 w; w.x = pk2(v0[0], v0[1]); w.y = pk2(v0[2], v0[3]); w.z = pk2(v1[0], v1[1]); w.w = pk2(v1[2], v1[3]);
                    *(u32x4*)(rowp + bj * HALF) = w; }
                if (LATSS) { if (u.pn == 3 || u.pn == 4) { lss += __shfl_xor(lss, 16); lss += __shfl_xor(lss, 32);
                    if (fq == 0) latss[(size_t)(row0 + ai * HALF + m * 16) * 8 + (u.pn == 4 ? 4 : 0) + wc] = lss; } } }
    }
};
template <bool BASEF32> struct EpiRes {
    static constexpr bool PERM = true; struct State {};
    const void* base; bf16_t* out; float* rowss;
    __device__ __forceinline__ void operator()(const f32x4 (&acc)[2][2][4][2], State&, const Unit& u, int wr, int wc, int fr, int fq) const {
        asm volatile("" : "+v"(fr), "+v"(fq));
        const int row0 = u.pm * BM + wr * 64 + fr, col0 = u.pn * BM + wc * 32 + 8 * fq;
#pragma unroll
        for (int ai = 0; ai < 2; ++ai) {
            f32x4 bs[4][2][2];
#pragma unroll
            for (int m = 0; m < 4; ++m) { const size_t off = (size_t)(row0 + ai * HALF + m * 16) * 1024 + col0;
#pragma unroll
                for (int bj = 0; bj < 2; ++bj) {
                    if (BASEF32) { bs[m][bj][0] = *(const f32x4*)((const float*)base + off + bj * HALF); bs[m][bj][1] = *(const f32x4*)((const float*)base + off + bj * HALF + 4); }
                    else { const u32x4 w = *(const u32x4*)((const bf16_t*)base + off + bj * HALF);
                        bs[m][bj][0] = (f32x4){lo_f(w.x), hi_f(w.x), lo_f(w.y), hi_f(w.y)}; bs[m][bj][1] = (f32x4){lo_f(w.z), hi_f(w.z), lo_f(w.w), hi_f(w.w)}; } } }
            asm volatile("" ::: "memory");
#pragma unroll
            for (int m = 0; m < 4; ++m) { const int row = row0 + ai * HALF + m * 16; const size_t off = (size_t)row * 1024 + col0; float ss = 0.f;
#pragma unroll
                for (int bj = 0; bj < 2; ++bj) { const f32x4 v0 = bs[m][bj][0] + acc[ai][bj][m][0], v1 = bs[m][bj][1] + acc[ai][bj][m][1];
                    u32x4 w; w.x = pk2(v0[0], v0[1]); w.y = pk2(v0[2], v0[3]); w.z = pk2(v1[0], v1[1]); w.w = pk2(v1[2], v1[3]); *(u32x4*)(out + off + bj * HALF) = w;
                    ss += ((v0.x * v0.x + v0.y * v0.y) + (v0.z * v0.z + v0.w * v0.w)) + ((v1.x * v1.x + v1.y * v1.y) + (v1.z * v1.z + v1.w * v1.w)); }
                ss += __shfl_xor(ss, 16); ss += __shfl_xor(ss, 32); if (fq == 0) rowss[(size_t)row * 16 + u.pn * 4 + wc] = ss; }
            asm volatile("" ::: "memory");
        }
    }
};
struct EpiFinal {
    static constexpr bool PERM = true; struct State {};
    const bf16_t* base; float* out; float* rowss; const float* g; unsigned* cnt;
    __device__ __forceinline__ void operator()(const f32x4 (&acc_)[2][2][4][2], State&, const Unit& u, int wr, int wc, int fr, int fq) const {
        asm volatile("" : "+v"(fr), "+v"(fq));
        f32x4 (&acc)[2][2][4][2] = const_cast<f32x4 (&)[2][2][4][2]>(acc_);
        const int row0 = u.pm * BM + wr * 64 + fr, col0 = u.pn * BM + wc * 32 + 8 * fq;
#pragma unroll
        for (int ai = 0; ai < 2; ++ai) {
            u32x4 bs[4][2];
#pragma unroll
            for (int m = 0; m < 4; ++m) { const size_t off = (size_t)(row0 + ai * HALF + m * 16) * 1024 + col0;
#pragma unroll
                for (int bj = 0; bj < 2; ++bj) bs[m][bj] = *(const u32x4*)(base + off + bj * HALF); }
            asm volatile("" ::: "memory");
#pragma unroll
            for (int m = 0; m < 4; ++m) { const int row = row0 + ai * HALF + m * 16; float ss = 0.f;
#pragma unroll
                for (int bj = 0; bj < 2; ++bj) { const u32x4 w = bs[m][bj];
                    const f32x4 v0 = acc[ai][bj][m][0] + (f32x4){lo_f(w.x), hi_f(w.x), lo_f(w.y), hi_f(w.y)}, v1 = acc[ai][bj][m][1] + (f32x4){lo_f(w.z), hi_f(w.z), lo_f(w.w), hi_f(w.w)};
                    acc[ai][bj][m][0] = v0; acc[ai][bj][m][1] = v1;
                    ss += ((v0.x * v0.x + v0.y * v0.y) + (v0.z * v0.z + v0.w * v0.w)) + ((v1.x * v1.x + v1.y * v1.y) + (v1.z * v1.z + v1.w * v1.w)); }
                ss += __shfl_xor(ss, 16); ss += __shfl_xor(ss, 32); if (fq == 0) rowss[(size_t)row * 16 + u.pn * 4 + wc] = ss; }
        }
        asm volatile("s_waitcnt vmcnt(0)" ::: "memory"); __builtin_amdgcn_s_barrier(); asm volatile("" ::: "memory");
        if (threadIdx.x == 0) {
            __builtin_amdgcn_fence(__ATOMIC_RELEASE, "agent"); asm volatile("s_waitcnt vmcnt(0)" ::: "memory");
            unsigned* c = cnt + 64 * u.pm;
            (void)__hip_atomic_fetch_add(c, 1u, __ATOMIC_RELAXED, __HIP_MEMORY_SCOPE_AGENT);
            unsigned sp = 0;
            while (__hip_atomic_load(c, __ATOMIC_RELAXED, __HIP_MEMORY_SCOPE_AGENT) < 4u) { __builtin_amdgcn_s_sleep(1); if (++sp > (1u << 16)) break; }
            __builtin_amdgcn_fence(__ATOMIC_ACQUIRE, "agent"); asm volatile("s_waitcnt vmcnt(0)" ::: "memory");
        }
        asm volatile("" ::: "memory"); __builtin_amdgcn_s_barrier(); asm volatile("" ::: "memory");
        f32x4 gv[2][2];
#pragma unroll
        for (int bj = 0; bj < 2; ++bj)
#pragma unroll
            for (int q = 0; q < 2; ++q) gv[bj][q] = *(const f32x4*)(g + col0 + bj * HALF + 4 * q);
#pragma unroll
        for (int ai = 0; ai < 2; ++ai)
#pragma unroll
            for (int m = 0; m < 4; ++m) { const int row = row0 + ai * HALF + m * 16; const float rinv = row_rinv(rowss, row, fq); float* op = out + (size_t)row * 1024 + col0;
#pragma unroll
                for (int bj = 0; bj < 2; ++bj) { *(f32x4*)(op + bj * HALF) = acc[ai][bj][m][0] * rinv * gv[bj][0]; *(f32x4*)(op + bj * HALF + 4) = acc[ai][bj][m][1] * rinv * gv[bj][1]; } }
    }
};
struct EpiGateBranch {
    static constexpr bool PERM = true;
    struct State { unsigned g8[2][2][4][2]; };
    bf16_t* mixed; const float* bgate; const float* rowss; LAS unsigned* glds;
    __device__ __forceinline__ void operator()(const f32x4 (&acc)[2][2][4][2], State& st, const Unit& u, int wr, int wc, int fr, int fq) const {
        asm volatile("" : "+v"(fr), "+v"(fq));
        const int rl0 = wr * 64 + fr, cl0 = wc * 32 + 8 * fq, n = u.pn >> 2, pd = u.pn & 3;
        LAS unsigned* gl = glds + (wr * 4 + wc) * 512 + (fq * 16 + fr) * 8;
        if (u.kind == 0) {
            f32x4 bv[2][2];
#pragma unroll
            for (int bj = 0; bj < 2; ++bj)
#pragma unroll
                for (int q = 0; q < 2; ++q) bv[bj][q] = *(const f32x4*)(bgate + u.pn * BM + cl0 + bj * HALF + 4 * q);
#pragma unroll
            for (int ai = 0; ai < 2; ++ai)
#pragma unroll
                for (int m = 0; m < 4; ++m) {
                    const float rinv = row_rinv(rowss, u.pm * BM + rl0 + ai * HALF + m * 16, fq);
#pragma unroll
                    for (int bj = 0; bj < 2; ++bj)
#pragma unroll
                        for (int q = 0; q < 2; ++q) { const f32x4 v = acc[ai][bj][m][q] * rinv + bv[bj][q]; unsigned w = 0u;
#pragma unroll
                            for (int e = 0; e < 4; ++e) w |= (unsigned)(sigmoidf_(v[e]) * 255.0f + 0.5f) << (8 * e);
                            if (ai == 1 && bj == 1) gl[m * 2 + q] = w; else st.g8[ai][bj][m][q] = w; } }
        } else {
#pragma unroll
            for (int ai = 0; ai < 2; ++ai) {
                u32x4 oo[4][2];
#pragma unroll
                for (int m = 0; m < 4; ++m) { const int rl = rl0 + ai * HALF + m * 16; const bf16_t* mp = mixed + (size_t)(u.pm * BM + rl) * 1024 + pd * 256 + cl0;
#pragma unroll
                    for (int bj = 0; bj < 2; ++bj) { oo[m][bj] = (u32x4){0u, 0u, 0u, 0u}; if (n > 0) oo[m][bj] = *(const u32x4*)(mp + bj * HALF); } }
                asm volatile("" ::: "memory");
#pragma unroll
                for (int m = 0; m < 4; ++m) { const int rl = rl0 + ai * HALF + m * 16; bf16_t* mp = mixed + (size_t)(u.pm * BM + rl) * 1024 + pd * 256 + cl0;
#pragma unroll
                    for (int bj = 0; bj < 2; ++bj) { const unsigned g0 = (ai == 1 && bj == 1) ? gl[m * 2] : st.g8[ai][bj][m][0], g1 = (ai == 1 && bj == 1) ? gl[m * 2 + 1] : st.g8[ai][bj][m][1]; const u32x4 o = oo[m][bj]; const f32x4 a0 = acc[ai][bj][m][0] * (1.0f / 255.0f), a1 = acc[ai][bj][m][1] * (1.0f / 255.0f);
                        float v[8];
                        v[0] = fmaf(a0[0], (float)(g0 & 255u), lo_f(o.x)); v[1] = fmaf(a0[1], (float)((g0 >> 8) & 255u), hi_f(o.x)); v[2] = fmaf(a0[2], (float)((g0 >> 16) & 255u), lo_f(o.y)); v[3] = fmaf(a0[3], (float)(g0 >> 24), hi_f(o.y));
                        v[4] = fmaf(a1[0], (float)(g1 & 255u), lo_f(o.z)); v[5] = fmaf(a1[1], (float)((g1 >> 8) & 255u), hi_f(o.z)); v[6] = fmaf(a1[2], (float)((g1 >> 16) & 255u), lo_f(o.w)); v[7] = fmaf(a1[3], (float)(g1 >> 24), hi_f(o.w));
                        u32x4 w; w.x = pk2(v[0], v[1]); w.y = pk2(v[2], v[3]); w.z = pk2(v[4], v[5]); w.w = pk2(v[6], v[7]);
                        *(u32x4*)(mp + bj * HALF) = w; } }
                asm volatile("" ::: "memory");
            }
        }
    }
};

template <class Epi, class Sched>
__device__ __forceinline__ void gemm_phase(LAS unsigned char* lds, const int lda, const int ldb, const Sched& S, const Epi& E) {
    const int tid = fresh_tid(), wid = __builtin_amdgcn_readfirstlane(tid >> 6), lane = tid & 63, wr = wid >> 2, wc = wid & 3, fr = lane & 15, fq = lane >> 4;
    unsigned voffA[2], voffB[2];
#pragma unroll
    for (int i = 0; i < 2; ++i) { int R, C; stage_rc(tid * 16 + i * 8192, R, C); const int Rb = Epi::PERM ? ((R & ~31) + perm32(R & 31)) : R;
        voffA[i] = (unsigned)(R * lda + C) * 2u; voffB[i] = (unsigned)(Rb * ldb + C) * 2u; }
    const size_t kstep = (size_t)(BK * 2);
    const size_t hstepA = (size_t)HALF * lda * 2, hstepB = (size_t)HALF * ldb * 2;
    const unsigned ldsw = (unsigned)wid * 1024u;
    const int aoff = lds_byte(wr * 64 + fr, fq * 8), boff = lds_byte(wc * 32 + fr, fq * 8);
#define PG8_SA(b, h) (((b) * 2 + (h)) * HTB)
#define PG8_SB(b, h) ((4 + (b) * 2 + (h)) * HTB)
#define PG8_STAGE(bufoff, gbase, voff) do { _Pragma("unroll") for (int _i = 0; _i < 2; ++_i) \
        __builtin_amdgcn_global_load_lds((const unsigned*)((const char*)(gbase) + (voff)[_i]), (LAS unsigned*)(lds + (bufoff) + ldsw + _i * 8192), 16, 0, 0); } while (0)
#define PG8_LDA(dst, b, h) do { _Pragma("unroll") for (int m = 0; m < 4; ++m) _Pragma("unroll") for (int k = 0; k < 2; ++k) dst[m][k] = *(const LAS bf16x8*)(lds + PG8_SA(b, h) + aoff + m * 2048 + k * 1024); } while (0)
#define PG8_LDB(dst, b, h) do { _Pragma("unroll") for (int n = 0; n < 2; ++n) _Pragma("unroll") for (int k = 0; k < 2; ++k) dst[n][k] = *(const LAS bf16x8*)(lds + PG8_SB(b, h) + boff + n * 2048 + k * 1024); } while (0)
#define PG8_MMA(ai, bj, At, Bt) do { __builtin_amdgcn_s_setprio(1); _Pragma("unroll") for (int m = 0; m < 4; ++m) _Pragma("unroll") for (int n = 0; n < 2; ++n) _Pragma("unroll") for (int k = 0; k < 2; ++k) \
        acc[ai][bj][m][n] = __builtin_amdgcn_mfma_f32_16x16x32_bf16(Bt[n][k], At[m][k], acc[ai][bj][m][n], 0, 0, 0); __builtin_amdgcn_s_setprio(0); } while (0)
#define PG8_WAIT_V(n) asm volatile("s_waitcnt vmcnt(" #n ")" ::: "memory")
#define PG8_WAIT_L(n) asm volatile("s_waitcnt lgkmcnt(" #n ")" ::: "memory")
#define PG8_BAR __builtin_amdgcn_s_barrier()
#define PG8_SCHED __builtin_amdgcn_sched_barrier(0)
    Unit cur, nxt; int ui = 0;
    if (!S.next(0, cur)) return;
    f32x4 acc[2][2][4][2];
#pragma unroll
    for (int a = 0; a < 2; ++a)
#pragma unroll
        for (int b = 0; b < 2; ++b)
#pragma unroll
            for (int m = 0; m < 4; ++m)
#pragma unroll
                for (int n = 0; n < 2; ++n) acc[a][b][m][n] = (f32x4){0.f, 0.f, 0.f, 0.f};
    bf16x8 At[4][2], B0[2][2], B1[2][2];
    typename Epi::State est;
    const char* cA = cur.a; const char* cB = cur.b;
    PG8_STAGE(PG8_SB(0, 0), cB, voffB); PG8_STAGE(PG8_SB(0, 1), cB + hstepB, voffB); PG8_STAGE(PG8_SA(0, 0), cA, voffA); PG8_STAGE(PG8_SA(0, 1), cA + hstepA, voffA);
    if (wr == 1) PG8_BAR;
    PG8_WAIT_V(2); PG8_BAR;
    PG8_STAGE(PG8_SB(1, 0), cB + kstep, voffB); PG8_STAGE(PG8_SA(1, 0), cA + kstep, voffA); PG8_STAGE(PG8_SB(1, 1), cB + hstepB + kstep, voffB);
    PG8_WAIT_V(6); PG8_BAR;
    for (;;) {
        const bool has_next = S.next(ui + 1, nxt);
        const char* nA = has_next ? nxt.a : cA; const char* nB = has_next ? nxt.b : cB;
        const int nt = cur.nt;
        for (int t = 0; t < nt; t += 2) {
            const bool last = (t == nt - 2);
            const char* a1 = cA + (size_t)(t + 1) * kstep;
            const char* a2 = last ? nA : cA + (size_t)(t + 2) * kstep; const char* b2 = last ? nB : cB + (size_t)(t + 2) * kstep;
            const char* a3 = a2 + kstep; const char* b3 = b2 + kstep;
            PG8_LDB(B0, 0, 0); PG8_LDB(B1, 0, 1); PG8_SCHED; PG8_LDA(At, 0, 0); PG8_STAGE(PG8_SA(1, 1), a1 + hstepA, voffA);
            PG8_WAIT_V(8); PG8_WAIT_L(0); PG8_BAR; PG8_MMA(0, 0, At, B0); PG8_MMA(0, 1, At, B1); PG8_BAR; PG8_SCHED;
            PG8_LDA(At, 0, 1); PG8_STAGE(PG8_SB(0, 0), b2, voffB); PG8_STAGE(PG8_SB(0, 1), b2 + hstepB, voffB); PG8_STAGE(PG8_SA(0, 0), a2, voffA);
            PG8_WAIT_V(8); PG8_WAIT_L(0); PG8_BAR; PG8_MMA(1, 0, At, B0); PG8_MMA(1, 1, At, B1); PG8_BAR; PG8_SCHED;
            PG8_LDB(B0, 1, 0); PG8_LDB(B1, 1, 1); PG8_SCHED; PG8_LDA(At, 1, 0); PG8_STAGE(PG8_SA(0, 1), a2 + hstepA, voffA);
            PG8_WAIT_V(8); PG8_WAIT_L(0); PG8_BAR; PG8_MMA(0, 0, At, B0); PG8_MMA(0, 1, At, B1); PG8_BAR; PG8_SCHED;
            PG8_LDA(At, 1, 1); PG8_STAGE(PG8_SB(1, 0), b3, voffB); PG8_STAGE(PG8_SB(1, 1), b3 + hstepB, voffB); PG8_STAGE(PG8_SA(1, 0), a3, voffA);
            PG8_WAIT_V(8); PG8_WAIT_L(0); PG8_BAR; PG8_MMA(1, 0, At, B0); PG8_MMA(1, 1, At, B1); PG8_BAR; PG8_SCHED;
        }
        if (wr == 0) PG8_BAR;
        E(acc, est, cur, wr, wc, fr, fq);
        if (!has_next) break;
#pragma unroll
        for (int a = 0; a < 2; ++a)
#pragma unroll
            for (int b = 0; b < 2; ++b)
#pragma unroll
                for (int m = 0; m < 4; ++m)
#pragma unroll
                    for (int n = 0; n < 2; ++n) acc[a][b][m][n] = (f32x4){0.f, 0.f, 0.f, 0.f};
        cur = nxt; cA = nA; cB = nB; ++ui;
        if (wr == 1) PG8_BAR;
    }
    PG8_WAIT_V(0);
    PG8_BAR;
#undef PG8_SA
#undef PG8_SB
#undef PG8_STAGE
#undef PG8_LDA
#undef PG8_LDB
#undef PG8_MMA
#undef PG8_WAIT_V
#undef PG8_WAIT_L
#undef PG8_BAR
#undef PG8_SCHED
}
}

namespace att {
constexpr int VP = 144;
typedef short v4i16_t __attribute__((ext_vector_type(4)));
__device__ __forceinline__ int crow(int i, int h) { return (i & 3) + 8 * (i >> 2) + 4 * h; }
__device__ __forceinline__ s16x4 vtr(const LAS unsigned char* p) { return __builtin_bit_cast(s16x4, __builtin_amdgcn_ds_read_tr16_b64_v4i16((LAS v4i16_t*)p)); }
#define MFMA32(a, b, c) __builtin_amdgcn_mfma_f32_32x32x16_bf16((a), (b), (c), 0, 0, 0)

template <int MODE>
__device__ __forceinline__ void unit(int layer, int b, int h, int qb, LAS unsigned char* lds) {
    const cargs_t ap = get_args();
    unsigned char* const ws_ = ap->ws;
    constexpr int DK = MODE == 1 ? 96 : 64, ND = DK / 16, KP = DK * 2 + 16, KBUF = 64 * KP, VBUF = 64 * VP;
    LAS unsigned char* Ks = lds; LAS unsigned char* Vs = lds + 2 * KBUF;
    LAS float* Fs = (LAS float*)(lds + 2 * KBUF + 2 * VBUF); LAS float* Tab = Fs + 128;
    const int tid = fresh_tid(), lane = tid & 63, wid = __builtin_amdgcn_readfirstlane(tid >> 6), r = lane & 31, hh = lane >> 5;
    const size_t tok0 = (size_t)b * SEQ;
    const int qw = qb * 256 + wid * 32, qc = qw >> 6;
    const bf16_t* PROJ = (const bf16_t*)(ws_ + WS_PROJ); const bf16_t* QKVB = (const bf16_t*)(ws_ + WS_QKVB); const bf16_t* KROT = (const bf16_t*)(ws_ + WS_KROT);
    const float* FCUM = (const float*)(ws_ + WS_FCUM) + (size_t)(b * 4 + h) * SEQ;
    bf16_t* BR = (bf16_t*)(ws_ + WS_BR);
    const bf16_t *Qp, *Kp, *Vp; int ldq, ldk;
    if (MODE == 0) { Qp = PROJ + C_AQ + h * 64; Kp = PROJ + C_AK + h * 64; Vp = PROJ + C_AV + h * 64; ldq = PLD; ldk = PLD; }
    else if (MODE == 2) { Qp = PROJ + C_CQ + h * 64; Kp = PROJ + C_CK + h * 64; Vp = PROJ + C_CV + h * 64; ldq = PLD; ldk = PLD; }
    else { Qp = QKVB + h * 96; Kp = QKVB + 512 + h * 128; Vp = Kp + 64; ldq = 1024; ldk = 1024; }
    const int t_lo = (MODE == 0) ? (qb * 4 - 8 > 0 ? qb * 4 - 8 : 0) : 0, t_hi = qb * 4 + 4;
    const float cs = (MODE == 1 ? 0.10206207261596577f : 0.125f) * LOG2E;

    u32x4 kregA, vregA, kr2A, kregB, vregB, kr2B; float fregA = 0.f, fregB = 0.f;
    const int srow = tid >> 3, sch = tid & 7;
#define ATT_LOAD(j, X) do { const size_t trow = tok0 + (size_t)(j) * 64; \
        kreg##X = *(const u32x4*)(Kp + (trow + srow) * ldk + sch * 8); vreg##X = *(const u32x4*)(Vp + (trow + srow) * ldk + sch * 8); \
        if (MODE == 1) { if (tid < 256) kr2##X = *(const u32x4*)(KROT + (trow + (tid >> 2)) * 32 + (tid & 3) * 8); } \
        if (MODE == 2) { if (tid < 64) freg##X = FCUM[(j) * 64 + tid]; } } while (0)
#define ATT_STORE(s, X) do { *(LAS u32x4*)(Ks + (s) * KBUF + srow * KP + sch * 16) = kreg##X; *(LAS u32x4*)(Vs + (s) * VBUF + srow * VP + sch * 16) = vreg##X; \
        if (MODE == 1) { if (tid < 256) *(LAS u32x4*)(Ks + (s) * KBUF + (tid >> 2) * KP + 128 + (tid & 3) * 16) = kr2##X; } \
        if (MODE == 2) { if (tid < 64) Fs[(s) * 64 + tid] = freg##X * LOG2E; } } while (0)

    ATT_LOAD(t_hi - 1, A);
    ATT_LOAD(t_hi - 2, B);
    if (MODE == 0) { if (tid < 257) Tab[tid] = ap->rel_bias[(size_t)(layer * 4 + h) * 257 + tid] * LOG2E; }
    bf16x8 qf[ND];
    { const bf16_t* qrow = Qp + (tok0 + qw + r) * ldq;
#pragma unroll
      for (int d0 = 0; d0 < ND; ++d0) qf[d0] = *(const bf16x8*)(qrow + d0 * 16 + hh * 8); }
    if (MODE == 1) {
        const float pos = (float)ap->pos[tok0 + qw + r];
#pragma unroll
        for (int j = 0; j < 8; ++j) {
            const float invf = exp2f(-(float)(8 * hh + j) * 0.8304820237218406f);
            const float ang = pos * invf, kk = rintf(ang * 0.15915494309189535f);
            float rem = fmaf(-kk, 6.2831854820251465f, ang); rem = fmaf(kk, 1.7484555e-7f, rem);
            const float sn = __sinf(rem), cn = __cosf(rem);
            const float x1 = bf2f((unsigned short)qf[4][j]), x2 = bf2f((unsigned short)qf[5][j]);
            const unsigned w = pk2(x1 * cn - x2 * sn, x2 * cn + x1 * sn);
            qf[4][j] = (short)(w & 0xffffu); qf[5][j] = (short)(w >> 16);
        }
    }
    float fq = 0.f;
    if (MODE == 2) fq = FCUM[qw + r] * LOG2E;
    float m_run = -INFINITY, l_run = 0.f;
    f32x16 o0, o1;
#pragma unroll
    for (int i = 0; i < 16; ++i) { o0[i] = 0.f; o1[i] = 0.f; }
    ATT_STORE(0, A);
    __syncthreads();
    const int i16 = lane & 15, vq = i16 >> 2, vp = i16 & 3, vblk = (lane >> 4) & 1;
    const int voff = (4 * hh + vq) * VP + vblk * 32 + vp * 8;

    auto compute = [&](const int j, const int s) __attribute__((always_inline)) {
        const bool active = (MODE == 0) ? (j <= qc && j >= qc - 8) : (j <= qc);
        if (active) {
            const LAS unsigned char* kb = Ks + s * KBUF + r * KP + hh * 16;
            f32x16 p0, p1;
#pragma unroll
            for (int i = 0; i < 16; ++i) { p0[i] = 0.f; p1[i] = 0.f; }
#pragma unroll
            for (int d0 = 0; d0 < ND; ++d0) {
                const bf16x8 kf0 = *(const LAS bf16x8*)(kb + d0 * 32), kf1 = *(const LAS bf16x8*)(kb + 32 * KP + d0 * 32);
                p0 = MFMA32(kf0, qf[d0], p0); p1 = MFMA32(kf1, qf[d0], p1);
            }
            if (MODE == 0) {
                const int delta = qc - j;
                if (delta >= 3) { const float cb = Tab[256];
#pragma unroll
                    for (int i = 0; i < 16; ++i) { p0[i] = fmaf(p0[i], cs, cb); p1[i] = fmaf(p1[i], cs, cb); }
                } else { const int brel = 64 * delta + (qw & 63) + r + 128;
#pragma unroll
                    for (int i = 0; i < 16; ++i) { const int kj = crow(i, hh); int i0 = brel - kj, i1 = brel - kj - 32;
                        i0 = i0 < 0 ? 0 : (i0 > 256 ? 256 : i0); i1 = i1 < 0 ? 0 : (i1 > 256 ? 256 : i1);
                        p0[i] = fmaf(p0[i], cs, Tab[i0]); p1[i] = fmaf(p1[i], cs, Tab[i1]); }
                }
            } else if (MODE == 1) {
#pragma unroll
                for (int i = 0; i < 16; ++i) { p0[i] *= cs; p1[i] *= cs; }
            } else {
                const LAS float* fs = Fs + s * 64 + 4 * hh;
#pragma unroll
                for (int g = 0; g < 4; ++g) { const f32x4 f0 = *(const LAS f32x4*)(fs + 8 * g), f1 = *(const LAS f32x4*)(fs + 32 + 8 * g);
#pragma unroll
                    for (int e = 0; e < 4; ++e) { p0[4 * g + e] = fmaf(p0[4 * g + e], cs, fq - f0[e]); p1[4 * g + e] = fmaf(p1[4 * g + e], cs, fq - f1[e]); } }
                if (j == qc) { const int qrel = (qw & 63) + r;
#pragma unroll
                    for (int i = 0; i < 16; ++i) { const int kj = crow(i, hh); if (kj > qrel) p0[i] = -INFINITY; if (kj + 32 > qrel) p1[i] = -INFINITY; } }
            }
            float mx = p0[0];
#pragma unroll
            for (int i = 1; i < 16; ++i) mx = fmaxf(mx, p0[i]);
#pragma unroll
            for (int i = 0; i < 16; ++i) mx = fmaxf(mx, p1[i]);
            { auto rr = __builtin_amdgcn_permlane32_swap(__float_as_uint(mx), __float_as_uint(mx), false, false); mx = fmaxf(__uint_as_float(rr[0]), __uint_as_float(rr[1])); }
            if (__all(mx < m_run - 40.f)) return;
            if (__any(mx > m_run)) {
                const float m_new = fmaxf(m_run, mx);
                const float alpha = __builtin_amdgcn_exp2f(m_run - m_new);
                m_run = m_new; l_run *= alpha;
#pragma unroll
                for (int i = 0; i < 16; ++i) { o0[i] *= alpha; o1[i] *= alpha; }
            }
            float sum = 0.f;
#pragma unroll
            for (int i = 0; i < 16; ++i) { p0[i] = __builtin_amdgcn_exp2f(p0[i] - m_run); p1[i] = __builtin_amdgcn_exp2f(p1[i] - m_run); sum += p0[i] + p1[i]; }
            l_run += sum;
            const LAS unsigned char* vb = Vs + s * VBUF + voff;
#pragma unroll
            for (int kbk = 0; kbk < 2; ++kbk)
#pragma unroll
                for (int st = 0; st < 2; ++st) {
                    const f32x16& pp = kbk ? p1 : p0;
                    u32x4 pw; pw.x = pk2(pp[8 * st + 0], pp[8 * st + 1]); pw.y = pk2(pp[8 * st + 2], pp[8 * st + 3]); pw.z = pk2(pp[8 * st + 4], pp[8 * st + 5]); pw.w = pk2(pp[8 * st + 6], pp[8 * st + 7]);
                    const bf16x8 pf = __builtin_bit_cast(bf16x8, pw);
                    const LAS unsigned char* vr = vb + (32 * kbk + 16 * st) * VP;
                    const s16x4 a_lo = vtr(vr), a_hi = vtr(vr + 8 * VP), b_lo = vtr(vr + 64), b_hi = vtr(vr + 8 * VP + 64);
                    const bf16x8 v0 = __builtin_shufflevector(a_lo, a_hi, 0, 1, 2, 3, 4, 5, 6, 7), v1 = __builtin_shufflevector(b_lo, b_hi, 0, 1, 2, 3, 4, 5, 6, 7);
                    o0 = MFMA32(v0, pf, o0); o1 = MFMA32(v1, pf, o1);
                }
        }
    };
    for (int j = t_hi - 1; j >= t_lo; j -= 2) {
        if (j - 2 >= t_lo) ATT_LOAD(j - 2, A);
        compute(j, 0);
        ATT_STORE(1, B);
        __syncthreads();
        if (j - 3 >= t_lo) ATT_LOAD(j - 3, B);
        compute(j - 1, 1);
        if (j - 2 >= t_lo) ATT_STORE(0, A);
        __syncthreads();
    }
    const float l_tot = l_run + __shfl_xor(l_run, 32);
    const float inv = 1.0f / l_tot;
    bf16_t* dst = BR + (tok0 + qw + r) * 1024 + (MODE == 0 ? 0 : (MODE == 1 ? 256 : 512)) + h * 64 + 4 * hh;
#pragma unroll
    for (int g = 0; g < 4; ++g) {
        u32x2 w0, w1;
        w0.x = pk2(o0[4 * g] * inv, o0[4 * g + 1] * inv); w0.y = pk2(o0[4 * g + 2] * inv, o0[4 * g + 3] * inv);
        w1.x = pk2(o1[4 * g] * inv, o1[4 * g + 1] * inv); w1.y = pk2(o1[4 * g + 2] * inv, o1[4 * g + 3] * inv);
        *(u32x2*)(dst + 8 * g) = w0; *(u32x2*)(dst + 32 + 8 * g) = w1;
    }
#undef ATT_LOAD
#undef ATT_STORE
}
}

__device__ __forceinline__ void transpose_item(const float* W, int N, int nblk, bf16_t* WT, int ldt, LAS float* scr, int item, int lane, const float* gk = nullptr) {
    const int kb = item / nblk, nb = item % nblk, k0 = 64 * kb, n0 = 32 * nb;
    const int nn = n0 + (lane & 31); const bool ok = nn < N;
    float tmp[32];
#pragma unroll
    for (int i = 0; i < 32; ++i) { const int kk = 2 * i + (lane >> 5); tmp[i] = ok ? W[(size_t)(k0 + kk) * N + nn] : 0.f; }
#pragma unroll
    for (int i = 0; i < 32; ++i) { const int kk = 2 * i + (lane >> 5); scr[kk * 33 + (lane & 31)] = tmp[i]; }
    LDS_WAIT(); asm volatile("" ::: "memory");
    const int c = lane & 7;
    f32x4 ga = {1.f, 1.f, 1.f, 1.f}, gb = ga;
    if (gk) { ga = *(const f32x4*)(gk + k0 + 8 * c); gb = *(const f32x4*)(gk + k0 + 8 * c + 4); }
#pragma unroll
    for (int j = 0; j < 4; ++j) { const int n = (lane >> 3) + 8 * j; const LAS float* s = scr + (8 * c) * 33 + n;
        u32x4 o; o.x = pk2(s[0 * 33] * ga.x, s[1 * 33] * ga.y); o.y = pk2(s[2 * 33] * ga.z, s[3 * 33] * ga.w); o.z = pk2(s[4 * 33] * gb.x, s[5 * 33] * gb.y); o.w = pk2(s[6 * 33] * gb.z, s[7 * 33] * gb.w);
        *(u32x4*)(WT + (size_t)(n0 + n) * ldt + k0 + 8 * c) = o; }
    LDS_WAIT(); asm volatile("" ::: "memory");
}
__device__ __forceinline__ void prenorm_row(const float* xrow, bf16_t* orow, float* rowss, int lane) {
    const f32x4* xr = (const f32x4*)xrow + lane;
    f32x4 v[4]; float s = 0.f;
#pragma unroll
    for (int j = 0; j < 4; ++j) { v[j] = xr[64 * j]; s += (v[j].x * v[j].x + v[j].y * v[j].y) + (v[j].z * v[j].z + v[j].w * v[j].w); }
    s = wave_sum(s); if (lane < 16) rowss[lane] = (lane == 0) ? s : 0.f;
#pragma unroll
    for (int j = 0; j < 4; ++j) { u32x2 w; w.x = pk2(v[j].x, v[j].y); w.y = pk2(v[j].z, v[j].w); ((u32x2*)orow)[lane + 64 * j] = w; }
}
__device__ __forceinline__ float logsig(float z) { return fminf(z, 0.f) - __logf(1.0f + __expf(-fabsf(z))); }


constexpr int I_G = 16 * 128, I_B = 4 * 32, I_O = 16 * 32, I_U = 16 * 128, I_D = 64 * 32, N_LATE_ITEMS = I_G + 4 * I_B + I_O + I_U + I_D;
__device__ __forceinline__ void late_weight_item(int l, int r, LAS float* scr, int lane) {
    const cargs_t ap = get_args(); unsigned char* const ws = ap->ws;
    if (r < I_G) { transpose_item(ap->w_gate + (size_t)l * 1024 * 4096, 4096, 128, (bf16_t*)(ws + WS_WGT), 1024, scr, r, lane, ap->g_mix + l * 1024); return; } r -= I_G;
    if (r < 4 * I_B) { const int n = r / I_B; transpose_item(ap->w_branch + (size_t)l * 4 * 256 * 1024 + (size_t)n * 256 * 1024, 1024, 32, (bf16_t*)(ws + WS_WBT) + (size_t)n * 1024 * 1024 + n * 256, 1024, scr, r % I_B, lane); return; } r -= 4 * I_B;
    if (r < I_O) { transpose_item(ap->w_o + (size_t)l * 1024 * 1024, 1024, 32, (bf16_t*)(ws + WS_WOT), 1024, scr, r, lane); return; } r -= I_O;
    if (r < I_U) { transpose_item(ap->w_up + (size_t)l * 1024 * 4096, 4096, 128, (bf16_t*)(ws + WS_W1T), 1024, scr, r, lane, ap->g_ffn + l * 1024); return; } r -= I_U;
    transpose_item(ap->w_down + (size_t)l * 4096 * 1024, 1024, 32, (bf16_t*)(ws + WS_W2T), 4096, scr, r, lane);
}
__device__ __forceinline__ void conv_tokens(int l, int t0, int lane) {
    const cargs_t ap = get_args(); unsigned char* const ws = ap->ws;
    const bf16_t* U = (const bf16_t*)(ws + WS_U); bf16_t* BR = (bf16_t*)(ws + WS_BR);
    const float* wdw = ap->w_dw + (size_t)l * 31 * 256; const f32x4 bdw = *(const f32x4*)(ap->b_dw + l * 256 + 4 * lane);
    const f32x4 gln = *(const f32x4*)(ap->g_conv_ln + l * 256 + 4 * lane), bln = *(const f32x4*)(ap->b_conv_ln + l * 256 + 4 * lane);
    const int ts0 = t0 & (SEQ - 1);
    const float* wl = wdw + 4 * lane; asm volatile("" : "+v"(wl));
    u32x2 ur[38];
#pragma unroll
    for (int i = 0; i < 38; ++i) { const int tt = ts0 - 30 + i; ur[i] = (u32x2){0u, 0u}; if (tt >= 0) ur[i] = *(const u32x2*)(U + (size_t)(t0 - 30 + i) * 256 + 4 * lane); }
    f32x4 acc[8];
#pragma unroll
    for (int j = 0; j < 8; ++j) acc[j] = bdw;
#pragma unroll
    for (int k = 0; k < 31; ++k) { const f32x4 w = *(const f32x4*)(wl + k * 256);
#pragma unroll
        for (int j = 0; j < 8; ++j) { const u32x2 u = ur[j + k];
            acc[j].x = fmaf(lo_f(u.x), w.x, acc[j].x); acc[j].y = fmaf(hi_f(u.x), w.y, acc[j].y); acc[j].z = fmaf(lo_f(u.y), w.z, acc[j].z); acc[j].w = fmaf(hi_f(u.y), w.w, acc[j].w); } }
#pragma unroll
    for (int j = 0; j < 8; ++j) {
        const float mean = wave_sum((acc[j].x + acc[j].y) + (acc[j].z + acc[j].w)) * (1.0f / 256.0f);
        const f32x4 d = acc[j] - mean;
        const float rstd = 1.0f / sqrtf(wave_sum((d.x * d.x + d.y * d.y) + (d.z * d.z + d.w * d.w)) * (1.0f / 256.0f) + EPS);
        const f32x4 y = d * rstd * gln + bln;
        u32x2 o; o.x = pk2(y.x * sigmoidf_(y.x), y.y * sigmoidf_(y.y)); o.y = pk2(y.z * sigmoidf_(y.z), y.w * sigmoidf_(y.w));
        *(u32x2*)(BR + (size_t)(t0 + j) * 1024 + 768 + 4 * lane) = o;
    }
}

__device__ __forceinline__ void win_item(int l, int r, LAS float* scr, int lane) {
    const cargs_t ap = get_args();
    transpose_item(ap->w_in + (size_t)l * 1024 * INC, INC, 80, (bf16_t*)(ap->ws + (l == 0 ? WS_WINT : WS_WINT1)), 1024, scr, r, lane, ap->g_mix + l * 1024);
}
__device__ __forceinline__ void wlat_chunk(int l, int c) {
    const cargs_t ap = get_args();
    const float* w_uq = ap->w_uq + (size_t)l * 256 * 384; const float* w_ukv = ap->w_ukv + (size_t)l * 128 * 512; const float* gq = ap->g_q_lat + l * 256; const float* gkv = ap->g_kv_lat + l * 128;
    const int n = c / 48, k0 = (c % 48) * 8; float v[8];
#pragma unroll
    for (int e = 0; e < 8; ++e) { const int k = k0 + e; v[e] = (n < 384 && k < 256) ? gq[k] * w_uq[(size_t)k * 384 + n] : ((n >= 512 && k >= 256) ? gkv[k - 256] * w_ukv[(size_t)(k - 256) * 512 + (n - 512)] : 0.f); }
    u32x4 o; o.x = pk2(v[0], v[1]); o.y = pk2(v[2], v[3]); o.z = pk2(v[4], v[5]); o.w = pk2(v[6], v[7]);
    *(u32x4*)((bf16_t*)(ap->ws + (l == 0 ? WS_WLT : WS_WLT1)) + (size_t)n * 384 + k0) = o;
}

#define XB_TMO      128
#define XB_XCNT(j)  (256  + 64 * (j))
#define XB_XSUB(j)  (1280 + 64 * (j))
#define XB_XGEN(j)  (2304 + 64 * (j))
#define XB_TOP      3328
#define XB_TOPGEN   3392
#define XCD_BAR_WORDS 3456
#define XB_SPIN_CAP (1u << 18)
__device__ __forceinline__ unsigned xb_ld(unsigned* p)              { return __hip_atomic_load(p, __ATOMIC_RELAXED, __HIP_MEMORY_SCOPE_AGENT); }
__device__ __forceinline__ unsigned xb_add(unsigned* p, unsigned v) { return __hip_atomic_fetch_add(p, v, __ATOMIC_RELAXED, __HIP_MEMORY_SCOPE_AGENT); }
__device__ __forceinline__ unsigned xb_xcc_id() { return (unsigned)__builtin_amdgcn_s_getreg((3 << 11) | 20) & 0xFu; }
#define XB_SPIN(cond, bar) do { unsigned _sp = 0; while (cond) { __builtin_amdgcn_s_sleep(1); \
    if ((++_sp & 255u) == 0u) { if (xb_ld(&(bar)[XB_TMO])) break; if (_sp > XB_SPIN_CAP) { atomicAdd(&(bar)[XB_TMO], 1u); break; } } } } while (0)
struct XcdBarrier { unsigned* bar; unsigned x; volatile LAS unsigned* st; };
__device__ __forceinline__ void xcd_barrier_complete(unsigned* bar, unsigned x, unsigned& nloc, unsigned& nx) {
    const unsigned G = gridDim.x * gridDim.y * gridDim.z;
    unsigned sum, cnt, mine, sp = 0u;
    for (;;) {
        sum = 0u; cnt = 0u; mine = 0u;
#pragma unroll
        for (unsigned j = 0; j < 16; ++j) { const unsigned c = xb_ld(&bar[XB_XCNT(j)]); sum += c; cnt += (c > 0u) ? 1u : 0u; mine = (j == x) ? c : mine; }
        if (sum == G) break;
        __builtin_amdgcn_s_sleep(1);
        if ((++sp & 255u) == 0u) { if (xb_ld(&bar[XB_TMO])) break; if (sp > XB_SPIN_CAP) { atomicAdd(&bar[XB_TMO], 1u); break; } }
    }
    nloc = mine > 0u ? mine : 1u; nx = cnt > 0u ? cnt : 1u;
}
__device__ __forceinline__ void xcd_barrier(const XcdBarrier& b) {
    asm volatile("s_waitcnt vmcnt(0)" ::: "memory");
    __syncthreads();
    if (threadIdx.x == 0) {
        unsigned* bar = b.bar;
        __builtin_amdgcn_s_waitcnt(0);
        unsigned nloc = b.st[0], nx = b.st[1];
        if (nloc == 0u) { xcd_barrier_complete(bar, b.x, nloc, nx); b.st[0] = nloc; b.st[1] = nx; }
        const unsigned old = xb_add(&bar[XB_XSUB(b.x)], 1u);
        const unsigned gen = old / nloc;
        if (old + 1u == (gen + 1u) * nloc) {
            __builtin_amdgcn_fence(__ATOMIC_RELEASE, "agent");
            asm volatile("s_waitcnt vmcnt(0)" ::: "memory");
            const unsigned og = xb_add(&bar[XB_TOP], 1u);
            const unsigned tg = og / nx;
            if (og + 1u == (tg + 1u) * nx) xb_add(&bar[XB_TOPGEN], 1u);
            else XB_SPIN(xb_ld(&bar[XB_TOPGEN]) == tg, bar);
            __builtin_amdgcn_fence(__ATOMIC_ACQUIRE, "agent");
            xb_add(&bar[XB_XGEN(b.x)], 1u);
            asm volatile("s_waitcnt vmcnt(0)" ::: "memory");
        } else {
            XB_SPIN(xb_ld(&bar[XB_XGEN(b.x)]) == gen, bar);
            __builtin_amdgcn_fence(__ATOMIC_ACQUIRE, "agent");
            asm volatile("s_waitcnt vmcnt(0)" ::: "memory");
        }
    }
    __syncthreads();
}
constexpr int CTL_BAR_WORD = 4096;
constexpr int LDS_MISC = 131072 + 128;
#define GRID_BAR() do { const cargs_t ap_ = get_args(); XcdBarrier b_; b_.bar = (unsigned*)(ap_->ws + WS_CTL) + CTL_BAR_WORD; b_.x = xb_xcc_id(); \
    b_.st = (volatile LAS unsigned*)(lds + LDS_MISC); xcd_barrier(b_); } while (0)

#define WSP(T, off) ((T*)(ws + (off)))
#define REP_P1 1
#define REP_P2 1
#define REP_P3 1
#define REP_P4 1
#define REP_P5 1
#define REP_P6 1
#define REP_P7 1
#define REP_P8 1
#define REP_P9 1
#define REP_P10 1
#define REP_SYNC 0
#define PHASE_BEGIN(R) _Pragma("unroll 1") for (int rep = 0; rep < (R); ++rep) {
#define PHASE_END GRID_BAR(); }
__global__ void __launch_bounds__(512, 2) fwd_megakernel(Args A_unused) {
    extern __shared__ __attribute__((aligned(16))) unsigned char lds_raw[];
    LAS unsigned char* lds = (LAS unsigned char*)lds_raw;
    {
        if (threadIdx.x < 8) ((LAS unsigned*)(lds + LDS_MISC))[threadIdx.x] = 0u;
        __syncthreads();
        const cargs_t ap = get_args();
        if (threadIdx.x == 0) (void)xb_add((unsigned*)(ap->ws + WS_CTL) + CTL_BAR_WORD + XB_XCNT(xb_xcc_id()), 1u);
    }
    cg::this_grid().sync();

#pragma unroll 1
    for (int l = 0; l < 2; ++l) {
        if (l == 0) {
        PHASE_BEGIN(REP_P1)
            const cargs_t ap = get_args(); unsigned char* const ws = ap->ws;
            const int tid = fresh_tid(), lane = tid & 63, wid = __builtin_amdgcn_readfirstlane(tid >> 6), G = gridDim.x, bx = blockIdx.x, gw = bx * 8 + wid, NGW = G * 8;
            LAS float* scr = (LAS float*)(lds + wid * 16384);
            for (int it = gw; it < 1280; it += NGW) win_item(0, it, scr, lane);
            for (int c = bx * 512 + tid; c < 1024 * 48; c += G * 512) wlat_chunk(0, c);
            const float* xin = ap->x; bf16_t* XN = WSP(bf16_t, WS_XN); float* rss = WSP(float, WS_ROWSS);
            for (int m = gw; m < TOK; m += NGW) prenorm_row(xin + (size_t)m * 1024, XN + (size_t)m * 1024, rss + (size_t)m * 16, lane);
        GRID_BAR(); }
        }
        PHASE_BEGIN(REP_P2)
            const cargs_t ap = get_args(); unsigned char* const ws = ap->ws;
            const char* hin = (l == 0) ? WSP(const char, WS_XN) : (const char*)ap->out;
            pg8::PlainOrder S{hin, (l == 0) ? WSP(const char, WS_WINT) : WSP(const char, WS_WINT1), 1024, 1024, 64, 10, 16, (int)gridDim.x, (int)blockIdx.x};
            const float* slots = WSP(const float, WS_ROWSS) + (size_t)(l * 2) * ROWSS_STRIDE;
            pg8::Unit u0; int pm0 = -1; if (S.next(0, u0)) { pm0 = u0.pm; fill_rinv_table(lds, slots, pm0); }
            pg8::EpiBf16<0, 1, true> E{WSP(bf16_t, WS_PROJ), PLD, slots, pm0, (unsigned)(uintptr_t)(lds + LDS_RINV), WSP(float, WS_LATSS)};
            pg8::gemm_phase(lds, 1024, 1024, S, E);
        PHASE_END
        PHASE_BEGIN(REP_P3)
            const cargs_t ap = get_args(); unsigned char* const ws = ap->ws;
            const int tid = fresh_tid(), lane = tid & 63, wid = __builtin_amdgcn_readfirstlane(tid >> 6), G = gridDim.x, bx = blockIdx.x, gw = bx * 8 + wid, NGW = G * 8;
            const bf16_t* PROJ = WSP(const bf16_t, WS_PROJ);
            if (bx < 16) {
                const int b = bx >> 2, h = bx & 3; const float bf = ap->b_forget[l * 4 + h];
                const bf16_t* src = PROJ + ((size_t)b * SEQ + tid * 8) * PLD + C_CF + h;
                float v[8];
#pragma unroll
                for (int i = 0; i < 8; ++i) v[i] = bf2f(src[(size_t)i * PLD]);
#pragma unroll
                for (int i = 0; i < 8; ++i) { v[i] = logsig(v[i] + bf); if (i) v[i] += v[i - 1]; }
                float incl = v[7];
#pragma unroll
                for (int o = 1; o < 64; o <<= 1) { const float u = __shfl_up(incl, o); if (lane >= o) incl += u; }
                LAS float* wtot = (LAS float*)(lds + 131072 + 64);
                if (lane == 63) wtot[wid] = incl;
                __syncthreads();
                float off = incl - v[7];
                for (int w = 0; w < wid; ++w) off += wtot[w];
                float* dst = WSP(float, WS_FCUM) + (size_t)(b * 4 + h) * SEQ + tid * 8;
                f32x4 o0 = {v[0] + off, v[1] + off, v[2] + off, v[3] + off}, o1 = {v[4] + off, v[5] + off, v[6] + off, v[7] + off};
                *(f32x4*)dst = o0; *(f32x4*)(dst + 4) = o1;
            }
            const int* posp = ap->pos;
            bf16_t* KROT = WSP(bf16_t, WS_KROT); bf16_t* U = WSP(bf16_t, WS_U);
            const float invf = exp2f(-(float)(lane & 15) * 0.8304820237218406f);
            for (int t0 = gw * 4; t0 < TOK; t0 += NGW * 4) {
                u32x2 dv4[4], dg4[4]; float x14[4], x24[4], pos4[4];
#pragma unroll
                for (int j = 0; j < 4; ++j) { const bf16_t* row = PROJ + (size_t)(t0 + j) * PLD;
                    dv4[j] = *(const u32x2*)(row + C_DV + 4 * lane); dg4[j] = *(const u32x2*)(row + C_DG + 4 * lane);
                    x14[j] = bf2f(row[C_BKR + (lane & 15)]); x24[j] = bf2f(row[C_BKR + 16 + (lane & 15)]); pos4[j] = (float)posp[t0 + j]; }
#pragma unroll
                for (int j = 0; j < 4; ++j) { const int t = t0 + j;
                    if (lane < 16) {
                        const float ang = pos4[j] * invf, kk = rintf(ang * 0.15915494309189535f);
                        float rem = fmaf(-kk, 6.2831854820251465f, ang); rem = fmaf(kk, 1.7484555e-7f, rem);
                        const float sn = __sinf(rem), cn = __cosf(rem);
                        const unsigned w = pk2(x14[j] * cn - x24[j] * sn, x24[j] * cn + x14[j] * sn);
                        KROT[(size_t)t * 32 + lane] = (bf16_t)(w & 0xffffu); KROT[(size_t)t * 32 + 16 + lane] = (bf16_t)(w >> 16);
                    }
                    {
                        const u32x2 v = dv4[j], gt = dg4[j];
                        u32x2 o; o.x = pk2(lo_f(v.x) * sigmoidf_(lo_f(gt.x)), hi_f(v.x) * sigmoidf_(hi_f(gt.x))); o.y = pk2(lo_f(v.y) * sigmoidf_(lo_f(gt.y)), hi_f(v.y) * sigmoidf_(hi_f(gt.y)));
                        *(u32x2*)(U + (size_t)t * 256 + 4 * lane) = o;
                    }
                }
            }
            { const cargs_t ap2 = get_args(); unsigned char* const ws = ap2->ws;
              pg8::PlainOrder S{WSP(const char, WS_PROJ) + C_BQL * 2, (l == 0) ? WSP(const char, WS_WLT) : WSP(const char, WS_WLT1), PLD, 384, 64, 4, 6, (int)gridDim.x, (int)blockIdx.x};
              pg8::EpiBf16<0, 2> E{WSP(bf16_t, WS_QKVB), 1024, nullptr, -1, 0u, WSP(float, WS_LATSS)};
              pg8::gemm_phase(lds, PLD, 384, S, E); }
        PHASE_END
        PHASE_BEGIN(REP_P5)
            LAS int* wq = (LAS int*)(lds + 131072);
            for (;;) {
                __syncthreads();
                if (threadIdx.x == 0) { const cargs_t ap = get_args(); wq[0] = atomicAdd((int*)(ap->ws + WS_CTL) + 16 * (l * 8 + rep), 1); }
                __syncthreads();
                const int it = wq[0];
                if (it >= 768 + 256 + N_LATE_ITEMS / 16 + (l == 0 ? 80 + 96 : 0)) break;
                if (it >= 768) {
                    const int tidq = fresh_tid(), laneq = tidq & 63, widq = __builtin_amdgcn_readfirstlane(tidq >> 6);
                    if (it < 1024) conv_tokens(l, ((it - 768) * 8 + widq) * 8, laneq);
                    else if (it >= 1024 + N_LATE_ITEMS / 16) {
                        const int e = it - (1024 + N_LATE_ITEMS / 16);
                        if (e < 80) { LAS float* scr = (LAS float*)(lds + widq * 16384); win_item(l + 1, e * 16 + widq * 2, scr, laneq); win_item(l + 1, e * 16 + widq * 2 + 1, scr, laneq); }
                        else wlat_chunk(l + 1, (e - 80) * 512 + tidq);
                    }
                    else { LAS float* scr = (LAS float*)(lds + widq * 16384); const int r0 = (it - 1024) * 16 + widq * 2; late_weight_item(l, r0, scr, laneq); late_weight_item(l, r0 + 1, scr, laneq); }
                    continue;
                }
                int mode, bh, qb;
                if (it >= 384 && it < 640) { const int a = it - 384; mode = 0; bh = a & 15; qb = a >> 4; }
                else { const int k = it < 384 ? it : it - 256; const int lvl = k >> 5, w = k & 31; qb = 15 - lvl; mode = (w < 16) ? 1 : 2; bh = w & 15; }
                if (mode == 0) att::unit<0>(l, bh >> 2, bh & 3, qb, lds);
                else if (mode == 1) att::unit<1>(l, bh >> 2, bh & 3, qb, lds);
                else att::unit<2>(l, bh >> 2, bh & 3, qb, lds);
            }
        PHASE_END
        PHASE_BEGIN(REP_P6)
            const cargs_t ap = get_args(); unsigned char* const ws = ap->ws;
            const char* hin = (l == 0) ? WSP(const char, WS_XN) : (const char*)ap->out;
            pg8::GateBranchOrder S{hin, WSP(const char, WS_BR), WSP(const char, WS_WGT), WSP(const char, WS_WBT), (int)gridDim.x, (int)blockIdx.x};
            pg8::EpiGateBranch E{WSP(bf16_t, WS_MIXED), ap->b_gate + (size_t)l * 4096, WSP(const float, WS_ROWSS) + (size_t)(l * 2) * ROWSS_STRIDE, (LAS unsigned*)(lds + 131072 + 1024)};
            pg8::gemm_phase(lds, 1024, 1024, S, E);
        PHASE_END
        PHASE_BEGIN(REP_P7)
            const cargs_t ap = get_args(); unsigned char* const ws = ap->ws;
            pg8::PlainOrder S{WSP(const char, WS_MIXED), WSP(const char, WS_WOT), 1024, 1024, 64, 4, 16, (int)gridDim.x, (int)blockIdx.x};
            if (l == 0) { pg8::EpiRes<true> E{ap->x, WSP(bf16_t, WS_XA), WSP(float, WS_ROWSS) + (size_t)1 * ROWSS_STRIDE};
                pg8::gemm_phase(lds, 1024, 1024, S, E); }
            else { pg8::EpiRes<false> E{ap->out, WSP(bf16_t, WS_XA), WSP(float, WS_ROWSS) + (size_t)3 * ROWSS_STRIDE};
                pg8::gemm_phase(lds, 1024, 1024, S, E); }
        PHASE_END
        PHASE_BEGIN(REP_P9)
            const cargs_t ap = get_args(); unsigned char* const ws = ap->ws;
            pg8::PlainOrder S{WSP(const char, WS_XA), WSP(const char, WS_W1T), 1024, 1024, 64, 16, 16, (int)gridDim.x, (int)blockIdx.x};
            const float* slots = WSP(const float, WS_ROWSS) + (size_t)(l * 2 + 1) * ROWSS_STRIDE;
            pg8::Unit u0; int pm0 = -1; if (S.next(0, u0)) { pm0 = u0.pm; fill_rinv_table(lds, slots, pm0); }
            pg8::EpiBf16<2, 1> E{WSP(bf16_t, WS_H), 4096, slots, pm0, (unsigned)(uintptr_t)(lds + LDS_RINV), nullptr};
            pg8::gemm_phase(lds, 1024, 1024, S, E);
        PHASE_END
        PHASE_BEGIN(REP_P10)
            const cargs_t ap = get_args(); unsigned char* const ws = ap->ws;
            pg8::PlainOrder S{WSP(const char, WS_H), WSP(const char, WS_W2T), 4096, 4096, 64, 4, 64, (int)gridDim.x, (int)blockIdx.x};
            if (l == 0) { pg8::EpiRes<false> E{WSP(const bf16_t, WS_XA), (bf16_t*)ap->out, WSP(float, WS_ROWSS) + (size_t)2 * ROWSS_STRIDE};
                pg8::gemm_phase(lds, 4096, 4096, S, E); }
            else { pg8::EpiFinal E{WSP(const bf16_t, WS_XA), ap->out, WSP(float, WS_ROWSS) + (size_t)4 * ROWSS_STRIDE, ap->g_final, (unsigned*)(ws + WS_CTL) + 8192};
                pg8::gemm_phase(lds, 4096, 4096, S, E); }
        if (l == 0) GRID_BAR(); }
    }
    _Pragma("unroll 1") for (int i = 0; i < REP_SYNC; ++i) GRID_BAR();
}

extern "C" void kernel_launch(void* const* d_in, const int* in_sizes, int n_in, void* d_out, int out_size, void* d_ws, size_t ws_size, hipStream_t stream) {
    static int grid = 0;
    if (grid == 0) {
        if (n_in != 22 || out_size != TOK * DM || ws_size < WS_END) { fprintf(stderr, "kernel_launch: unexpected shapes (n_in %d out %d ws %zu)\n", n_in, out_size, ws_size); grid = -1; return; }
        int dev = 0, cus = 0, per_cu = 0;
        if (hipGetDevice(&dev) != hipSuccess || hipDeviceGetAttribute(&cus, hipDeviceAttributeMultiprocessorCount, dev) != hipSuccess) { grid = -1; return; }
        if (hipFuncSetAttribute((const void*)fwd_megakernel, hipFuncAttributeMaxDynamicSharedMemorySize, LDS_BYTES) != hipSuccess) { fprintf(stderr, "hipFuncSetAttribute failed\n"); grid = -1; return; }
        if (hipOccupancyMaxActiveBlocksPerMultiprocessor(&per_cu, (const void*)fwd_megakernel, 512, LDS_BYTES) != hipSuccess || per_cu < 1) { fprintf(stderr, "occupancy query: %d blocks per CU\n", per_cu); grid = -1; return; }
        grid = cus;
    }
    if (grid < 0) return;
    (void)hipMemsetAsync((char*)d_ws + WS_CTL, 0, 65536, stream);
    Args a{};
    a.x = (const float*)d_in[0]; a.pos = (const int*)d_in[1]; a.g_mix = (const float*)d_in[2]; a.w_in = (const float*)d_in[3]; a.w_gate = (const float*)d_in[4]; a.b_gate = (const float*)d_in[5];
    a.rel_bias = (const float*)d_in[6]; a.g_q_lat = (const float*)d_in[7]; a.w_uq = (const float*)d_in[8]; a.g_kv_lat = (const float*)d_in[9]; a.w_ukv = (const float*)d_in[10];
    a.b_forget = (const float*)d_in[11]; a.w_dw = (const float*)d_in[12]; a.b_dw = (const float*)d_in[13]; a.g_conv_ln = (const float*)d_in[14]; a.b_conv_ln = (const float*)d_in[15];
    a.w_branch = (const float*)d_in[16]; a.w_o = (const float*)d_in[17]; a.g_ffn = (const float*)d_in[18]; a.w_up = (const float*)d_in[19]; a.w_down = (const float*)d_in[20]; a.g_final = (const float*)d_in[21];
    a.out = (float*)d_out; a.ws = (unsigned char*)d_ws;
    void* args[] = {&a};
    hipError_t e = hipLaunchCooperativeKernel((const void*)fwd_megakernel, dim3(grid), dim3(512), args, LDS_BYTES, stream);
    if (e != hipSuccess) fprintf(stderr, "cooperative launch failed: %s (grid %d)\n", hipGetErrorString(e), grid);
}
```

```cpp
#include <hip/hip_runtime.h>
#include <hip/hip_cooperative_groups.h>
#include <cstdio>
#include <cstdint>
namespace cg = cooperative_groups;

#define LAS __attribute__((address_space(3)))
typedef unsigned short bf16_t;
typedef short bf16x8 __attribute__((ext_vector_type(8)));
typedef short s16x4 __attribute__((ext_vector_type(4)));
typedef float f32x4 __attribute__((ext_vector_type(4)));
typedef float f32x16 __attribute__((ext_vector_type(16)));
typedef unsigned u32x4 __attribute__((ext_vector_type(4)));
typedef unsigned u32x2 __attribute__((ext_vector_type(2)));
typedef float f32x2_t __attribute__((ext_vector_type(2)));
typedef __bf16 bf16x2_t __attribute__((ext_vector_type(2)));

constexpr int NB = 4, SEQ = 4096, DM = 1024, TOK = NB * SEQ, DFF = 4096, INC = 2468, PLD = 2560;
constexpr int C_AQ = 0, C_AK = 256, C_AV = 512, C_BQL = 768, C_BKVL = 1024, C_BKR = 1152, C_CQ = 1184, C_CK = 1440, C_CV = 1696, C_CF = 1952, C_DV = 1956, C_DG = 2212;
constexpr float LOG2E = 1.4426950408889634f;
constexpr float EPS = 1e-6f;
constexpr size_t MiB = 1u << 20;
constexpr size_t WS_W1T = 4 * MiB, WS_W2T = 12 * MiB, WS_XN = 20 * MiB, WS_PROJ = 52 * MiB, WS_XA = 52 * MiB, WS_H = 116 * MiB;
constexpr size_t WS_QKVB = 132 * MiB, WS_MIXED = 132 * MiB, WS_BR = 164 * MiB, WS_LAT = 196 * MiB, WS_U = 208 * MiB;
constexpr size_t WS_WINT = 216 * MiB, WS_WGT = 221 * MiB, WS_WLT = 229 * MiB, WS_WBT = 230 * MiB, WS_WOT = 238 * MiB;
constexpr size_t WS_CTL = 244 * MiB, WS_FCUM = 244 * MiB + 256 * 1024, WS_KROT = 245 * MiB, WS_END = 256 * MiB;
constexpr size_t WS_WINT1 = 251 * MiB, WS_WLT1 = 0, WS_LATSS = 1 * MiB;
constexpr size_t WS_ROWSS = 246 * MiB, ROWSS_STRIDE = (size_t)TOK * 16;
constexpr int LDS_RINV = 131072 + 1024 + 16384;
constexpr int LDS_BYTES = LDS_RINV + 1024;

struct Args {
    const float* x; const int* pos; const float* g_mix; const float* w_in; const float* w_gate; const float* b_gate; const float* rel_bias;
    const float* g_q_lat; const float* w_uq; const float* g_kv_lat; const float* w_ukv; const float* b_forget; const float* w_dw; const float* b_dw;
    const float* g_conv_ln; const float* b_conv_ln; const float* w_branch; const float* w_o; const float* g_ffn; const float* w_up; const float* w_down; const float* g_final;
    float* out; unsigned char* ws;
};

typedef const __attribute__((address_space(4))) Args* cargs_t;
__device__ __forceinline__ cargs_t get_args() { cargs_t p = (cargs_t)__builtin_amdgcn_kernarg_segment_ptr(); asm volatile("" : "+s"(p)); return p; }
__device__ __forceinline__ int fresh_tid() { int t = threadIdx.x; asm volatile("" : "+v"(t)); return t; }
__device__ __forceinline__ float bf2f(unsigned short b) { return __uint_as_float((unsigned)b << 16); }
__device__ __forceinline__ unsigned pk2(float lo, float hi) { f32x2_t v = {lo, hi}; bf16x2_t b = __builtin_convertvector(v, bf16x2_t); return __builtin_bit_cast(unsigned, b); }
__device__ __forceinline__ float lo_f(unsigned w) { return __uint_as_float(w << 16); }
__device__ __forceinline__ float hi_f(unsigned w) { return __uint_as_float(w & 0xffff0000u); }
__device__ __forceinline__ float wave_sum(float v) {
#pragma unroll
    for (int o = 1; o < 64; o <<= 1) v += __shfl_xor(v, o);
    return v;
}
__device__ __forceinline__ float sigmoidf_(float x) { return 1.0f / (1.0f + __expf(-x)); }
#define LDS_WAIT() asm volatile("s_waitcnt lgkmcnt(0)" ::: "memory")
__device__ __forceinline__ float row_rinv(const float* slots, int row, int fq) {
    const f32x4 a = *(const f32x4*)(slots + (size_t)row * 16 + 4 * fq);
    float s = (a.x + a.y) + (a.z + a.w);
    s += __shfl_xor(s, 16); s += __shfl_xor(s, 32);
    return __builtin_amdgcn_rsqf(s * (1.0f / 1024.0f) + EPS);
}
__device__ __forceinline__ void fill_rinv_table(LAS unsigned char* lds, const float* slots, int pm) {
    const int t = fresh_tid();
    if (t < 256) { const f32x4* p = (const f32x4*)(slots + (size_t)(pm * 256 + t) * 16); const f32x4 a = p[0], b = p[1], c = p[2], d = p[3];
        const float s = (((a.x + a.y) + (a.z + a.w)) + ((b.x + b.y) + (b.z + b.w))) + (((c.x + c.y) + (c.z + c.w)) + ((d.x + d.y) + (d.z + d.w)));
        ((LAS float*)(lds + LDS_RINV))[t] = __builtin_amdgcn_rsqf(s * (1.0f / 1024.0f) + EPS); }
    __syncthreads();
}
__device__ __forceinline__ float lds_rinv_read(unsigned addr) { float r; asm volatile("ds_read_b32 %0, %1" : "=v"(r) : "v"(addr)); return r; }
namespace pg8 {
constexpr int BM = 256, BK = 64, HALF = 128, HTB = HALF * BK * 2, STAGE_BYTES = 8 * HTB, NXCD = 8, WGM = 8;
__host__ __device__ __forceinline__ int lds_byte(int r, int c) { const int st = (r >> 4) * 2 + (c >> 5), rr = r & 15, cc = c & 31, ob = rr * 64 + cc * 2; return st * 1024 + (ob ^ (((ob >> 9) & 1) << 5)); }
__host__ __device__ __forceinline__ void stage_rc(int b, int& R, int& C) { const int st = b / 1024, sb = b % 1024, swz = sb ^ (((sb >> 9) & 1) << 5); R = (st >> 1) * 16 + swz / 64; C = (st & 1) * 32 + (swz % 64) / 2; }
__host__ __device__ __forceinline__ int perm32(int rho) { const int n = rho >> 4, i = rho & 15; return 8 * (i >> 2) + 4 * n + (i & 3); }

struct Unit { int pm, pn, nt, kind; const char* a; const char* b; };

__device__ __forceinline__ bool tile_of(int L, int nM, int nN, int& pm, int& pn) {
    const int nwg = nM * nN; if (L >= nwg) return false;
    int wgid = L; { const int q = nwg / NXCD, r = nwg % NXCD, xcd = wgid % NXCD, off = wgid / NXCD; wgid = (xcd < r ? xcd * (q + 1) : r * (q + 1) + (xcd - r) * q) + off; }
    const int nig = WGM * nN, gid = wgid / nig, fm = gid * WGM, gsz = (nM - fm) < WGM ? (nM - fm) : WGM;
    pm = fm + ((wgid % nig) % gsz); pn = (wgid % nig) / gsz; return true;
}
struct PlainOrder {
    const char* A; const char* Bt; int lda, ldb, nM, nN, nt, G, c;
    __device__ __forceinline__ bool next(int i, Unit& u) const {
        int pm, pn; if (!tile_of(i * G + c, nM, nN, pm, pn)) return false;
        u.pm = pm; u.pn = pn; u.nt = nt; u.kind = 0; u.a = A + (size_t)pm * 256 * lda * 2; u.b = Bt + (size_t)pn * 256 * ldb * 2; return true;
    }
};
struct GateBranchOrder {
    const char* XN; const char* BR; const char* WgT; const char* WbT; int G, c;
    __device__ __forceinline__ bool next(int i, Unit& u) const {
        const int gi = i >> 3, j = i & 7; int pm, pd; if (!tile_of(gi * G + c, 64, 4, pm, pd)) return false;
        const int n = j >> 1, kind = j & 1; u.pm = pm; u.pn = n * 4 + pd; u.kind = kind;
        if (kind == 0) { u.nt = 16; u.a = XN + (size_t)pm * 256 * 1024 * 2; u.b = WgT + (size_t)u.pn * 256 * 1024 * 2; }
        else { u.nt = 4; u.a = BR + ((size_t)pm * 256 * 1024 + n * 256) * 2; u.b = WbT + ((size_t)u.pn * 256 * 1024 + n * 256) * 2; }
        return true;
    }
};

template <int ACT  , int RS  , bool LATSS = false  > struct EpiBf16 {
    static constexpr bool PERM = true; struct State {};
    bf16_t* O; int ldc; const float* rowss; int pm_tab; unsigned tab; float* latss;
    __device__ __forceinline__ void operator()(const f32x4 (&acc)[2][2][4][2], State&, const Unit& u, int wr, int wc, int fr, int fq) const {
        asm volatile("" : "+v"(fr), "+v"(fq));
        const int row0 = u.pm * BM + wr * 64 + fr, col0 = u.pn * BM + wc * 32 + 8 * fq;
        float rv[2][4];
        if (RS == 1) {
            if (u.pm == pm_tab) {
#pragma unroll
                for (int ai = 0; ai < 2; ++ai)
#pragma unroll
                    for (int m = 0; m < 4; ++m) rv[ai][m] = lds_rinv_read(tab + (unsigned)(wr * 64 + fr + ai * HALF + m * 16) * 4u);
                asm volatile("s_waitcnt lgkmcnt(0)" : "+v"(rv[0][0]), "+v"(rv[0][1]), "+v"(rv[0][2]), "+v"(rv[0][3]), "+v"(rv[1][0]), "+v"(rv[1][1]), "+v"(rv[1][2]), "+v"(rv[1][3]));
            } else {
#pragma unroll
                for (int ai = 0; ai < 2; ++ai)
#pragma unroll
                    for (int m = 0; m < 4; ++m) rv[ai][m] = row_rinv(rowss, row0 + ai * HALF + m * 16, fq);
            }
        }
#pragma unroll
        for (int ai = 0; ai < 2; ++ai)
#pragma unroll
            for (int m = 0; m < 4; ++m) { bf16_t* rowp = O + (size_t)(row0 + ai * HALF + m * 16) * ldc + col0;
                float rinv = 1.f; if (RS == 1) rinv = rv[ai][m];
                if (RS == 2) { const f32x4 a = *(const f32x4*)(latss + (size_t)(row0 + ai * HALF + m * 16) * 8 + (u.pn >= 2 ? 4 : 0));
                    rinv = __builtin_amdgcn_rsqf(((a.x + a.y) + (a.z + a.w)) * (u.pn >= 2 ? (1.0f / 128.0f) : (1.0f / 256.0f)) + EPS); }
                float lss = 0.f;
#pragma unroll
                for (int bj = 0; bj < 2; ++bj) { f32x4 v0 = acc[ai][bj][m][0], v1 = acc[ai][bj][m][1];
                    if (RS) { v0 = v0 * rinv; v1 = v1 * rinv; }
                    if (LATSS) { if (bj == 0 || u.pn == 3) lss += ((v0.x * v0.x + v0.y * v0.y) + (v0.z * v0.z + v0.w * v0.w)) + ((v1.x * v1.x + v1.y * v1.y) + (v1.z * v1.z + v1.w * v1.w)); }
                    if (ACT == 2) {
#pragma unroll
                        for (int e = 0; e < 4; ++e) { const float a0 = fmaxf(v0[e], 0.f), a1 = fmaxf(v1[e], 0.f); v0[e] = a0 * a0; v1[e] = a1 * a1; } }
                    u32x4 w; w.x = pk2(v0[0], v0[1]); w.y = pk2(v0[2], v0[3]); w.z = pk2(v1[0], v1[1]); w.w = pk2(v1[2], v1[3]);
                    *(u32x4*)(rowp + bj * HALF) = w; }
                if (LATSS) { if (u.pn == 3 || u.pn == 4) { lss += __shfl_xor(lss, 16); lss += __shfl_xor(lss, 32);
                    if (fq == 0) latss[(size_t)(row0 + ai * HALF + m * 16) * 8 + (u.pn == 4 ? 4 : 0) + wc] = lss; } } }
    }
};
template <bool BASEF32> struct EpiRes {
    static constexpr bool PERM = true; struct State {};
    const void* base; bf16_t* out; float* rowss;
    __device__ __forceinline__ void operator()(const f32x4 (&acc)[2][2][4][2], State&, const Unit& u, int wr, int wc, int fr, int fq) const {
        asm volatile("" : "+v"(fr), "+v"(fq));
        const int row0 = u.pm * BM + wr * 64 + fr, col0 = u.pn * BM + wc * 32 + 8 * fq;
#pragma unroll
        for (int ai = 0; ai < 2; ++ai) {
            f32x4 bs[4][2][2];
#pragma unroll
            for (int m = 0; m < 4; ++m) { const size_t off = (size_t)(row0 + ai * HALF + m * 16) * 1024 + col0;
#pragma unroll
                for (int bj = 0; bj < 2; ++bj) {
                    if (BASEF32) { bs[m][bj][0] = *(const f32x4*)((const float*)base + off + bj * HALF); bs[m][bj][1] = *(const f32x4*)((const float*)base + off + bj * HALF + 4); }
                    else { const u32x4 w = *(const u32x4*)((const bf16_t*)base + off + bj * HALF);
                        bs[m][bj][0] = (f32x4){lo_f(w.x), hi_f(w.x), lo_f(w.y), hi_f(w.y)}; bs[m][bj][1] = (f32x4){lo_f(w.z), hi_f(w.z), lo_f(w.w), hi_f(w.w)}; } } }
            asm volatile("" ::: "memory");
#pragma unroll
            for (int m = 0; m < 4; ++m) { const int row = row0 + ai * HALF + m * 16; const size_t off = (size_t)row * 1024 + col0; float ss = 0.f;
#pragma unroll
                for (int bj = 0; bj < 2; ++bj) { const f32x4 v0 = bs[m][bj][0] + acc[ai][bj][m][0], v1 = bs[m][bj][1] + acc[ai][bj][m][1];
                    u32x4 w; w.x = pk2(v0[0], v0[1]); w.y = pk2(v0[2], v0[3]); w.z = pk2(v1[0], v1[1]); w.w = pk2(v1[2], v1[3]); *(u32x4*)(out + off + bj * HALF) = w;
                    ss += ((v0.x * v0.x + v0.y * v0.y) + (v0.z * v0.z + v0.w * v0.w)) + ((v1.x * v1.x + v1.y * v1.y) + (v1.z * v1.z + v1.w * v1.w)); }
                ss += __shfl_xor(ss, 16); ss += __shfl_xor(ss, 32); if (fq == 0) rowss[(size_t)row * 16 + u.pn * 4 + wc] = ss; }
            asm volatile("" ::: "memory");
        }
    }
};
struct EpiFinal {
    static constexpr bool PERM = true; struct State {};
    const bf16_t* base; float* out; float* rowss; const float* g; unsigned* cnt;
    __device__ __forceinline__ void operator()(const f32x4 (&acc_)[2][2][4][2], State&, const Unit& u, int wr, int wc, int fr, int fq) const {
        asm volatile("" : "+v"(fr), "+v"(fq));
        f32x4 (&acc)[2][2][4][2] = const_cast<f32x4 (&)[2][2][4][2]>(acc_);
        const int row0 = u.pm * BM + wr * 64 + fr, col0 = u.pn * BM + wc * 32 + 8 * fq;
#pragma unroll
        for (int ai = 0; ai < 2; ++ai) {
            u32x4 bs[4][2];
#pragma unroll
            for (int m = 0; m < 4; ++m) { const size_t off = (size_t)(row0 + ai * HALF + m * 16) * 1024 + col0;
#pragma unroll
                for (int bj = 0; bj < 2; ++bj) bs[m][bj] = *(const u32x4*)(base + off + bj * HALF); }
            asm volatile("" ::: "memory");
#pragma unroll
            for (int m = 0; m < 4; ++m) { const int row = row0 + ai * HALF + m * 16; float ss = 0.f;
#pragma unroll
                for (int bj = 0; bj < 2; ++bj) { const u32x4 w = bs[m][bj];
                    const f32x4 v0 = acc[ai][bj][m][0] + (f32x4){lo_f(w.x), hi_f(w.x), lo_f(w.y), hi_f(w.y)}, v1 = acc[ai][bj][m][1] + (f32x4){lo_f(w.z), hi_f(w.z), lo_f(w.w), hi_f(w.w)};
                    acc[ai][bj][m][0] = v0; acc[ai][bj][m][1] = v1;
                    ss += ((v0.x * v0.x + v0.y * v0.y) + (v0.z * v0.z + v0.w * v0.w)) + ((v1.x * v1.x + v1.y * v1.y) + (v1.z * v1.z + v1.w * v1.w)); }
                ss += __shfl_xor(ss, 16); ss += __shfl_xor(ss, 32); if (fq == 0) rowss[(size_t)row * 16 + u.pn * 4 + wc] = ss; }
        }
        asm volatile("s_waitcnt vmcnt(0)" ::: "memory"); __builtin_amdgcn_s_barrier(); asm volatile("" ::: "memory");
        if (threadIdx.x == 0) {
            __builtin_amdgcn_fence(__ATOMIC_RELEASE, "agent"); asm volatile("s_waitcnt vmcnt(0)" ::: "memory");
            unsigned* c = cnt + 64 * u.pm;
            (void)__hip_atomic_fetch_add(c, 1u, __ATOMIC_RELAXED, __HIP_MEMORY_SCOPE_AGENT);
            unsigned sp = 0;
            while (__hip_atomic_load(c, __ATOMIC_RELAXED, __HIP_MEMORY_SCOPE_AGENT) < 4u) { __builtin_amdgcn_s_sleep(1); if (++sp > (1u << 16)) break; }
            __builtin_amdgcn_fence(__ATOMIC_ACQUIRE, "agent"); asm volatile("s_waitcnt vmcnt(0)" ::: "memory");
        }
        asm volatile("" ::: "memory"); __builtin_amdgcn_s_barrier(); asm volatile("" ::: "memory");
        f32x4 gv[2][2];
#pragma unroll
        for (int bj = 0; bj < 2; ++bj)
#pragma unroll
            for (int q = 0; q < 2; ++q) gv[bj][q] = *(const f32x4*)(g + col0 + bj * HALF + 4 * q);
#pragma unroll
        for (int ai = 0; ai < 2; ++ai)
#pragma unroll
            for (int m = 0; m < 4; ++m) { const int row = row0 + ai * HALF + m * 16; const float rinv = row_rinv(rowss, row, fq); float* op = out + (size_t)row * 1024 + col0;
#pragma unroll
                for (int bj = 0; bj < 2; ++bj) { *(f32x4*)(op + bj * HALF) = acc[ai][bj][m][0] * rinv * gv[bj][0]; *(f32x4*)(op + bj * HALF + 4) = acc[ai][bj][m][1] * rinv * gv[bj][1]; } }
    }
};
struct EpiGateBranch {
    static constexpr bool PERM = true;
    struct State { unsigned g8[2][2][4][2]; };
    bf16_t* mixed; const float* bgate; const float* rowss; LAS unsigned* glds;
    __device__ __forceinline__ void operator()(const f32x4 (&acc)[2][2][4][2], State& st, const Unit& u, int wr, int wc, int fr, int fq) const {
        asm volatile("" : "+v"(fr), "+v"(fq));
        const int rl0 = wr * 64 + fr, cl0 = wc * 32 + 8 * fq, n = u.pn >> 2, pd = u.pn & 3;
        LAS unsigned* gl = glds + (wr * 4 + wc) * 512 + (fq * 16 + fr) * 8;
        if (u.kind == 0) {
            f32x4 bv[2][2];
#pragma unroll
            for (int bj = 0; bj < 2; ++bj)
#pragma unroll
                for (int q = 0; q < 2; ++q) bv[bj][q] = *(const f32x4*)(bgate + u.pn * BM + cl0 + bj * HALF + 4 * q);
#pragma unroll
            for (int ai = 0; ai < 2; ++ai)
#pragma unroll
                for (int m = 0; m < 4; ++m) {
                    const float rinv = row_rinv(rowss, u.pm * BM + rl0 + ai * HALF + m * 16, fq);
#pragma unroll
                    for (int bj = 0; bj < 2; ++bj)
#pragma unroll
                        for (int q = 0; q < 2; ++q) { const f32x4 v = acc[ai][bj][m][q] * rinv + bv[bj][q]; unsigned w = 0u;
#pragma unroll
                            for (int e = 0; e < 4; ++e) w |= (unsigned)(sigmoidf_(v[e]) * 255.0f + 0.5f) << (8 * e);
                            if (ai == 1 && bj == 1) gl[m * 2 + q] = w; else st.g8[ai][bj][m][q] = w; } }
        } else {
#pragma unroll
            for (int ai = 0; ai < 2; ++ai) {
                u32x4 oo[4][2];
#pragma unroll
                for (int m = 0; m < 4; ++m) { const int rl = rl0 + ai * HALF + m * 16; const bf16_t* mp = mixed + (size_t)(u.pm * BM + rl) * 1024 + pd * 256 + cl0;
#pragma unroll
                    for (int bj = 0; bj < 2; ++bj) { oo[m][bj] = (u32x4){0u, 0u, 0u, 0u}; if (n > 0) oo[m][bj] = *(const u32x4*)(mp + bj * HALF); } }
                asm volatile("" ::: "memory");
#pragma unroll
                for (int m = 0; m < 4; ++m) { const int rl = rl0 + ai * HALF + m * 16; bf16_t* mp = mixed + (size_t)(u.pm * BM + rl) * 1024 + pd * 256 + cl0;
#pragma unroll
                    for (int bj = 0; bj < 2; ++bj) { const unsigned g0 = (ai == 1 && bj == 1) ? gl[m * 2] : st.g8[ai][bj][m][0], g1 = (ai == 1 && bj == 1) ? gl[m * 2 + 1] : st.g8[ai][bj][m][1]; const u32x4 o = oo[m][bj]; const f32x4 a0 = acc[ai][bj][m][0] * (1.0f / 255.0f), a1 = acc[ai][bj][m][1] * (1.0f / 255.0f);
                        float v[8];
                        v[0] = fmaf(a0[0], (float)(g0 & 255u), lo_f(o.x)); v[1] = fmaf(a0[1], (float)((g0 >> 8) & 255u), hi_f(o.x)); v[2] = fmaf(a0[2], (float)((g0 >> 16) & 255u), lo_f(o.y)); v[3] = fmaf(a0[3], (float)(g0 >> 24), hi_f(o.y));
                        v[4] = fmaf(a1[0], (float)(g1 & 255u), lo_f(o.z)); v[5] = fmaf(a1[1], (float)((g1 >> 8) & 255u), hi_f(o.z)); v[6] = fmaf(a1[2], (float)((g1 >> 16) & 255u), lo_f(o.w)); v[7] = fmaf(a1[3], (float)(g1 >> 24), hi_f(o.w));
                        u32x4 w; w.x = pk2(v[0], v[1]); w.y = pk2(v[2], v[3]); w.z = pk2(v[4], v[5]); w.w = pk2(v[6], v[7]);
                        *(u32x4*)(mp + bj * HALF) = w; } }
                asm volatile("" ::: "memory");
            }
        }
    }
};

template <class Epi, class Sched>
__device__ __forceinline__ void gemm_phase(LAS unsigned char* lds, const int lda, const int ldb, const Sched& S, const Epi& E) {
    const int tid = fresh_tid(), wid = __builtin_amdgcn_readfirstlane(tid >> 6), lane = tid & 63, wr = wid >> 2, wc = wid & 3, fr = lane & 15, fq = lane >> 4;
    unsigned voffA[2], voffB[2];
#pragma unroll
    for (int i = 0; i < 2; ++i) { int R, C; stage_rc(tid * 16 + i * 8192, R, C); const int Rb = Epi::PERM ? ((R & ~31) + perm32(R & 31)) : R;
        voffA[i] = (unsigned)(R * lda + C) * 2u; voffB[i] = (unsigned)(Rb * ldb + C) * 2u; }
    const size_t kstep = (size_t)(BK * 2);
    const size_t hstepA = (size_t)HALF * lda * 2, hstepB = (size_t)HALF * ldb * 2;
    const unsigned ldsw = (unsigned)wid * 1024u;
    const int aoff = lds_byte(wr * 64 + fr, fq * 8), boff = lds_byte(wc * 32 + fr, fq * 8);
#define PG8_SA(b, h) (((b) * 2 + (h)) * HTB)
#define PG8_SB(b, h) ((4 + (b) * 2 + (h)) * HTB)
#define PG8_STAGE(bufoff, gbase, voff) do { _Pragma("unroll") for (int _i = 0; _i < 2; ++_i) \
        __builtin_amdgcn_global_load_lds((const unsigned*)((const char*)(gbase) + (voff)[_i]), (LAS unsigned*)(lds + (bufoff) + ldsw + _i * 8192), 16, 0, 0); } while (0)
#define PG8_LDA(dst, b, h) do { _Pragma("unroll") for (int m = 0; m < 4; ++m) _Pragma("unroll") for (int k = 0; k < 2; ++k) dst[m][k] = *(const LAS bf16x8*)(lds + PG8_SA(b, h) + aoff + m * 2048 + k * 1024); } while (0)
#define PG8_LDB(dst, b, h) do { _Pragma("unroll") for (int n = 0; n < 2; ++n) _Pragma("unroll") for (int k = 0; k < 2; ++k) dst[n][k] = *(const LAS bf16x8*)(lds + PG8_SB(b, h) + boff + n * 2048 + k * 1024); } while (0)
#define PG8_MMA(ai, bj, At, Bt) do { __builtin_amdgcn_s_setprio(1); _Pragma("unroll") for (int m = 0; m < 4; ++m) _Pragma("unroll") for (int n = 0; n < 2; ++n) _Pragma("unroll") for (int k = 0; k < 2; ++k) \
        acc[ai][bj][m][n] = __builtin_amdgcn_mfma_f32_16x16x32_bf16(Bt[n][k], At[m][k], acc[ai][bj][m][n], 0, 0, 0); __builtin_amdgcn_s_setprio(0); } while (0)
#define PG8_WAIT_V(n) asm volatile("s_waitcnt vmcnt(" #n ")" ::: "memory")
#define PG8_WAIT_L(n) asm volatile("s_waitcnt lgkmcnt(" #n ")" ::: "memory")
#define PG8_BAR __builtin_amdgcn_s_barrier()
#define PG8_SCHED __builtin_amdgcn_sched_barrier(0)
    Unit cur, nxt; int ui = 0;
    if (!S.next(0, cur)) return;
    f32x4 acc[2][2][4][2];
#pragma unroll
    for (int a = 0; a < 2; ++a)
#pragma unroll
        for (int b = 0; b < 2; ++b)
#pragma unroll
            for (int m = 0; m < 4; ++m)
#pragma unroll
                for (int n = 0; n < 2; ++n) acc[a][b][m][n] = (f32x4){0.f, 0.f, 0.f, 0.f};
    bf16x8 At[4][2], B0[2][2], B1[2][2];
    typename Epi::State est;
    const char* cA = cur.a; const char* cB = cur.b;
    PG8_STAGE(PG8_SB(0, 0), cB, voffB); PG8_STAGE(PG8_SB(0, 1), cB + hstepB, voffB); PG8_STAGE(PG8_SA(0, 0), cA, voffA); PG8_STAGE(PG8_SA(0, 1), cA + hstepA, voffA);
    if (wr == 1) PG8_BAR;
    PG8_WAIT_V(2); PG8_BAR;
    PG8_STAGE(PG8_SB(1, 0), cB + kstep, voffB); PG8_STAGE(PG8_SA(1, 0), cA + kstep, voffA); PG8_STAGE(PG8_SB(1, 1), cB + hstepB + kstep, voffB);
    PG8_WAIT_V(6); PG8_BAR;
    for (;;) {
        const bool has_next = S.next(ui + 1, nxt);
        const char* nA = has_next ? nxt.a : cA; const char* nB = has_next ? nxt.b : cB;
        const int nt = cur.nt;
        for (int t = 0; t < nt; t += 2) {
            const bool last = (t == nt - 2);
            const char* a1 = cA + (size_t)(t + 1) * kstep;
            const char* a2 = last ? nA : cA + (size_t)(t + 2) * kstep; const char* b2 = last ? nB : cB + (size_t)(t + 2) * kstep;
            const char* a3 = a2 + kstep; const char* b3 = b2 + kstep;
            PG8_LDB(B0, 0, 0); PG8_LDB(B1, 0, 1); PG8_SCHED; PG8_LDA(At, 0, 0); PG8_STAGE(PG8_SA(1, 1), a1 + hstepA, voffA);
            PG8_WAIT_V(8); PG8_WAIT_L(0); PG8_BAR; PG8_MMA(0, 0, At, B0); PG8_MMA(0, 1, At, B1); PG8_BAR; PG8_SCHED;
            PG8_LDA(At, 0, 1); PG8_STAGE(PG8_SB(0, 0), b2, voffB); PG8_STAGE(PG8_SB(0, 1), b2 + hstepB, voffB); PG8_STAGE(PG8_SA(0, 0), a2, voffA);
            PG8_WAIT_V(8); PG8_WAIT_L(0); PG8_BAR; PG8_MMA(1, 0, At, B0); PG8_MMA(1, 1, At, B1); PG8_BAR; PG8_SCHED;
            PG8_LDB(B0, 1, 0); PG8_LDB(B1, 1, 1); PG8_SCHED; PG8_LDA(At, 1, 0); PG8_STAGE(PG8_SA(0, 1), a2 + hstepA, voffA);
            PG8_WAIT_V(8); PG8_WAIT_L(0); PG8_BAR; PG8_MMA(0, 0, At, B0); PG8_MMA(0, 1, At, B1); PG8_BAR; PG8_SCHED;
            PG8_LDA(At, 1, 1); PG8_STAGE(PG8_SB(1, 0), b3, voffB); PG8_STAGE(PG8_SB(1, 1), b3 + hstepB, voffB); PG8_STAGE(PG8_SA(1, 0), a3, voffA);
            PG8_WAIT_V(8); PG8_WAIT_L(0); PG8_BAR; PG8_MMA(1, 0, At, B0); PG8_MMA(1, 1, At, B1); PG8_BAR; PG8_SCHED;
        }
        if (wr == 0) PG8_BAR;
        E(acc, est, cur, wr, wc, fr, fq);
        if (!has_next) break;
#pragma unroll
        for (int a = 0; a < 2; ++a)
#pragma unroll
            for (int b = 0; b < 2; ++b)
#pragma unroll
                for (int m = 0; m < 4; ++m)
#pragma unroll
                    for (int n = 0; n < 2; ++n) acc[a][b][m][n] = (f32x4){0.f, 0.f, 0.f, 0.f};
        cur = nxt; cA = nA; cB = nB; ++ui;
        if (wr == 1) PG8_BAR;
    }
    PG8_WAIT_V(0);
    PG8_BAR;
#undef PG8_SA
#undef PG8_SB
#undef PG8_STAGE
#undef PG8_LDA
#undef PG8_LDB
#undef PG8_MMA
#undef PG8_WAIT_V
#undef PG8_WAIT_L
#undef PG8_BAR
#undef PG8_SCHED
}
}

namespace att {
constexpr int VP = 144;
typedef short v4i16_t __attribute__((ext_vector_type(4)));
__device__ __forceinline__ int crow(int i, int h) { return (i & 3) + 8 * (i >> 2) + 4 * h; }
__device__ __forceinline__ s16x4 vtr(const LAS unsigned char* p) { return __builtin_bit_cast(s16x4, __builtin_amdgcn_ds_read_tr16_b64_v4i16((LAS v4i16_t*)p)); }
#define MFMA32(a, b, c) __builtin_amdgcn_mfma_f32_32x32x16_bf16((a), (b), (c), 0, 0, 0)

template <int MODE>
__device__ __forceinline__ void unit(int layer, int b, int h, int qb, LAS unsigned char* lds) {
    const cargs_t ap = get_args();
    unsigned char* const ws_ = ap->ws;
    constexpr int DK = MODE == 1 ? 96 : 64, ND = DK / 16, KP = DK * 2 + 16, KBUF = 64 * KP, VBUF = 64 * VP;
    LAS unsigned char* Ks = lds; LAS unsigned char* Vs = lds + 2 * KBUF;
    LAS float* Fs = (LAS float*)(lds + 2 * KBUF + 2 * VBUF); LAS float* Tab = Fs + 128;
    const int tid = fresh_tid(), lane = tid & 63, wid = __builtin_amdgcn_readfirstlane(tid >> 6), r = lane & 31, hh = lane >> 5;
    const size_t tok0 = (size_t)b * SEQ;
    const int qw = qb * 256 + wid * 32, qc = qw >> 6;
    const bf16_t* PROJ = (const bf16_t*)(ws_ + WS_PROJ); const bf16_t* QKVB = (const bf16_t*)(ws_ + WS_QKVB); const bf16_t* KROT = (const bf16_t*)(ws_ + WS_KROT);
    const float* FCUM = (const float*)(ws_ + WS_FCUM) + (size_t)(b * 4 + h) * SEQ;
    bf16_t* BR = (bf16_t*)(ws_ + WS_BR);
    const bf16_t *Qp, *Kp, *Vp; int ldq, ldk;
    if (MODE == 0) { Qp = PROJ + C_AQ + h * 64; Kp = PROJ + C_AK + h * 64; Vp = PROJ + C_AV + h * 64; ldq = PLD; ldk = PLD; }
    else if (MODE == 2) { Qp = PROJ + C_CQ + h * 64; Kp = PROJ + C_CK + h * 64; Vp = PROJ + C_CV + h * 64; ldq = PLD; ldk = PLD; }
    else { Qp = QKVB + h * 96; Kp = QKVB + 512 + h * 128; Vp = Kp + 64; ldq = 1024; ldk = 1024; }
    const int t_lo = (MODE == 0) ? (qb * 4 - 8 > 0 ? qb * 4 - 8 : 0) : 0, t_hi = qb * 4 + 4;
    const float cs = (MODE == 1 ? 0.10206207261596577f : 0.125f) * LOG2E;

    u32x4 kregA, vregA, kr2A, kregB, vregB, kr2B; float fregA = 0.f, fregB = 0.f;
    const int srow = tid >> 3, sch = tid & 7;
#define ATT_LOAD(j, X) do { const int jl_ = (j) < t_lo ? t_lo : (j); const size_t trow = tok0 + (size_t)jl_ * 64; \
        kreg##X = *(const u32x4*)(Kp + (trow + srow) * ldk + sch * 8); vreg##X = *(const u32x4*)(Vp + (trow + srow) * ldk + sch * 8); \
        if (MODE == 1) { kr2##X = *(const u32x4*)(KROT + (trow + ((tid >> 2) & 63)) * 32 + (tid & 3) * 8); } \
        if (MODE == 2) { freg##X = FCUM[jl_ * 64 + (tid & 63)]; } } while (0)
#define ATT_STORE(s, X) do { *(LAS u32x4*)(Ks + (s) * KBUF + srow * KP + sch * 16) = kreg##X; *(LAS u32x4*)(Vs + (s) * VBUF + srow * VP + sch * 16) = vreg##X; \
        if (MODE == 1) { if (tid < 256) *(LAS u32x4*)(Ks + (s) * KBUF + (tid >> 2) * KP + 128 + (tid & 3) * 16) = kr2##X; } \
        if (MODE == 2) { if (tid < 64) Fs[(s) * 64 + tid] = freg##X * LOG2E; } } while (0)

    ATT_LOAD(t_hi - 1, A);
    ATT_LOAD(t_hi - 2, B);
    if (MODE == 0) { if (tid < 257) Tab[tid] = ap->rel_bias[(size_t)(layer * 4 + h) * 257 + tid] * LOG2E; }
    bf16x8 qf[ND];
    { const bf16_t* qrow = Qp + (tok0 + qw + r) * ldq;
#pragma unroll
      for (int d0 = 0; d0 < ND; ++d0) qf[d0] = *(const bf16x8*)(qrow + d0 * 16 + hh * 8); }
    if (MODE == 1) {
        const float pos = (float)ap->pos[tok0 + qw + r];
#pragma unroll
        for (int j = 0; j < 8; ++j) {
            const float invf = exp2f(-(float)(8 * hh + j) * 0.8304820237218406f);
            const float ang = pos * invf, kk = rintf(ang * 0.15915494309189535f);
            float rem = fmaf(-kk, 6.2831854820251465f, ang); rem = fmaf(kk, 1.7484555e-7f, rem);
            const float sn = __sinf(rem), cn = __cosf(rem);
            const float x1 = bf2f((unsigned short)qf[4][j]), x2 = bf2f((unsigned short)qf[5][j]);
            const unsigned w = pk2(x1 * cn - x2 * sn, x2 * cn + x1 * sn);
            qf[4][j] = (short)(w & 0xffffu); qf[5][j] = (short)(w >> 16);
        }
    }
    float fq = 0.f;
    if (MODE == 2) fq = FCUM[qw + r] * LOG2E;
    float m_run = -INFINITY, l_run = 0.f;
    f32x16 o0, o1;
#pragma unroll
    for (int i = 0; i < 16; ++i) { o0[i] = 0.f; o1[i] = 0.f; }
    ATT_STORE(0, A);
    __syncthreads();
    const int i16 = lane & 15, vq = i16 >> 2, vp = i16 & 3, vblk = (lane >> 4) & 1;
    const int voff = (4 * hh + vq) * VP + vblk * 32 + vp * 8;

    auto compute = [&](const int j, const int s) __attribute__((always_inline)) {
        const bool active = (MODE == 0) ? (j <= qc && j >= qc - 8) : (j <= qc);
        if (active) {
            const LAS unsigned char* kb = Ks + s * KBUF + r * KP + hh * 16;
            f32x16 p0, p1;
#pragma unroll
            for (int i = 0; i < 16; ++i) { p0[i] = 0.f; p1[i] = 0.f; }
#pragma unroll
            for (int d0 = 0; d0 < ND; ++d0) {
                const bf16x8 kf0 = *(const LAS bf16x8*)(kb + d0 * 32), kf1 = *(const LAS bf16x8*)(kb + 32 * KP + d0 * 32);
                p0 = MFMA32(kf0, qf[d0], p0); p1 = MFMA32(kf1, qf[d0], p1);
            }
            if (MODE == 0) {
                const int delta = qc - j;
                if (delta >= 3) { const float cb = Tab[256];
#pragma unroll
                    for (int i = 0; i < 16; ++i) { p0[i] = fmaf(p0[i], cs, cb); p1[i] = fmaf(p1[i], cs, cb); }
                } else { const int brel = 64 * delta + (qw & 63) + r + 128;
#pragma unroll
                    for (int i = 0; i < 16; ++i) { const int kj = crow(i, hh); int i0 = brel - kj, i1 = brel - kj - 32;
                        i0 = i0 < 0 ? 0 : (i0 > 256 ? 256 : i0); i1 = i1 < 0 ? 0 : (i1 > 256 ? 256 : i1);
                        p0[i] = fmaf(p0[i], cs, Tab[i0]); p1[i] = fmaf(p1[i], cs, Tab[i1]); }
                }
            } else if (MODE == 1) {
#pragma unroll
                for (int i = 0; i < 16; ++i) { p0[i] *= cs; p1[i] *= cs; }
            } else {
                const LAS float* fs = Fs + s * 64 + 4 * hh;
#pragma unroll
                for (int g = 0; g < 4; ++g) { const f32x4 f0 = *(const LAS f32x4*)(fs + 8 * g), f1 = *(const LAS f32x4*)(fs + 32 + 8 * g);
#pragma unroll
                    for (int e = 0; e < 4; ++e) { p0[4 * g + e] = fmaf(p0[4 * g + e], cs, fq - f0[e]); p1[4 * g + e] = fmaf(p1[4 * g + e], cs, fq - f1[e]); } }
                if (j == qc) { const int qrel = (qw & 63) + r;
#pragma unroll
                    for (int i = 0; i < 16; ++i) { const int kj = crow(i, hh); if (kj > qrel) p0[i] = -INFINITY; if (kj + 32 > qrel) p1[i] = -INFINITY; } }
            }
            float mx = p0[0];
#pragma unroll
            for (int i = 1; i < 16; ++i) mx = fmaxf(mx, p0[i]);
#pragma unroll
            for (int i = 0; i < 16; ++i) mx = fmaxf(mx, p1[i]);
            { auto rr = __builtin_amdgcn_permlane32_swap(__float_as_uint(mx), __float_as_uint(mx), false, false); mx = fmaxf(__uint_as_float(rr[0]), __uint_as_float(rr[1])); }
            if (__all(mx < m_run - 40.f)) return;
            if (__any(mx > m_run)) {
                const float m_new = fmaxf(m_run, mx);
                const float alpha = __builtin_amdgcn_exp2f(m_run - m_new);
                m_run = m_new; l_run *= alpha;
#pragma unroll
                for (int i = 0; i < 16; ++i) { o0[i] *= alpha; o1[i] *= alpha; }
            }
            float sum = 0.f;
#pragma unroll
            for (int i = 0; i < 16; ++i) { p0[i] = __builtin_amdgcn_exp2f(p0[i] - m_run); p1[i] = __builtin_amdgcn_exp2f(p1[i] - m_run); sum += p0[i] + p1[i]; }
            l_run += sum;
            const LAS unsigned char* vb = Vs + s * VBUF + voff;
#pragma unroll
            for (int kbk = 0; kbk < 2; ++kbk)
#pragma unroll
                for (int st = 0; st < 2; ++st) {
                    const f32x16& pp = kbk ? p1 : p0;
                    u32x4 pw; pw.x = pk2(pp[8 * st + 0], pp[8 * st + 1]); pw.y = pk2(pp[8 * st + 2], pp[8 * st + 3]); pw.z = pk2(pp[8 * st + 4], pp[8 * st + 5]); pw.w = pk2(pp[8 * st + 6], pp[8 * st + 7]);
                    const bf16x8 pf = __builtin_bit_cast(bf16x8, pw);
                    const LAS unsigned char* vr = vb + (32 * kbk + 16 * st) * VP;
                    const s16x4 a_lo = vtr(vr), a_hi = vtr(vr + 8 * VP), b_lo = vtr(vr + 64), b_hi = vtr(vr + 8 * VP + 64);
                    const bf16x8 v0 = __builtin_shufflevector(a_lo, a_hi, 0, 1, 2, 3, 4, 5, 6, 7), v1 = __builtin_shufflevector(b_lo, b_hi, 0, 1, 2, 3, 4, 5, 6, 7);
                    o0 = MFMA32(v0, pf, o0); o1 = MFMA32(v1, pf, o1);
                }
        }
    };
    for (int j = t_hi - 1; j >= t_lo; j -= 2) {
        ATT_LOAD(j - 2, A);
        compute(j, 0);
        ATT_STORE(1, B);
        __syncthreads();
        ATT_LOAD(j - 3, B);
        compute(j - 1, 1);
        ATT_STORE(0, A);
        __syncthreads();
    }
    const float l_tot = l_run + __shfl_xor(l_run, 32);
    const float inv = 1.0f / l_tot;
    bf16_t* dst = BR + (tok0 + qw + r) * 1024 + (MODE == 0 ? 0 : (MODE == 1 ? 256 : 512)) + h * 64 + 4 * hh;
#pragma unroll
    for (int g = 0; g < 4; ++g) {
        u32x2 w0, w1;
        w0.x = pk2(o0[4 * g] * inv, o0[4 * g + 1] * inv); w0.y = pk2(o0[4 * g + 2] * inv, o0[4 * g + 3] * inv);
        w1.x = pk2(o1[4 * g] * inv, o1[4 * g + 1] * inv); w1.y = pk2(o1[4 * g + 2] * inv, o1[4 * g + 3] * inv);
        *(u32x2*)(dst + 8 * g) = w0; *(u32x2*)(dst + 32 + 8 * g) = w1;
    }
#undef ATT_LOAD
#undef ATT_STORE
}
}

__device__ __forceinline__ void transpose_item(const float* W, int N, int nblk, bf16_t* WT, int ldt, LAS float* scr, int item, int lane, const float* gk = nullptr) {
    const int kb = item / nblk, nb = item % nblk, k0 = 64 * kb, n0 = 32 * nb;
    const int nn = n0 + (lane & 31); const bool ok = nn < N;
    float tmp[32];
#pragma unroll
    for (int i = 0; i < 32; ++i) { const int kk = 2 * i + (lane >> 5); tmp[i] = ok ? W[(size_t)(k0 + kk) * N + nn] : 0.f; }
#pragma unroll
    for (int i = 0; i < 32; ++i) { const int kk = 2 * i + (lane >> 5); scr[kk * 33 + (lane & 31)] = tmp[i]; }
    LDS_WAIT(); asm volatile("" ::: "memory");
    const int c = lane & 7;
    f32x4 ga = {1.f, 1.f, 1.f, 1.f}, gb = ga;
    if (gk) { ga = *(const f32x4*)(gk + k0 + 8 * c); gb = *(const f32x4*)(gk + k0 + 8 * c + 4); }
#pragma unroll
    for (int j = 0; j < 4; ++j) { const int n = (lane >> 3) + 8 * j; const LAS float* s = scr + (8 * c) * 33 + n;
        u32x4 o; o.x = pk2(s[0 * 33] * ga.x, s[1 * 33] * ga.y); o.y = pk2(s[2 * 33] * ga.z, s[3 * 33] * ga.w); o.z = pk2(s[4 * 33] * gb.x, s[5 * 33] * gb.y); o.w = pk2(s[6 * 33] * gb.z, s[7 * 33] * gb.w);
        *(u32x4*)(WT + (size_t)(n0 + n) * ldt + k0 + 8 * c) = o; }
    LDS_WAIT(); asm volatile("" ::: "memory");
}
__device__ __forceinline__ void prenorm_row(const float* xrow, bf16_t* orow, float* rowss, int lane) {
    const f32x4* xr = (const f32x4*)xrow + lane;
    f32x4 v[4]; float s = 0.f;
#pragma unroll
    for (int j = 0; j < 4; ++j) { v[j] = xr[64 * j]; s += (v[j].x * v[j].x + v[j].y * v[j].y) + (v[j].z * v[j].z + v[j].w * v[j].w); }
    s = wave_sum(s); if (lane < 16) rowss[lane] = (lane == 0) ? s : 0.f;
#pragma unroll
    for (int j = 0; j < 4; ++j) { u32x2 w; w.x = pk2(v[j].x, v[j].y); w.y = pk2(v[j].z, v[j].w); ((u32x2*)orow)[lane + 64 * j] = w; }
}
__device__ __forceinline__ float logsig(float z) { return fminf(z, 0.f) - __logf(1.0f + __expf(-fabsf(z))); }


constexpr int I_G = 16 * 128, I_B = 4 * 32, I_O = 16 * 32, I_U = 16 * 128, I_D = 64 * 32, N_LATE_ITEMS = I_G + 4 * I_B + I_O + I_U + I_D;
__device__ __forceinline__ void late_weight_item(int l, int r, LAS float* scr, int lane) {
    const cargs_t ap = get_args(); unsigned char* const ws = ap->ws;
    if (r < I_G) { transpose_item(ap->w_gate + (size_t)l * 1024 * 4096, 4096, 128, (bf16_t*)(ws + WS_WGT), 1024, scr, r, lane, ap->g_mix + l * 1024); return; } r -= I_G;
    if (r < 4 * I_B) { const int n = r / I_B; transpose_item(ap->w_branch + (size_t)l * 4 * 256 * 1024 + (size_t)n * 256 * 1024, 1024, 32, (bf16_t*)(ws + WS_WBT) + (size_t)n * 1024 * 1024 + n * 256, 1024, scr, r % I_B, lane); return; } r -= 4 * I_B;
    if (r < I_O) { transpose_item(ap->w_o + (size_t)l * 1024 * 1024, 1024, 32, (bf16_t*)(ws + WS_WOT), 1024, scr, r, lane); return; } r -= I_O;
    if (r < I_U) { transpose_item(ap->w_up + (size_t)l * 1024 * 4096, 4096, 128, (bf16_t*)(ws + WS_W1T), 1024, scr, r, lane, ap->g_ffn + l * 1024); return; } r -= I_U;
    transpose_item(ap->w_down + (size_t)l * 4096 * 1024, 1024, 32, (bf16_t*)(ws + WS_W2T), 4096, scr, r, lane);
}
__device__ __forceinline__ void conv_tokens(int l, int t0, int lane) {
    const cargs_t ap = get_args(); unsigned char* const ws = ap->ws;
    const bf16_t* U = (const bf16_t*)(ws + WS_U); bf16_t* BR = (bf16_t*)(ws + WS_BR);
    const float* wdw = ap->w_dw + (size_t)l * 31 * 256; const f32x4 bdw = *(const f32x4*)(ap->b_dw + l * 256 + 4 * lane);
    const f32x4 gln = *(const f32x4*)(ap->g_conv_ln + l * 256 + 4 * lane), bln = *(const f32x4*)(ap->b_conv_ln + l * 256 + 4 * lane);
    const int ts0 = t0 & (SEQ - 1);
    const float* wl = wdw + 4 * lane; asm volatile("" : "+v"(wl));
    u32x2 ur[38];
#pragma unroll
    for (int i = 0; i < 38; ++i) { const int tt = ts0 - 30 + i; ur[i] = (u32x2){0u, 0u}; if (tt >= 0) ur[i] = *(const u32x2*)(U + (size_t)(t0 - 30 + i) * 256 + 4 * lane); }
    f32x4 acc[8];
#pragma unroll
    for (int j = 0; j < 8; ++j) acc[j] = bdw;
#pragma unroll
    for (int k = 0; k < 31; ++k) { const f32x4 w = *(const f32x4*)(wl + k * 256);
#pragma unroll
        for (int j = 0; j < 8; ++j) { const u32x2 u = ur[j + k];
            acc[j].x = fmaf(lo_f(u.x), w.x, acc[j].x); acc[j].y = fmaf(hi_f(u.x), w.y, acc[j].y); acc[j].z = fmaf(lo_f(u.y), w.z, acc[j].z); acc[j].w = fmaf(hi_f(u.y), w.w, acc[j].w); } }
#pragma unroll
    for (int j = 0; j < 8; ++j) {
        const float mean = wave_sum((acc[j].x + acc[j].y) + (acc[j].z + acc[j].w)) * (1.0f / 256.0f);
        const f32x4 d = acc[j] - mean;
        const float rstd = 1.0f / sqrtf(wave_sum((d.x * d.x + d.y * d.y) + (d.z * d.z + d.w * d.w)) * (1.0f / 256.0f) + EPS);
        const f32x4 y = d * rstd * gln + bln;
        u32x2 o; o.x = pk2(y.x * sigmoidf_(y.x), y.y * sigmoidf_(y.y)); o.y = pk2(y.z * sigmoidf_(y.z), y.w * sigmoidf_(y.w));
        *(u32x2*)(BR + (size_t)(t0 + j) * 1024 + 768 + 4 * lane) = o;
    }
}

__device__ __forceinline__ void win_item(int l, int r, LAS float* scr, int lane) {
    const cargs_t ap = get_args();
    transpose_item(ap->w_in + (size_t)l * 1024 * INC, INC, 80, (bf16_t*)(ap->ws + (l == 0 ? WS_WINT : WS_WINT1)), 1024, scr, r, lane, ap->g_mix + l * 1024);
}
__device__ __forceinline__ void wlat_chunk(int l, int c) {
    const cargs_t ap = get_args();
    const float* w_uq = ap->w_uq + (size_t)l * 256 * 384; const float* w_ukv = ap->w_ukv + (size_t)l * 128 * 512; const float* gq = ap->g_q_lat + l * 256; const float* gkv = ap->g_kv_lat + l * 128;
    const int n = c / 48, k0 = (c % 48) * 8; float v[8];
#pragma unroll
    for (int e = 0; e < 8; ++e) { const int k = k0 + e; v[e] = (n < 384 && k < 256) ? gq[k] * w_uq[(size_t)k * 384 + n] : ((n >= 512 && k >= 256) ? gkv[k - 256] * w_ukv[(size_t)(k - 256) * 512 + (n - 512)] : 0.f); }
    u32x4 o; o.x = pk2(v[0], v[1]); o.y = pk2(v[2], v[3]); o.z = pk2(v[4], v[5]); o.w = pk2(v[6], v[7]);
    *(u32x4*)((bf16_t*)(ap->ws + (l == 0 ? WS_WLT : WS_WLT1)) + (size_t)n * 384 + k0) = o;
}

#define XB_TMO      128
#define XB_XCNT(j)  (256  + 64 * (j))
#define XB_XSUB(j)  (1280 + 64 * (j))
#define XB_XGEN(j)  (2304 + 64 * (j))
#define XB_TOP      3328
#define XB_TOPGEN   3392
#define XCD_BAR_WORDS 3456
#define XB_SPIN_CAP (1u << 18)
__device__ __forceinline__ unsigned xb_ld(unsigned* p)              { return __hip_atomic_load(p, __ATOMIC_RELAXED, __HIP_MEMORY_SCOPE_AGENT); }
__device__ __forceinline__ unsigned xb_add(unsigned* p, unsigned v) { return __hip_atomic_fetch_add(p, v, __ATOMIC_RELAXED, __HIP_MEMORY_SCOPE_AGENT); }
__device__ __forceinline__ unsigned xb_xcc_id() { return (unsigned)__builtin_amdgcn_s_getreg((3 << 11) | 20) & 0xFu; }
#define XB_SPIN(cond, bar) do { unsigned _sp = 0; while (cond) { __builtin_amdgcn_s_sleep(1); \
    if ((++_sp & 255u) == 0u) { if (xb_ld(&(bar)[XB_TMO])) break; if (_sp > XB_SPIN_CAP) { atomicAdd(&(bar)[XB_TMO], 1u); break; } } } } while (0)
struct XcdBarrier { unsigned* bar; unsigned x; volatile LAS unsigned* st; };
__device__ __forceinline__ void xcd_barrier_complete(unsigned* bar, unsigned x, unsigned& nloc, unsigned& nx) {
    const unsigned G = gridDim.x * gridDim.y * gridDim.z;
    unsigned sum, cnt, mine, sp = 0u;
    for (;;) {
        sum = 0u; cnt = 0u; mine = 0u;
#pragma unroll
        for (unsigned j = 0; j < 16; ++j) { const unsigned c = xb_ld(&bar[XB_XCNT(j)]); sum += c; cnt += (c > 0u) ? 1u : 0u; mine = (j == x) ? c : mine; }
        if (sum == G) break;
        __builtin_amdgcn_s_sleep(1);
        if ((++sp & 255u) == 0u) { if (xb_ld(&bar[XB_TMO])) break; if (sp > XB_SPIN_CAP) { atomicAdd(&bar[XB_TMO], 1u); break; } }
    }
    nloc = mine > 0u ? mine : 1u; nx = cnt > 0u ? cnt : 1u;
}
__device__ __forceinline__ void xcd_barrier(const XcdBarrier& b) {
    asm volatile("s_waitcnt vmcnt(0)" ::: "memory");
    __syncthreads();
    if (threadIdx.x == 0) {
        unsigned* bar = b.bar;
        __builtin_amdgcn_s_waitcnt(0);
        unsigned nloc = b.st[0], nx = b.st[1];
        if (nloc == 0u) { xcd_barrier_complete(bar, b.x, nloc, nx); b.st[0] = nloc; b.st[1] = nx; }
        const unsigned old = xb_add(&bar[XB_XSUB(b.x)], 1u);
        const unsigned gen = old / nloc;
        if (old + 1u == (gen + 1u) * nloc) {
            __builtin_amdgcn_fence(__ATOMIC_RELEASE, "agent");
            asm volatile("s_waitcnt vmcnt(0)" ::: "memory");
            const unsigned og = xb_add(&bar[XB_TOP], 1u);
            const unsigned tg = og / nx;
            if (og + 1u == (tg + 1u) * nx) xb_add(&bar[XB_TOPGEN], 1u);
            else XB_SPIN(xb_ld(&bar[XB_TOPGEN]) == tg, bar);
            __builtin_amdgcn_fence(__ATOMIC_ACQUIRE, "agent");
            xb_add(&bar[XB_XGEN(b.x)], 1u);
            asm volatile("s_waitcnt vmcnt(0)" ::: "memory");
        } else {
            XB_SPIN(xb_ld(&bar[XB_XGEN(b.x)]) == gen, bar);
            __builtin_amdgcn_fence(__ATOMIC_ACQUIRE, "agent");
            asm volatile("s_waitcnt vmcnt(0)" ::: "memory");
        }
    }
    __syncthreads();
}
constexpr int CTL_BAR_WORD = 4096;
constexpr int LDS_MISC = 131072 + 128;
#define GRID_BAR() do { const cargs_t ap_ = get_args(); XcdBarrier b_; b_.bar = (unsigned*)(ap_->ws + WS_CTL) + CTL_BAR_WORD; b_.x = xb_xcc_id(); \
    b_.st = (volatile LAS unsigned*)(lds + LDS_MISC); xcd_barrier(b_); } while (0)

#define WSP(T, off) ((T*)(ws + (off)))
#define REP_P1 1
#define REP_P2 1
#define REP_P3 1
#define REP_P4 1
#define REP_P5 1
#define REP_P6 1
#define REP_P7 1
#define REP_P8 1
#define REP_P9 1
#define REP_P10 1
#define REP_SYNC 0
#define PHASE_BEGIN(R) _Pragma("unroll 1") for (int rep = 0; rep < (R); ++rep) {
#define PHASE_END GRID_BAR(); }
__global__ void __launch_bounds__(512, 2) fwd_megakernel(Args A_unused) {
    extern __shared__ __attribute__((aligned(16))) unsigned char lds_raw[];
    LAS unsigned char* lds = (LAS unsigned char*)lds_raw;
    {
        if (threadIdx.x < 8) ((LAS unsigned*)(lds + LDS_MISC))[threadIdx.x] = 0u;
        __syncthreads();
        const cargs_t ap = get_args();
        if (threadIdx.x == 0) (void)xb_add((unsigned*)(ap->ws + WS_CTL) + CTL_BAR_WORD + XB_XCNT(xb_xcc_id()), 1u);
    }
    cg::this_grid().sync();

#pragma unroll 1
    for (int l = 0; l < 2; ++l) {
        if (l == 0) {
        PHASE_BEGIN(REP_P1)
            const cargs_t ap = get_args(); unsigned char* const ws = ap->ws;
            const int tid = fresh_tid(), lane = tid & 63, wid = __builtin_amdgcn_readfirstlane(tid >> 6), G = gridDim.x, bx = blockIdx.x, gw = bx * 8 + wid, NGW = G * 8;
            LAS float* scr = (LAS float*)(lds + wid * 16384);
            for (int it = gw; it < 1280; it += NGW) win_item(0, it, scr, lane);
            for (int c = bx * 512 + tid; c < 1024 * 48; c += G * 512) wlat_chunk(0, c);
            const float* xin = ap->x; bf16_t* XN = WSP(bf16_t, WS_XN); float* rss = WSP(float, WS_ROWSS);
            for (int m = gw; m < TOK; m += NGW) prenorm_row(xin + (size_t)m * 1024, XN + (size_t)m * 1024, rss + (size_t)m * 16, lane);
        GRID_BAR(); }
        }
        PHASE_BEGIN(REP_P2)
            const cargs_t ap = get_args(); unsigned char* const ws = ap->ws;
            const char* hin = (l == 0) ? WSP(const char, WS_XN) : (const char*)ap->out;
            pg8::PlainOrder S{hin, (l == 0) ? WSP(const char, WS_WINT) : WSP(const char, WS_WINT1), 1024, 1024, 64, 10, 16, (int)gridDim.x, (int)blockIdx.x};
            const float* slots = WSP(const float, WS_ROWSS) + (size_t)(l * 2) * ROWSS_STRIDE;
            pg8::Unit u0; int pm0 = -1; if (S.next(0, u0)) { pm0 = u0.pm; fill_rinv_table(lds, slots, pm0); }
            pg8::EpiBf16<0, 1, true> E{WSP(bf16_t, WS_PROJ), PLD, slots, pm0, (unsigned)(uintptr_t)(lds + LDS_RINV), WSP(float, WS_LATSS)};
            pg8::gemm_phase(lds, 1024, 1024, S, E);
        PHASE_END
        PHASE_BEGIN(REP_P3)
            const cargs_t ap = get_args(); unsigned char* const ws = ap->ws;
            const int tid = fresh_tid(), lane = tid & 63, wid = __builtin_amdgcn_readfirstlane(tid >> 6), G = gridDim.x, bx = blockIdx.x, gw = bx * 8 + wid, NGW = G * 8;
            const bf16_t* PROJ = WSP(const bf16_t, WS_PROJ);
            if (bx < 16) {
                const int b = bx >> 2, h = bx & 3; const float bf = ap->b_forget[l * 4 + h];
                const bf16_t* src = PROJ + ((size_t)b * SEQ + tid * 8) * PLD + C_CF + h;
                float v[8];
#pragma unroll
                for (int i = 0; i < 8; ++i) v[i] = bf2f(src[(size_t)i * PLD]);
#pragma unroll
                for (int i = 0; i < 8; ++i) { v[i] = logsig(v[i] + bf); if (i) v[i] += v[i - 1]; }
                float incl = v[7];
#pragma unroll
                for (int o = 1; o < 64; o <<= 1) { const float u = __shfl_up(incl, o); if (lane >= o) incl += u; }
                LAS float* wtot = (LAS float*)(lds + 131072 + 64);
                if (lane == 63) wtot[wid] = incl;
                __syncthreads();
                float off = incl - v[7];
                for (int w = 0; w < wid; ++w) off += wtot[w];
                float* dst = WSP(float, WS_FCUM) + (size_t)(b * 4 + h) * SEQ + tid * 8;
                f32x4 o0 = {v[0] + off, v[1] + off, v[2] + off, v[3] + off}, o1 = {v[4] + off, v[5] + off, v[6] + off, v[7] + off};
                *(f32x4*)dst = o0; *(f32x4*)(dst + 4) = o1;
            }
            const int* posp = ap->pos;
            bf16_t* KROT = WSP(bf16_t, WS_KROT); bf16_t* U = WSP(bf16_t, WS_U);
            const float invf = exp2f(-(float)(lane & 15) * 0.8304820237218406f);
            for (int t0 = gw * 4; t0 < TOK; t0 += NGW * 4) {
                u32x2 dv4[4], dg4[4]; float x14[4], x24[4], pos4[4];
#pragma unroll
                for (int j = 0; j < 4; ++j) { const bf16_t* row = PROJ + (size_t)(t0 + j) * PLD;
                    dv4[j] = *(const u32x2*)(row + C_DV + 4 * lane); dg4[j] = *(const u32x2*)(row + C_DG + 4 * lane);
                    x14[j] = bf2f(row[C_BKR + (lane & 15)]); x24[j] = bf2f(row[C_BKR + 16 + (lane & 15)]); pos4[j] = (float)posp[t0 + j]; }
#pragma unroll
                for (int j = 0; j < 4; ++j) { const int t = t0 + j;
                    if (lane < 16) {
                        const float ang = pos4[j] * invf, kk = rintf(ang * 0.15915494309189535f);
                        float rem = fmaf(-kk, 6.2831854820251465f, ang); rem = fmaf(kk, 1.7484555e-7f, rem);
                        const float sn = __sinf(rem), cn = __cosf(rem);
                        const unsigned w = pk2(x14[j] * cn - x24[j] * sn, x24[j] * cn + x14[j] * sn);
                        KROT[(size_t)t * 32 + lane] = (bf16_t)(w & 0xffffu); KROT[(size_t)t * 32 + 16 + lane] = (bf16_t)(w >> 16);
                    }
                    {
                        const u32x2 v = dv4[j], gt = dg4[j];
                        u32x2 o; o.x = pk2(lo_f(v.x) * sigmoidf_(lo_f(gt.x)), hi_f(v.x) * sigmoidf_(hi_f(gt.x))); o.y = pk2(lo_f(v.y) * sigmoidf_(lo_f(gt.y)), hi_f(v.y) * sigmoidf_(hi_f(gt.y)));
                        *(u32x2*)(U + (size_t)t * 256 + 4 * lane) = o;
                    }
                }
            }
            { const cargs_t ap2 = get_args(); unsigned char* const ws = ap2->ws;
              pg8::PlainOrder S{WSP(const char, WS_PROJ) + C_BQL * 2, (l == 0) ? WSP(const char, WS_WLT) : WSP(const char, WS_WLT1), PLD, 384, 64, 4, 6, (int)gridDim.x, (int)blockIdx.x};
              pg8::EpiBf16<0, 2> E{WSP(bf16_t, WS_QKVB), 1024, nullptr, -1, 0u, WSP(float, WS_LATSS)};
              pg8::gemm_phase(lds, PLD, 384, S, E); }
        PHASE_END
        PHASE_BEGIN(REP_P5)
            LAS int* wq = (LAS int*)(lds + 131072);
            for (;;) {
                __syncthreads();
                if (threadIdx.x == 0) { const cargs_t ap = get_args(); wq[0] = atomicAdd((int*)(ap->ws + WS_CTL) + 16 * (l * 8 + rep), 1); }
                __syncthreads();
                const int it = wq[0];
                if (it >= 768 + 256 + N_LATE_ITEMS / 16 + (l == 0 ? 80 + 96 : 0)) break;
                if (it >= 768) {
                    const int tidq = fresh_tid(), laneq = tidq & 63, widq = __builtin_amdgcn_readfirstlane(tidq >> 6);
                    if (it < 1024) conv_tokens(l, ((it - 768) * 8 + widq) * 8, laneq);
                    else if (it >= 1024 + N_LATE_ITEMS / 16) {
                        const int e = it - (1024 + N_LATE_ITEMS / 16);
                        if (e < 80) { LAS float* scr = (LAS float*)(lds + widq * 16384); win_item(l + 1, e * 16 + widq * 2, scr, laneq); win_item(l + 1, e * 16 + widq * 2 + 1, scr, laneq); }
                        else wlat_chunk(l + 1, (e - 80) * 512 + tidq);
                    }
                    else { LAS float* scr = (LAS float*)(lds + widq * 16384); const int r0 = (it - 1024) * 16 + widq * 2; late_weight_item(l, r0, scr, laneq); late_weight_item(l, r0 + 1, scr, laneq); }
                    continue;
                }
                int mode, bh, qb;
                if (it >= 384 && it < 640) { const int a = it - 384; mode = 0; bh = a & 15; qb = a >> 4; }
                else { const int k = it < 384 ? it : it - 256; const int lvl = k >> 5, w = k & 31; qb = 15 - lvl; mode = (w < 16) ? 1 : 2; bh = w & 15; }
                if (mode == 0) att::unit<0>(l, bh >> 2, bh & 3, qb, lds);
                else if (mode == 1) att::unit<1>(l, bh >> 2, bh & 3, qb, lds);
                else att::unit<2>(l, bh >> 2, bh & 3, qb, lds);
            }
        PHASE_END
        PHASE_BEGIN(REP_P6)
            const cargs_t ap = get_args(); unsigned char* const ws = ap->ws;
            const char* hin = (l == 0) ? WSP(const char, WS_XN) : (const char*)ap->out;
            pg8::GateBranchOrder S{hin, WSP(const char, WS_BR), WSP(const char, WS_WGT), WSP(const char, WS_WBT), (int)gridDim.x, (int)blockIdx.x};
            pg8::EpiGateBranch E{WSP(bf16_t, WS_MIXED), ap->b_gate + (size_t)l * 4096, WSP(const float, WS_ROWSS) + (size_t)(l * 2) * ROWSS_STRIDE, (LAS unsigned*)(lds + 131072 + 1024)};
            pg8::gemm_phase(lds, 1024, 1024, S, E);
        PHASE_END
        PHASE_BEGIN(REP_P7)
            const cargs_t ap = get_args(); unsigned char* const ws = ap->ws;
            pg8::PlainOrder S{WSP(const char, WS_MIXED), WSP(const char, WS_WOT), 1024, 1024, 64, 4, 16, (int)gridDim.x, (int)blockIdx.x};
            if (l == 0) { pg8::EpiRes<true> E{ap->x, WSP(bf16_t, WS_XA), WSP(float, WS_ROWSS) + (size_t)1 * ROWSS_STRIDE};
                pg8::gemm_phase(lds, 1024, 1024, S, E); }
            else { pg8::EpiRes<false> E{ap->out, WSP(bf16_t, WS_XA), WSP(float, WS_ROWSS) + (size_t)3 * ROWSS_STRIDE};
                pg8::gemm_phase(lds, 1024, 1024, S, E); }
        PHASE_END
        PHASE_BEGIN(REP_P9)
            const cargs_t ap = get_args(); unsigned char* const ws = ap->ws;
            pg8::PlainOrder S{WSP(const char, WS_XA), WSP(const char, WS_W1T), 1024, 1024, 64, 16, 16, (int)gridDim.x, (int)blockIdx.x};
            const float* slots = WSP(const float, WS_ROWSS) + (size_t)(l * 2 + 1) * ROWSS_STRIDE;
            pg8::Unit u0; int pm0 = -1; if (S.next(0, u0)) { pm0 = u0.pm; fill_rinv_table(lds, slots, pm0); }
            pg8::EpiBf16<2, 1> E{WSP(bf16_t, WS_H), 4096, slots, pm0, (unsigned)(uintptr_t)(lds + LDS_RINV), nullptr};
            pg8::gemm_phase(lds, 1024, 1024, S, E);
        PHASE_END
        PHASE_BEGIN(REP_P10)
            const cargs_t ap = get_args(); unsigned char* const ws = ap->ws;
            pg8::PlainOrder S{WSP(const char, WS_H), WSP(const char, WS_W2T), 4096, 4096, 64, 4, 64, (int)gridDim.x, (int)blockIdx.x};
            if (l == 0) { pg8::EpiRes<false> E{WSP(const bf16_t, WS_XA), (bf16_t*)ap->out, WSP(float, WS_ROWSS) + (size_t)2 * ROWSS_STRIDE};
                pg8::gemm_phase(lds, 4096, 4096, S, E); }
            else { pg8::EpiFinal E{WSP(const bf16_t, WS_XA), ap->out, WSP(float, WS_ROWSS) + (size_t)4 * ROWSS_STRIDE, ap->g_final, (unsigned*)(ws + WS_CTL) + 8192};
                pg8::gemm_phase(lds, 4096, 4096, S, E); }
        if (l == 0) GRID_BAR(); }
    }
    _Pragma("unroll 1") for (int i = 0; i < REP_SYNC; ++i) GRID_BAR();
}

extern "C" void kernel_launch(void* const* d_in, const int* in_sizes, int n_in, void* d_out, int out_size, void* d_ws, size_t ws_size, hipStream_t stream) {
    static int grid = 0;
    if (grid == 0) {
        if (n_in != 22 || out_size != TOK * DM || ws_size < WS_END) { fprintf(stderr, "kernel_launch: unexpected shapes (n_in %d out %d ws %zu)\n", n_in, out_size, ws_size); grid = -1; return; }
        int dev = 0, cus = 0, per_cu = 0;
        if (hipGetDevice(&dev) != hipSuccess || hipDeviceGetAttribute(&cus, hipDeviceAttributeMultiprocessorCount, dev) != hipSuccess) { grid = -1; return; }
        if (hipFuncSetAttribute((const void*)fwd_megakernel, hipFuncAttributeMaxDynamicSharedMemorySize, LDS_BYTES) != hipSuccess) { fprintf(stderr, "hipFuncSetAttribute failed\n"); grid = -1; return; }
        if (hipOccupancyMaxActiveBlocksPerMultiprocessor(&per_cu, (const void*)fwd_megakernel, 512, LDS_BYTES) != hipSuccess || per_cu < 1) { fprintf(stderr, "occupancy query: %d blocks per CU\n", per_cu); grid = -1; return; }
        grid = cus;
    }
    if (grid < 0) return;
    (void)hipMemsetAsync((char*)d_ws + WS_CTL, 0, 65536, stream);
    Args a{};
    a.x = (const float*)d_in[0]; a.pos = (const int*)d_in[1]; a.g_mix = (const float*)d_in[2]; a.w_in = (const float*)d_in[3]; a.w_gate = (const float*)d_in[4]; a.b_gate = (const float*)d_in[5];
    a.rel_bias = (const float*)d_in[6]; a.g_q_lat = (const float*)d_in[7]; a.w_uq = (const float*)d_in[8]; a.g_kv_lat = (const float*)d_in[9]; a.w_ukv = (const float*)d_in[10];
    a.b_forget = (const float*)d_in[11]; a.w_dw = (const float*)d_in[12]; a.b_dw = (const float*)d_in[13]; a.g_conv_ln = (const float*)d_in[14]; a.b_conv_ln = (const float*)d_in[15];
    a.w_branch = (const float*)d_in[16]; a.w_o = (const float*)d_in[17]; a.g_ffn = (const float*)d_in[18]; a.w_up = (const float*)d_in[19]; a.w_down = (const float*)d_in[20]; a.g_final = (const float*)d_in[21];
    a.out = (float*)d_out; a.ws = (unsigned char*)d_ws;
    void* args[] = {&a};
    hipError_t e = hipLaunchCooperativeKernel((const void*)fwd_megakernel, dim3(grid), dim3(512), args, LDS_BYTES, stream);
    if (e != hipSuccess) fprintf(stderr, "cooperative launch failed: %s (grid %d)\n", hipGetErrorString(e), grid);
}
```

```cpp
#include <hip/hip_runtime.h>
#include <hip/hip_cooperative_groups.h>
#include <cstdio>
#include <cstdint>
namespace cg = cooperative_groups;

#define LAS __attribute__((address_space(3)))
typedef unsigned short bf16_t;
typedef short bf16x8 __attribute__((ext_vector_type(8)));
typedef short s16x4 __attribute__((ext_vector_type(4)));
typedef float f32x4 __attribute__((ext_vector_type(4)));
typedef float f32x16 __attribute__((ext_vector_type(16)));
typedef unsigned u32x4 __attribute__((ext_vector_type(4)));
typedef unsigned u32x2 __attribute__((ext_vector_type(2)));
typedef float f32x2_t __attribute__((ext_vector_type(2)));
typedef __bf16 bf16x2_t __attribute__((ext_vector_type(2)));

constexpr int NB = 4, SEQ = 4096, DM = 1024, TOK = NB * SEQ, DFF = 4096, INC = 2468, PLD = 2560;
constexpr int C_AQ = 0, C_AK = 256, C_AV = 512, C_BQL = 768, C_BKVL = 1024, C_BKR = 1152, C_CQ = 1184, C_CK = 1440, C_CV = 1696, C_CF = 1952, C_DV = 1956, C_DG = 2212;
constexpr float LOG2E = 1.4426950408889634f;
constexpr float EPS = 1e-6f;
constexpr size_t MiB = 1u << 20;
constexpr size_t WS_W1T = 4 * MiB, WS_W2T = 12 * MiB, WS_XN = 20 * MiB, WS_PROJ = 52 * MiB, WS_XA = 52 * MiB, WS_H = 116 * MiB;
constexpr size_t WS_QKVB = 132 * MiB, WS_MIXED = 132 * MiB, WS_BR = 164 * MiB, WS_LAT = 196 * MiB, WS_U = 208 * MiB;
constexpr size_t WS_WINT = 216 * MiB, WS_WGT = 221 * MiB, WS_WLT = 229 * MiB, WS_WBT = 230 * MiB, WS_WOT = 238 * MiB;
constexpr size_t WS_CTL = 244 * MiB, WS_FCUM = 244 * MiB + 256 * 1024, WS_KROT = 245 * MiB, WS_END = 256 * MiB;
constexpr size_t WS_WINT1 = 251 * MiB, WS_WLT1 = 0, WS_LATSS = 1 * MiB;
constexpr size_t WS_ROWSS = 246 * MiB, ROWSS_STRIDE = (size_t)TOK * 16;
constexpr int LDS_RINV = 131072 + 1024 + 16384;
constexpr int LDS_BIAS = LDS_RINV + 1024;
constexpr int LDS_BYTES = LDS_BIAS + 4096;

struct Args {
    const float* x; const int* pos; const float* g_mix; const float* w_in; const float* w_gate; const float* b_gate; const float* rel_bias;
    const float* g_q_lat; const float* w_uq; const float* g_kv_lat; const float* w_ukv; const float* b_forget; const float* w_dw; const float* b_dw;
    const float* g_conv_ln; const float* b_conv_ln; const float* w_branch; const float* w_o; const float* g_ffn; const float* w_up; const float* w_down; const float* g_final;
    float* out; unsigned char* ws;
};

typedef const __attribute__((address_space(4))) Args* cargs_t;
__device__ __forceinline__ cargs_t get_args() { cargs_t p = (cargs_t)__builtin_amdgcn_kernarg_segment_ptr(); asm volatile("" : "+s"(p)); return p; }
__device__ __forceinline__ int fresh_tid() { int t = threadIdx.x; asm volatile("" : "+v"(t)); return t; }
__device__ __forceinline__ float bf2f(unsigned short b) { return __uint_as_float((unsigned)b << 16); }
__device__ __forceinline__ unsigned pk2(float lo, float hi) { f32x2_t v = {lo, hi}; bf16x2_t b = __builtin_convertvector(v, bf16x2_t); return __builtin_bit_cast(unsigned, b); }
__device__ __forceinline__ float lo_f(unsigned w) { return __uint_as_float(w << 16); }
__device__ __forceinline__ float hi_f(unsigned w) { return __uint_as_float(w & 0xffff0000u); }
__device__ __forceinline__ float wave_sum(float v) {
#pragma unroll
    for (int o = 1; o < 64; o <<= 1) v += __shfl_xor(v, o);
    return v;
}
__device__ __forceinline__ float sigmoidf_(float x) { return 1.0f / (1.0f + __expf(-x)); }
#define LDS_WAIT() asm volatile("s_waitcnt lgkmcnt(0)" ::: "memory")
__device__ __forceinline__ float row_rinv(const float* slots, int row, int fq) {
    const f32x4 a = *(const f32x4*)(slots + (size_t)row * 16 + 4 * fq);
    float s = (a.x + a.y) + (a.z + a.w);
    s += __shfl_xor(s, 16); s += __shfl_xor(s, 32);
    return __builtin_amdgcn_rsqf(s * (1.0f / 1024.0f) + EPS);
}
__device__ __forceinline__ void fill_rinv_table(LAS unsigned char* lds, const float* slots, int pm) {
    const int t = fresh_tid();
    if (t < 256) { const f32x4* p = (const f32x4*)(slots + (size_t)(pm * 256 + t) * 16); const f32x4 a = p[0], b = p[1], c = p[2], d = p[3];
        const float s = (((a.x + a.y) + (a.z + a.w)) + ((b.x + b.y) + (b.z + b.w))) + (((c.x + c.y) + (c.z + c.w)) + ((d.x + d.y) + (d.z + d.w)));
        ((LAS float*)(lds + LDS_RINV))[t] = __builtin_amdgcn_rsqf(s * (1.0f / 1024.0f) + EPS); }
    __syncthreads();
}
__device__ __forceinline__ float lds_rinv_read(unsigned addr) { float r; asm volatile("ds_read_b32 %0, %1" : "=v"(r) : "v"(addr)); return r; }
__device__ __forceinline__ f32x4 lds_read4(unsigned addr) { f32x4 r; asm volatile("ds_read_b128 %0, %1" : "=v"(r) : "v"(addr)); return r; }
namespace pg8 {
constexpr int BM = 256, BK = 64, HALF = 128, HTB = HALF * BK * 2, STAGE_BYTES = 8 * HTB, NXCD = 8, WGM = 8;
__host__ __device__ __forceinline__ int lds_byte(int r, int c) { const int st = (r >> 4) * 2 + (c >> 5), rr = r & 15, cc = c & 31, ob = rr * 64 + cc * 2; return st * 1024 + (ob ^ (((ob >> 9) & 1) << 5)); }
__host__ __device__ __forceinline__ void stage_rc(int b, int& R, int& C) { const int st = b / 1024, sb = b % 1024, swz = sb ^ (((sb >> 9) & 1) << 5); R = (st >> 1) * 16 + swz / 64; C = (st & 1) * 32 + (swz % 64) / 2; }
__host__ __device__ __forceinline__ int perm32(int rho) { const int n = rho >> 4, i = rho & 15; return 8 * (i >> 2) + 4 * n + (i & 3); }

struct Unit { int pm, pn, nt, kind; const char* a; const char* b; };

__device__ __forceinline__ bool tile_of(int L, int nM, int nN, int& pm, int& pn) {
    const int nwg = nM * nN; if (L >= nwg) return false;
    int wgid = L; { const int q = nwg / NXCD, r = nwg % NXCD, xcd = wgid % NXCD, off = wgid / NXCD; wgid = (xcd < r ? xcd * (q + 1) : r * (q + 1) + (xcd - r) * q) + off; }
    const int nig = WGM * nN, gid = wgid / nig, fm = gid * WGM, gsz = (nM - fm) < WGM ? (nM - fm) : WGM;
    pm = fm + ((wgid % nig) % gsz); pn = (wgid % nig) / gsz; return true;
}
struct PlainOrder {
    const char* A; const char* Bt; int lda, ldb, nM, nN, nt, G, c;
    __device__ __forceinline__ bool next(int i, Unit& u) const {
        int pm, pn; if (!tile_of(i * G + c, nM, nN, pm, pn)) return false;
        u.pm = pm; u.pn = pn; u.nt = nt; u.kind = 0; u.a = A + (size_t)pm * 256 * lda * 2; u.b = Bt + (size_t)pn * 256 * ldb * 2; return true;
    }
};
struct GateBranchOrder {
    const char* XN; const char* BR; const char* WgT; const char* WbT; int G, c;
    __device__ __forceinline__ bool next(int i, Unit& u) const {
        const int gi = i >> 3, j = i & 7; int pm, pd; if (!tile_of(gi * G + c, 64, 4, pm, pd)) return false;
        const int n = j >> 1, kind = j & 1; u.pm = pm; u.pn = n * 4 + pd; u.kind = kind;
        if (kind == 0) { u.nt = 16; u.a = XN + (size_t)pm * 256 * 1024 * 2; u.b = WgT + (size_t)u.pn * 256 * 1024 * 2; }
        else { u.nt = 4; u.a = BR + ((size_t)pm * 256 * 1024 + n * 256) * 2; u.b = WbT + ((size_t)u.pn * 256 * 1024 + n * 256) * 2; }
        return true;
    }
};

template <int ACT  , int RS  , bool LATSS = false  > struct EpiBf16 {
    static constexpr bool PERM = true; struct State {};
    bf16_t* O; int ldc; const float* rowss; int pm_tab; unsigned tab; float* latss;
    __device__ __forceinline__ void operator()(const f32x4 (&acc)[2][2][4][2], State&, const Unit& u, int wr, int wc, int fr, int fq) const {
        asm volatile("" : "+v"(fr), "+v"(fq));
        const int row0 = u.pm * BM + wr * 64 + fr, col0 = u.pn * BM + wc * 32 + 8 * fq;
        float rv[2][4];
        if (RS == 1) {
            if (u.pm == pm_tab) {
#pragma unroll
                for (int ai = 0; ai < 2; ++ai)
#pragma unroll
                    for (int m = 0; m < 4; ++m) rv[ai][m] = lds_rinv_read(tab + (unsigned)(wr * 64 + fr + ai * HALF + m * 16) * 4u);
                asm volatile("s_waitcnt lgkmcnt(0)" : "+v"(rv[0][0]), "+v"(rv[0][1]), "+v"(rv[0][2]), "+v"(rv[0][3]), "+v"(rv[1][0]), "+v"(rv[1][1]), "+v"(rv[1][2]), "+v"(rv[1][3]));
            } else {
#pragma unroll
                for (int ai = 0; ai < 2; ++ai)
#pragma unroll
                    for (int m = 0; m < 4; ++m) rv[ai][m] = row_rinv(rowss, row0 + ai * HALF + m * 16, fq);
            }
        }
#pragma unroll
        for (int ai = 0; ai < 2; ++ai)
#pragma unroll
            for (int m = 0; m < 4; ++m) { bf16_t* rowp = O + (size_t)(row0 + ai * HALF + m * 16) * ldc + col0;
                float rinv = 1.f; if (RS == 1) rinv = rv[ai][m];
                if (RS == 2) { const f32x4 a = *(const f32x4*)(latss + (size_t)(row0 + ai * HALF + m * 16) * 8 + (u.pn >= 2 ? 4 : 0));
                    rinv = __builtin_amdgcn_rsqf(((a.x + a.y) + (a.z + a.w)) * (u.pn >= 2 ? (1.0f / 128.0f) : (1.0f / 256.0f)) + EPS); }
                float lss = 0.f;
#pragma unroll
                for (int bj = 0; bj < 2; ++bj) { f32x4 v0 = acc[ai][bj][m][0], v1 = acc[ai][bj][m][1];
                    if (RS) { v0 = v0 * rinv; v1 = v1 * rinv; }
                    if (LATSS) { if (bj == 0 || u.pn == 3) lss += ((v0.x * v0.x + v0.y * v0.y) + (v0.z * v0.z + v0.w * v0.w)) + ((v1.x * v1.x + v1.y * v1.y) + (v1.z * v1.z + v1.w * v1.w)); }
                    if (ACT == 2) {
#pragma unroll
                        for (int e = 0; e < 4; ++e) { const float a0 = fmaxf(v0[e], 0.f), a1 = fmaxf(v1[e], 0.f); v0[e] = a0 * a0; v1[e] = a1 * a1; } }
                    u32x4 w; w.x = pk2(v0[0], v0[1]); w.y = pk2(v0[2], v0[3]); w.z = pk2(v1[0], v1[1]); w.w = pk2(v1[2], v1[3]);
                    *(u32x4*)(rowp + bj * HALF) = w; }
                if (LATSS) { if (u.pn == 3 || u.pn == 4) { lss += __shfl_xor(lss, 16); lss += __shfl_xor(lss, 32);
                    if (fq == 0) latss[(size_t)(row0 + ai * HALF + m * 16) * 8 + (u.pn == 4 ? 4 : 0) + wc] = lss; } } }
    }
};
template <bool BASEF32> struct EpiRes {
    static constexpr bool PERM = true; struct State {};
    const void* base; bf16_t* out; float* rowss;
    __device__ __forceinline__ void operator()(const f32x4 (&acc)[2][2][4][2], State&, const Unit& u, int wr, int wc, int fr, int fq) const {
        asm volatile("" : "+v"(fr), "+v"(fq));
        const int row0 = u.pm * BM + wr * 64 + fr, col0 = u.pn * BM + wc * 32 + 8 * fq;
#pragma unroll
        for (int ai = 0; ai < 2; ++ai) {
            f32x4 bs[4][2][2];
#pragma unroll
            for (int m = 0; m < 4; ++m) { const size_t off = (size_t)(row0 + ai * HALF + m * 16) * 1024 + col0;
#pragma unroll
                for (int bj = 0; bj < 2; ++bj) {
                    if (BASEF32) { bs[m][bj][0] = *(const f32x4*)((const float*)base + off + bj * HALF); bs[m][bj][1] = *(const f32x4*)((const float*)base + off + bj * HALF + 4); }
                    else { const u32x4 w = *(const u32x4*)((const bf16_t*)base + off + bj * HALF);
                        bs[m][bj][0] = (f32x4){lo_f(w.x), hi_f(w.x), lo_f(w.y), hi_f(w.y)}; bs[m][bj][1] = (f32x4){lo_f(w.z), hi_f(w.z), lo_f(w.w), hi_f(w.w)}; } } }
            asm volatile("" ::: "memory");
#pragma unroll
            for (int m = 0; m < 4; ++m) { const int row = row0 + ai * HALF + m * 16; const size_t off = (size_t)row * 1024 + col0; float ss = 0.f;
#pragma unroll
                for (int bj = 0; bj < 2; ++bj) { const f32x4 v0 = bs[m][bj][0] + acc[ai][bj][m][0], v1 = bs[m][bj][1] + acc[ai][bj][m][1];
                    u32x4 w; w.x = pk2(v0[0], v0[1]); w.y = pk2(v0[2], v0[3]); w.z = pk2(v1[0], v1[1]); w.w = pk2(v1[2], v1[3]); *(u32x4*)(out + off + bj * HALF) = w;
                    ss += ((v0.x * v0.x + v0.y * v0.y) + (v0.z * v0.z + v0.w * v0.w)) + ((v1.x * v1.x + v1.y * v1.y) + (v1.z * v1.z + v1.w * v1.w)); }
                ss += __shfl_xor(ss, 16); ss += __shfl_xor(ss, 32); if (fq == 0) rowss[(size_t)row * 16 + u.pn * 4 + wc] = ss; }
            asm volatile("" ::: "memory");
        }
    }
};
struct EpiFinal {
    static constexpr bool PERM = true; struct State {};
    const bf16_t* base; float* out; float* rowss; const float* g; unsigned* cnt;
    __device__ __forceinline__ void operator()(const f32x4 (&acc_)[2][2][4][2], State&, const Unit& u, int wr, int wc, int fr, int fq) const {
        asm volatile("" : "+v"(fr), "+v"(fq));
        f32x4 (&acc)[2][2][4][2] = const_cast<f32x4 (&)[2][2][4][2]>(acc_);
        const int row0 = u.pm * BM + wr * 64 + fr, col0 = u.pn * BM + wc * 32 + 8 * fq;
#pragma unroll
        for (int ai = 0; ai < 2; ++ai) {
            u32x4 bs[4][2];
#pragma unroll
            for (int m = 0; m < 4; ++m) { const size_t off = (size_t)(row0 + ai * HALF + m * 16) * 1024 + col0;
#pragma unroll
                for (int bj = 0; bj < 2; ++bj) bs[m][bj] = *(const u32x4*)(base + off + bj * HALF); }
            asm volatile("" ::: "memory");
#pragma unroll
            for (int m = 0; m < 4; ++m) { const int row = row0 + ai * HALF + m * 16; float ss = 0.f;
#pragma unroll
                for (int bj = 0; bj < 2; ++bj) { const u32x4 w = bs[m][bj];
                    const f32x4 v0 = acc[ai][bj][m][0] + (f32x4){lo_f(w.x), hi_f(w.x), lo_f(w.y), hi_f(w.y)}, v1 = acc[ai][bj][m][1] + (f32x4){lo_f(w.z), hi_f(w.z), lo_f(w.w), hi_f(w.w)};
                    acc[ai][bj][m][0] = v0; acc[ai][bj][m][1] = v1;
                    ss += ((v0.x * v0.x + v0.y * v0.y) + (v0.z * v0.z + v0.w * v0.w)) + ((v1.x * v1.x + v1.y * v1.y) + (v1.z * v1.z + v1.w * v1.w)); }
                ss += __shfl_xor(ss, 16); ss += __shfl_xor(ss, 32); if (fq == 0) rowss[(size_t)row * 16 + u.pn * 4 + wc] = ss; }
        }
        asm volatile("s_waitcnt vmcnt(0)" ::: "memory"); __builtin_amdgcn_s_barrier(); asm volatile("" ::: "memory");
        if (threadIdx.x == 0) {
            __builtin_amdgcn_fence(__ATOMIC_RELEASE, "agent"); asm volatile("s_waitcnt vmcnt(0)" ::: "memory");
            unsigned* c = cnt + 64 * u.pm;
            (void)__hip_atomic_fetch_add(c, 1u, __ATOMIC_RELAXED, __HIP_MEMORY_SCOPE_AGENT);
            unsigned sp = 0;
            while (__hip_atomic_load(c, __ATOMIC_RELAXED, __HIP_MEMORY_SCOPE_AGENT) < 4u) { __builtin_amdgcn_s_sleep(1); if (++sp > (1u << 16)) break; }
            __builtin_amdgcn_fence(__ATOMIC_ACQUIRE, "agent"); asm volatile("s_waitcnt vmcnt(0)" ::: "memory");
        }
        asm volatile("" ::: "memory"); __builtin_amdgcn_s_barrier(); asm volatile("" ::: "memory");
        f32x4 gv[2][2];
#pragma unroll
        for (int bj = 0; bj < 2; ++bj)
#pragma unroll
            for (int q = 0; q < 2; ++q) gv[bj][q] = *(const f32x4*)(g + col0 + bj * HALF + 4 * q);
#pragma unroll
        for (int ai = 0; ai < 2; ++ai)
#pragma unroll
            for (int m = 0; m < 4; ++m) { const int row = row0 + ai * HALF + m * 16; const float rinv = row_rinv(rowss, row, fq); float* op = out + (size_t)row * 1024 + col0;
#pragma unroll
                for (int bj = 0; bj < 2; ++bj) { *(f32x4*)(op + bj * HALF) = acc[ai][bj][m][0] * rinv * gv[bj][0]; *(f32x4*)(op + bj * HALF + 4) = acc[ai][bj][m][1] * rinv * gv[bj][1]; } }
    }
};
struct EpiGateBranch {
    static constexpr bool PERM = true;
    struct State { unsigned g8[2][2][4][2]; };
    bf16_t* mixed; const float* bgate; const float* rowss; LAS unsigned* glds; int pm_tab, pd_tab; unsigned tab, btab;
    __device__ __forceinline__ void operator()(const f32x4 (&acc)[2][2][4][2], State& st, const Unit& u, int wr, int wc, int fr, int fq) const {
        asm volatile("" : "+v"(fr), "+v"(fq));
        const int rl0 = wr * 64 + fr, cl0 = wc * 32 + 8 * fq, n = u.pn >> 2, pd = u.pn & 3;
        LAS unsigned* gl = glds + (wr * 4 + wc) * 512 + (fq * 16 + fr) * 8;
        if (u.kind == 0) {
            f32x4 bv[2][2]; float rv[2][4];
            if (u.pm == pm_tab && pd == pd_tab) {
#pragma unroll
                for (int bj = 0; bj < 2; ++bj)
#pragma unroll
                    for (int q = 0; q < 2; ++q) bv[bj][q] = lds_read4(btab + (unsigned)(n * 256 + cl0 + bj * HALF + 4 * q) * 4u);
#pragma unroll
                for (int ai = 0; ai < 2; ++ai)
#pragma unroll
                    for (int m = 0; m < 4; ++m) rv[ai][m] = lds_rinv_read(tab + (unsigned)(rl0 + ai * HALF + m * 16) * 4u);
                asm volatile("s_waitcnt lgkmcnt(0)" : "+v"(bv[0][0]), "+v"(bv[0][1]), "+v"(bv[1][0]), "+v"(bv[1][1]), "+v"(rv[0][0]), "+v"(rv[0][1]), "+v"(rv[0][2]), "+v"(rv[0][3]), "+v"(rv[1][0]), "+v"(rv[1][1]), "+v"(rv[1][2]), "+v"(rv[1][3]));
            } else {
#pragma unroll
                for (int bj = 0; bj < 2; ++bj)
#pragma unroll
                    for (int q = 0; q < 2; ++q) bv[bj][q] = *(const f32x4*)(bgate + u.pn * BM + cl0 + bj * HALF + 4 * q);
#pragma unroll
                for (int ai = 0; ai < 2; ++ai)
#pragma unroll
                    for (int m = 0; m < 4; ++m) rv[ai][m] = row_rinv(rowss, u.pm * BM + rl0 + ai * HALF + m * 16, fq);
            }
#pragma unroll
            for (int ai = 0; ai < 2; ++ai)
#pragma unroll
                for (int m = 0; m < 4; ++m) {
                    const float rinv = rv[ai][m];
#pragma unroll
                    for (int bj = 0; bj < 2; ++bj)
#pragma unroll
                        for (int q = 0; q < 2; ++q) { const f32x4 v = acc[ai][bj][m][q] * rinv + bv[bj][q]; unsigned w = 0u;
#pragma unroll
                            for (int e = 0; e < 4; ++e) w |= (unsigned)(sigmoidf_(v[e]) * 255.0f + 0.5f) << (8 * e);
                            if (ai == 1 && bj == 1) gl[m * 2 + q] = w; else st.g8[ai][bj][m][q] = w; } }
        } else {
#pragma unroll
            for (int ai = 0; ai < 2; ++ai) {
                u32x4 oo[4][2];
#pragma unroll
                for (int m = 0; m < 4; ++m) { const int rl = rl0 + ai * HALF + m * 16; const bf16_t* mp = mixed + (size_t)(u.pm * BM + rl) * 1024 + pd * 256 + cl0;
#pragma unroll
                    for (int bj = 0; bj < 2; ++bj) { oo[m][bj] = (u32x4){0u, 0u, 0u, 0u}; if (n > 0) oo[m][bj] = *(const u32x4*)(mp + bj * HALF); } }
                asm volatile("" ::: "memory");
#pragma unroll
                for (int m = 0; m < 4; ++m) { const int rl = rl0 + ai * HALF + m * 16; bf16_t* mp = mixed + (size_t)(u.pm * BM + rl) * 1024 + pd * 256 + cl0;
#pragma unroll
                    for (int bj = 0; bj < 2; ++bj) { const unsigned g0 = (ai == 1 && bj == 1) ? gl[m * 2] : st.g8[ai][bj][m][0], g1 = (ai == 1 && bj == 1) ? gl[m * 2 + 1] : st.g8[ai][bj][m][1]; const u32x4 o = oo[m][bj]; const f32x4 a0 = acc[ai][bj][m][0] * (1.0f / 255.0f), a1 = acc[ai][bj][m][1] * (1.0f / 255.0f);
                        float v[8];
                        v[0] = fmaf(a0[0], (float)(g0 & 255u), lo_f(o.x)); v[1] = fmaf(a0[1], (float)((g0 >> 8) & 255u), hi_f(o.x)); v[2] = fmaf(a0[2], (float)((g0 >> 16) & 255u), lo_f(o.y)); v[3] = fmaf(a0[3], (float)(g0 >> 24), hi_f(o.y));
                        v[4] = fmaf(a1[0], (float)(g1 & 255u), lo_f(o.z)); v[5] = fmaf(a1[1], (float)((g1 >> 8) & 255u), hi_f(o.z)); v[6] = fmaf(a1[2], (float)((g1 >> 16) & 255u), lo_f(o.w)); v[7] = fmaf(a1[3], (float)(g1 >> 24), hi_f(o.w));
                        u32x4 w; w.x = pk2(v[0], v[1]); w.y = pk2(v[2], v[3]); w.z = pk2(v[4], v[5]); w.w = pk2(v[6], v[7]);
                        *(u32x4*)(mp + bj * HALF) = w; } }
                asm volatile("" ::: "memory");
            }
        }
    }
};

template <class Epi, class Sched>
__device__ __forceinline__ void gemm_phase(LAS unsigned char* lds, const int lda, const int ldb, const Sched& S, const Epi& E) {
    const int tid = fresh_tid(), wid = __builtin_amdgcn_readfirstlane(tid >> 6), lane = tid & 63, wr = wid >> 2, wc = wid & 3, fr = lane & 15, fq = lane >> 4;
    unsigned voffA[2], voffB[2];
#pragma unroll
    for (int i = 0; i < 2; ++i) { int R, C; stage_rc(tid * 16 + i * 8192, R, C); const int Rb = Epi::PERM ? ((R & ~31) + perm32(R & 31)) : R;
        voffA[i] = (unsigned)(R * lda + C) * 2u; voffB[i] = (unsigned)(Rb * ldb + C) * 2u; }
    const size_t kstep = (size_t)(BK * 2);
    const size_t hstepA = (size_t)HALF * lda * 2, hstepB = (size_t)HALF * ldb * 2;
    const unsigned ldsw = (unsigned)wid * 1024u;
    const int aoff = lds_byte(wr * 64 + fr, fq * 8), boff = lds_byte(wc * 32 + fr, fq * 8);
#define PG8_SA(b, h) (((b) * 2 + (h)) * HTB)
#define PG8_SB(b, h) ((4 + (b) * 2 + (h)) * HTB)
#define PG8_STAGE(bufoff, gbase, voff) do { _Pragma("unroll") for (int _i = 0; _i < 2; ++_i) \
        __builtin_amdgcn_global_load_lds((const unsigned*)((const char*)(gbase) + (voff)[_i]), (LAS unsigned*)(lds + (bufoff) + ldsw + _i * 8192), 16, 0, 0); } while (0)
#define PG8_LDA(dst, b, h) do { _Pragma("unroll") for (int m = 0; m < 4; ++m) _Pragma("unroll") for (int k = 0; k < 2; ++k) dst[m][k] = *(const LAS bf16x8*)(lds + PG8_SA(b, h) + aoff + m * 2048 + k * 1024); } while (0)
#define PG8_LDB(dst, b, h) do { _Pragma("unroll") for (int n = 0; n < 2; ++n) _Pragma("unroll") for (int k = 0; k < 2; ++k) dst[n][k] = *(const LAS bf16x8*)(lds + PG8_SB(b, h) + boff + n * 2048 + k * 1024); } while (0)
#define PG8_MMA(ai, bj, At, Bt) do { __builtin_amdgcn_s_setprio(1); _Pragma("unroll") for (int m = 0; m < 4; ++m) _Pragma("unroll") for (int n = 0; n < 2; ++n) _Pragma("unroll") for (int k = 0; k < 2; ++k) \
        acc[ai][bj][m][n] = __builtin_amdgcn_mfma_f32_16x16x32_bf16(Bt[n][k], At[m][k], acc[ai][bj][m][n], 0, 0, 0); __builtin_amdgcn_s_setprio(0); } while (0)
#define PG8_WAIT_V(n) asm volatile("s_waitcnt vmcnt(" #n ")" ::: "memory")
#define PG8_WAIT_L(n) asm volatile("s_waitcnt lgkmcnt(" #n ")" ::: "memory")
#define PG8_BAR __builtin_amdgcn_s_barrier()
#define PG8_SCHED __builtin_amdgcn_sched_barrier(0)
    Unit cur, nxt; int ui = 0;
    if (!S.next(0, cur)) return;
    f32x4 acc[2][2][4][2];
#pragma unroll
    for (int a = 0; a < 2; ++a)
#pragma unroll
        for (int b = 0; b < 2; ++b)
#pragma unroll
            for (int m = 0; m < 4; ++m)
#pragma unroll
                for (int n = 0; n < 2; ++n) acc[a][b][m][n] = (f32x4){0.f, 0.f, 0.f, 0.f};
    bf16x8 At[4][2], B0[2][2], B1[2][2];
    typename Epi::State est;
    const char* cA = cur.a; const char* cB = cur.b;
    PG8_STAGE(PG8_SB(0, 0), cB, voffB); PG8_STAGE(PG8_SB(0, 1), cB + hstepB, voffB); PG8_STAGE(PG8_SA(0, 0), cA, voffA); PG8_STAGE(PG8_SA(0, 1), cA + hstepA, voffA);
    if (wr == 1) PG8_BAR;
    PG8_WAIT_V(2); PG8_BAR;
    PG8_STAGE(PG8_SB(1, 0), cB + kstep, voffB); PG8_STAGE(PG8_SA(1, 0), cA + kstep, voffA); PG8_STAGE(PG8_SB(1, 1), cB + hstepB + kstep, voffB);
    PG8_WAIT_V(6); PG8_BAR;
    for (;;) {
        const bool has_next = S.next(ui + 1, nxt);
        const char* nA = has_next ? nxt.a : cA; const char* nB = has_next ? nxt.b : cB;
        const int nt = cur.nt;
        for (int t = 0; t < nt; t += 2) {
            const bool last = (t == nt - 2);
            const char* a1 = cA + (size_t)(t + 1) * kstep;
            const char* a2 = last ? nA : cA + (size_t)(t + 2) * kstep; const char* b2 = last ? nB : cB + (size_t)(t + 2) * kstep;
            const char* a3 = a2 + kstep; const char* b3 = b2 + kstep;
            PG8_LDB(B0, 0, 0); PG8_LDB(B1, 0, 1); PG8_SCHED; PG8_LDA(At, 0, 0); PG8_STAGE(PG8_SA(1, 1), a1 + hstepA, voffA);
            PG8_WAIT_V(8); PG8_WAIT_L(0); PG8_BAR; PG8_MMA(0, 0, At, B0); PG8_MMA(0, 1, At, B1); PG8_BAR; PG8_SCHED;
            PG8_LDA(At, 0, 1); PG8_STAGE(PG8_SB(0, 0), b2, voffB); PG8_STAGE(PG8_SB(0, 1), b2 + hstepB, voffB); PG8_STAGE(PG8_SA(0, 0), a2, voffA);
            PG8_WAIT_V(8); PG8_WAIT_L(0); PG8_BAR; PG8_MMA(1, 0, At, B0); PG8_MMA(1, 1, At, B1); PG8_BAR; PG8_SCHED;
            PG8_LDB(B0, 1, 0); PG8_LDB(B1, 1, 1); PG8_SCHED; PG8_LDA(At, 1, 0); PG8_STAGE(PG8_SA(0, 1), a2 + hstepA, voffA);
            PG8_WAIT_V(8); PG8_WAIT_L(0); PG8_BAR; PG8_MMA(0, 0, At, B0); PG8_MMA(0, 1, At, B1); PG8_BAR; PG8_SCHED;
            PG8_LDA(At, 1, 1); PG8_STAGE(PG8_SB(1, 0), b3, voffB); PG8_STAGE(PG8_SB(1, 1), b3 + hstepB, voffB); PG8_STAGE(PG8_SA(1, 0), a3, voffA);
            PG8_WAIT_V(8); PG8_WAIT_L(0); PG8_BAR; PG8_MMA(1, 0, At, B0); PG8_MMA(1, 1, At, B1); PG8_BAR; PG8_SCHED;
        }
        if (wr == 0) PG8_BAR;
        E(acc, est, cur, wr, wc, fr, fq);
        if (!has_next) break;
#pragma unroll
        for (int a = 0; a < 2; ++a)
#pragma unroll
            for (int b = 0; b < 2; ++b)
#pragma unroll
                for (int m = 0; m < 4; ++m)
#pragma unroll
                    for (int n = 0; n < 2; ++n) acc[a][b][m][n] = (f32x4){0.f, 0.f, 0.f, 0.f};
        cur = nxt; cA = nA; cB = nB; ++ui;
        if (wr == 1) PG8_BAR;
    }
    PG8_WAIT_V(0);
    PG8_BAR;
#undef PG8_SA
#undef PG8_SB
#undef PG8_STAGE
#undef PG8_LDA
#undef PG8_LDB
#undef PG8_MMA
#undef PG8_WAIT_V
#undef PG8_WAIT_L
#undef PG8_BAR
#undef PG8_SCHED
}
}

namespace att {
constexpr int VP = 144;
typedef short v4i16_t __attribute__((ext_vector_type(4)));
__device__ __forceinline__ int crow(int i, int h) { return (i & 3) + 8 * (i >> 2) + 4 * h; }
__device__ __forceinline__ s16x4 vtr(const LAS unsigned char* p) { return __builtin_bit_cast(s16x4, __builtin_amdgcn_ds_read_tr16_b64_v4i16((LAS v4i16_t*)p)); }
#define MFMA32(a, b, c) __builtin_amdgcn_mfma_f32_32x32x16_bf16((a), (b), (c), 0, 0, 0)

template <int MODE>
__device__ __forceinline__ void unit(int layer, int b, int h, int qb, LAS unsigned char* lds) {
    const cargs_t ap = get_args();
    unsigned char* const ws_ = ap->ws;
    constexpr int DK = MODE == 1 ? 96 : 64, ND = DK / 16, KP = DK * 2 + 16, KBUF = 64 * KP, VBUF = 64 * VP;
    LAS unsigned char* Ks = lds; LAS unsigned char* Vs = lds + 2 * KBUF;
    LAS float* Fs = (LAS float*)(lds + 2 * KBUF + 2 * VBUF); LAS float* Tab = Fs + 128;
    const int tid = fresh_tid(), lane = tid & 63, wid = __builtin_amdgcn_readfirstlane(tid >> 6), r = lane & 31, hh = lane >> 5;
    const size_t tok0 = (size_t)b * SEQ;
    const int qw = qb * 256 + wid * 32, qc = qw >> 6;
    const bf16_t* PROJ = (const bf16_t*)(ws_ + WS_PROJ); const bf16_t* QKVB = (const bf16_t*)(ws_ + WS_QKVB); const bf16_t* KROT = (const bf16_t*)(ws_ + WS_KROT);
    const float* FCUM = (const float*)(ws_ + WS_FCUM) + (size_t)(b * 4 + h) * SEQ;
    bf16_t* BR = (bf16_t*)(ws_ + WS_BR);
    const bf16_t *Qp, *Kp, *Vp; int ldq, ldk;
    if (MODE == 0) { Qp = PROJ + C_AQ + h * 64; Kp = PROJ + C_AK + h * 64; Vp = PROJ + C_AV + h * 64; ldq = PLD; ldk = PLD; }
    else if (MODE == 2) { Qp = PROJ + C_CQ + h * 64; Kp = PROJ + C_CK + h * 64; Vp = PROJ + C_CV + h * 64; ldq = PLD; ldk = PLD; }
    else { Qp = QKVB + h * 96; Kp = QKVB + 512 + h * 128; Vp = Kp + 64; ldq = 1024; ldk = 1024; }
    const int t_lo = (MODE == 0) ? (qb * 4 - 8 > 0 ? qb * 4 - 8 : 0) : 0, t_hi = qb * 4 + 4;
    const float cs = (MODE == 1 ? 0.10206207261596577f : 0.125f) * LOG2E;

    u32x4 kregA, vregA, kr2A, kregB, vregB, kr2B; float fregA = 0.f, fregB = 0.f;
    const int srow = tid >> 3, sch = tid & 7;
#define ATT_LOAD(j, X) do { const int jl_ = (j) < t_lo ? t_lo : (j); const size_t trow = tok0 + (size_t)jl_ * 64; \
        kreg##X = *(const u32x4*)(Kp + (trow + srow) * ldk + sch * 8); vreg##X = *(const u32x4*)(Vp + (trow + srow) * ldk + sch * 8); \
        if (MODE == 1) { kr2##X = *(const u32x4*)(KROT + (trow + ((tid >> 2) & 63)) * 32 + (tid & 3) * 8); } \
        if (MODE == 2) { freg##X = FCUM[jl_ * 64 + (tid & 63)]; } } while (0)
#define ATT_STORE(s, X) do { *(LAS u32x4*)(Ks + (s) * KBUF + srow * KP + sch * 16) = kreg##X; *(LAS u32x4*)(Vs + (s) * VBUF + srow * VP + sch * 16) = vreg##X; \
        if (MODE == 1) { if (tid < 256) *(LAS u32x4*)(Ks + (s) * KBUF + (tid >> 2) * KP + 128 + (tid & 3) * 16) = kr2##X; } \
        if (MODE == 2) { if (tid < 64) Fs[(s) * 64 + tid] = freg##X * LOG2E; } } while (0)

    ATT_LOAD(t_hi - 1, A);
    ATT_LOAD(t_hi - 2, B);
    if (MODE == 0) { if (tid < 257) Tab[tid] = ap->rel_bias[(size_t)(layer * 4 + h) * 257 + tid] * LOG2E; }
    bf16x8 qf[ND];
    { const bf16_t* qrow = Qp + (tok0 + qw + r) * ldq;
#pragma unroll
      for (int d0 = 0; d0 < ND; ++d0) qf[d0] = *(const bf16x8*)(qrow + d0 * 16 + hh * 8); }
    if (MODE == 1) {
        const float pos = (float)ap->pos[tok0 + qw + r];
#pragma unroll
        for (int j = 0; j < 8; ++j) {
            const float invf = exp2f(-(float)(8 * hh + j) * 0.8304820237218406f);
            const float ang = pos * invf, kk = rintf(ang * 0.15915494309189535f);
            float rem = fmaf(-kk, 6.2831854820251465f, ang); rem = fmaf(kk, 1.7484555e-7f, rem);
            const float sn = __sinf(rem), cn = __cosf(rem);
            const float x1 = bf2f((unsigned short)qf[4][j]), x2 = bf2f((unsigned short)qf[5][j]);
            const unsigned w = pk2(x1 * cn - x2 * sn, x2 * cn + x1 * sn);
            qf[4][j] = (short)(w & 0xffffu); qf[5][j] = (short)(w >> 16);
        }
    }
    float fq = 0.f;
    if (MODE == 2) fq = FCUM[qw + r] * LOG2E;
    float m_run = -INFINITY, l_run = 0.f;
    f32x16 o0, o1;
#pragma unroll
    for (int i = 0; i < 16; ++i) { o0[i] = 0.f; o1[i] = 0.f; }
    ATT_STORE(0, A);
    __syncthreads();
    const int i16 = lane & 15, vq = i16 >> 2, vp = i16 & 3, vblk = (lane >> 4) & 1;
    const int voff = (4 * hh + vq) * VP + vblk * 32 + vp * 8;

    auto compute = [&](const int j, const int s) __attribute__((always_inline)) {
        const bool active = (MODE == 0) ? (j <= qc && j >= qc - 8) : (j <= qc);
        if (active) {
            const LAS unsigned char* kb = Ks + s * KBUF + r * KP + hh * 16;
            f32x16 p0, p1;
#pragma unroll
            for (int i = 0; i < 16; ++i) { p0[i] = 0.f; p1[i] = 0.f; }
#pragma unroll
            for (int d0 = 0; d0 < ND; ++d0) {
                const bf16x8 kf0 = *(const LAS bf16x8*)(kb + d0 * 32), kf1 = *(const LAS bf16x8*)(kb + 32 * KP + d0 * 32);
                p0 = MFMA32(kf0, qf[d0], p0); p1 = MFMA32(kf1, qf[d0], p1);
            }
            if (MODE == 0) {
                const int delta = qc - j;
                if (delta >= 3) { const float cb = Tab[256];
#pragma unroll
                    for (int i = 0; i < 16; ++i) { p0[i] = fmaf(p0[i], cs, cb); p1[i] = fmaf(p1[i], cs, cb); }
                } else { const int brel = 64 * delta + (qw & 63) + r + 128;
#pragma unroll
                    for (int i = 0; i < 16; ++i) { const int kj = crow(i, hh); int i0 = brel - kj, i1 = brel - kj - 32;
                        i0 = i0 < 0 ? 0 : (i0 > 256 ? 256 : i0); i1 = i1 < 0 ? 0 : (i1 > 256 ? 256 : i1);
                        p0[i] = fmaf(p0[i], cs, Tab[i0]); p1[i] = fmaf(p1[i], cs, Tab[i1]); }
                }
            } else if (MODE == 1) {
#pragma unroll
                for (int i = 0; i < 16; ++i) { p0[i] *= cs; p1[i] *= cs; }
            } else {
                const LAS float* fs = Fs + s * 64 + 4 * hh;
#pragma unroll
                for (int g = 0; g < 4; ++g) { const f32x4 f0 = *(const LAS f32x4*)(fs + 8 * g), f1 = *(const LAS f32x4*)(fs + 32 + 8 * g);
#pragma unroll
                    for (int e = 0; e < 4; ++e) { p0[4 * g + e] = fmaf(p0[4 * g + e], cs, fq - f0[e]); p1[4 * g + e] = fmaf(p1[4 * g + e], cs, fq - f1[e]); } }
                if (j == qc) { const int qrel = (qw & 63) + r;
#pragma unroll
                    for (int i = 0; i < 16; ++i) { const int kj = crow(i, hh); if (kj > qrel) p0[i] = -INFINITY; if (kj + 32 > qrel) p1[i] = -INFINITY; } }
            }
            float mx = p0[0];
#pragma unroll
            for (int i = 1; i < 16; ++i) mx = fmaxf(mx, p0[i]);
#pragma unroll
            for (int i = 0; i < 16; ++i) mx = fmaxf(mx, p1[i]);
            { auto rr = __builtin_amdgcn_permlane32_swap(__float_as_uint(mx), __float_as_uint(mx), false, false); mx = fmaxf(__uint_as_float(rr[0]), __uint_as_float(rr[1])); }
            if (__all(mx < m_run - 40.f)) return;
            if (__any(mx > m_run)) {
                const float m_new = fmaxf(m_run, mx);
                const float alpha = __builtin_amdgcn_exp2f(m_run - m_new);
                m_run = m_new; l_run *= alpha;
#pragma unroll
                for (int i = 0; i < 16; ++i) { o0[i] *= alpha; o1[i] *= alpha; }
            }
            float sum = 0.f;
#pragma unroll
            for (int i = 0; i < 16; ++i) { p0[i] = __builtin_amdgcn_exp2f(p0[i] - m_run); p1[i] = __builtin_amdgcn_exp2f(p1[i] - m_run); sum += p0[i] + p1[i]; }
            l_run += sum;
            const LAS unsigned char* vb = Vs + s * VBUF + voff;
#pragma unroll
            for (int kbk = 0; kbk < 2; ++kbk)
#pragma unroll
                for (int st = 0; st < 2; ++st) {
                    const f32x16& pp = kbk ? p1 : p0;
                    u32x4 pw; pw.x = pk2(pp[8 * st + 0], pp[8 * st + 1]); pw.y = pk2(pp[8 * st + 2], pp[8 * st + 3]); pw.z = pk2(pp[8 * st + 4], pp[8 * st + 5]); pw.w = pk2(pp[8 * st + 6], pp[8 * st + 7]);
                    const bf16x8 pf = __builtin_bit_cast(bf16x8, pw);
                    const LAS unsigned char* vr = vb + (32 * kbk + 16 * st) * VP;
                    const s16x4 a_lo = vtr(vr), a_hi = vtr(vr + 8 * VP), b_lo = vtr(vr + 64), b_hi = vtr(vr + 8 * VP + 64);
                    const bf16x8 v0 = __builtin_shufflevector(a_lo, a_hi, 0, 1, 2, 3, 4, 5, 6, 7), v1 = __builtin_shufflevector(b_lo, b_hi, 0, 1, 2, 3, 4, 5, 6, 7);
                    o0 = MFMA32(v0, pf, o0); o1 = MFMA32(v1, pf, o1);
                }
        }
    };
    for (int j = t_hi - 1; j >= t_lo; j -= 2) {
        ATT_LOAD(j - 2, A);
        compute(j, 0);
        ATT_STORE(1, B);
        __syncthreads();
        ATT_LOAD(j - 3, B);
        compute(j - 1, 1);
        ATT_STORE(0, A);
        __syncthreads();
    }
    const float l_tot = l_run + __shfl_xor(l_run, 32);
    const float inv = 1.0f / l_tot;
    bf16_t* dst = BR + (tok0 + qw + r) * 1024 + (MODE == 0 ? 0 : (MODE == 1 ? 256 : 512)) + h * 64 + 4 * hh;
#pragma unroll
    for (int g = 0; g < 4; ++g) {
        u32x2 w0, w1;
        w0.x = pk2(o0[4 * g] * inv, o0[4 * g + 1] * inv); w0.y = pk2(o0[4 * g + 2] * inv, o0[4 * g + 3] * inv);
        w1.x = pk2(o1[4 * g] * inv, o1[4 * g + 1] * inv); w1.y = pk2(o1[4 * g + 2] * inv, o1[4 * g + 3] * inv);
        *(u32x2*)(dst + 8 * g) = w0; *(u32x2*)(dst + 32 + 8 * g) = w1;
    }
#undef ATT_LOAD
#undef ATT_STORE
}
}

__device__ __forceinline__ void transpose_item(const float* W, int N, int nblk, bf16_t* WT, int ldt, LAS float* scr, int item, int lane, const float* gk = nullptr) {
    const int kb = item / nblk, nb = item % nblk, k0 = 64 * kb, n0 = 32 * nb;
    const int nn = n0 + (lane & 31); const bool ok = nn < N;
    float tmp[32];
#pragma unroll
    for (int i = 0; i < 32; ++i) { const int kk = 2 * i + (lane >> 5); tmp[i] = ok ? W[(size_t)(k0 + kk) * N + nn] : 0.f; }
#pragma unroll
    for (int i = 0; i < 32; ++i) { const int kk = 2 * i + (lane >> 5); scr[kk * 33 + (lane & 31)] = tmp[i]; }
    LDS_WAIT(); asm volatile("" ::: "memory");
    const int c = lane & 7;
    f32x4 ga = {1.f, 1.f, 1.f, 1.f}, gb = ga;
    if (gk) { ga = *(const f32x4*)(gk + k0 + 8 * c); gb = *(const f32x4*)(gk + k0 + 8 * c + 4); }
#pragma unroll
    for (int j = 0; j < 4; ++j) { const int n = (lane >> 3) + 8 * j; const LAS float* s = scr + (8 * c) * 33 + n;
        u32x4 o; o.x = pk2(s[0 * 33] * ga.x, s[1 * 33] * ga.y); o.y = pk2(s[2 * 33] * ga.z, s[3 * 33] * ga.w); o.z = pk2(s[4 * 33] * gb.x, s[5 * 33] * gb.y); o.w = pk2(s[6 * 33] * gb.z, s[7 * 33] * gb.w);
        *(u32x4*)(WT + (size_t)(n0 + n) * ldt + k0 + 8 * c) = o; }
    LDS_WAIT(); asm volatile("" ::: "memory");
}
__device__ __forceinline__ void prenorm_row(const float* xrow, bf16_t* orow, float* rowss, int lane) {
    const f32x4* xr = (const f32x4*)xrow + lane;
    f32x4 v[4]; float s = 0.f;
#pragma unroll
    for (int j = 0; j < 4; ++j) { v[j] = xr[64 * j]; s += (v[j].x * v[j].x + v[j].y * v[j].y) + (v[j].z * v[j].z + v[j].w * v[j].w); }
    s = wave_sum(s); if (lane < 16) rowss[lane] = (lane == 0) ? s : 0.f;
#pragma unroll
    for (int j = 0; j < 4; ++j) { u32x2 w; w.x = pk2(v[j].x, v[j].y); w.y = pk2(v[j].z, v[j].w); ((u32x2*)orow)[lane + 64 * j] = w; }
}
__device__ __forceinline__ float logsig(float z) { return fminf(z, 0.f) - __logf(1.0f + __expf(-fabsf(z))); }


constexpr int I_G = 16 * 128, I_B = 4 * 32, I_O = 16 * 32, I_U = 16 * 128, I_D = 64 * 32, N_LATE_ITEMS = I_G + 4 * I_B + I_O + I_U + I_D;
__device__ __forceinline__ void late_weight_item(int l, int r, LAS float* scr, int lane) {
    const cargs_t ap = get_args(); unsigned char* const ws = ap->ws;
    if (r < I_G) { transpose_item(ap->w_gate + (size_t)l * 1024 * 4096, 4096, 128, (bf16_t*)(ws + WS_WGT), 1024, scr, r, lane, ap->g_mix + l * 1024); return; } r -= I_G;
    if (r < 4 * I_B) { const int n = r / I_B; transpose_item(ap->w_branch + (size_t)l * 4 * 256 * 1024 + (size_t)n * 256 * 1024, 1024, 32, (bf16_t*)(ws + WS_WBT) + (size_t)n * 1024 * 1024 + n * 256, 1024, scr, r % I_B, lane); return; } r -= 4 * I_B;
    if (r < I_O) { transpose_item(ap->w_o + (size_t)l * 1024 * 1024, 1024, 32, (bf16_t*)(ws + WS_WOT), 1024, scr, r, lane); return; } r -= I_O;
    if (r < I_U) { transpose_item(ap->w_up + (size_t)l * 1024 * 4096, 4096, 128, (bf16_t*)(ws + WS_W1T), 1024, scr, r, lane, ap->g_ffn + l * 1024); return; } r -= I_U;
    transpose_item(ap->w_down + (size_t)l * 4096 * 1024, 1024, 32, (bf16_t*)(ws + WS_W2T), 4096, scr, r, lane);
}
__device__ __forceinline__ void conv_tokens(int l, int t0, int lane) {
    const cargs_t ap = get_args(); unsigned char* const ws = ap->ws;
    const bf16_t* U = (const bf16_t*)(ws + WS_U); bf16_t* BR = (bf16_t*)(ws + WS_BR);
    const float* wdw = ap->w_dw + (size_t)l * 31 * 256; const f32x4 bdw = *(const f32x4*)(ap->b_dw + l * 256 + 4 * lane);
    const f32x4 gln = *(const f32x4*)(ap->g_conv_ln + l * 256 + 4 * lane), bln = *(const f32x4*)(ap->b_conv_ln + l * 256 + 4 * lane);
    const int ts0 = t0 & (SEQ - 1);
    const float* wl = wdw + 4 * lane; asm volatile("" : "+v"(wl));
    u32x2 ur[38];
#pragma unroll
    for (int i = 0; i < 38; ++i) { const int tt = ts0 - 30 + i; ur[i] = (u32x2){0u, 0u}; if (tt >= 0) ur[i] = *(const u32x2*)(U + (size_t)(t0 - 30 + i) * 256 + 4 * lane); }
    f32x4 acc[8];
#pragma unroll
    for (int j = 0; j < 8; ++j) acc[j] = bdw;
#pragma unroll
    for (int k = 0; k < 31; ++k) { const f32x4 w = *(const f32x4*)(wl + k * 256);
#pragma unroll
        for (int j = 0; j < 8; ++j) { const u32x2 u = ur[j + k];
            acc[j].x = fmaf(lo_f(u.x), w.x, acc[j].x); acc[j].y = fmaf(hi_f(u.x), w.y, acc[j].y); acc[j].z = fmaf(lo_f(u.y), w.z, acc[j].z); acc[j].w = fmaf(hi_f(u.y), w.w, acc[j].w); } }
#pragma unroll
    for (int j = 0; j < 8; ++j) {
        const float mean = wave_sum((acc[j].x + acc[j].y) + (acc[j].z + acc[j].w)) * (1.0f / 256.0f);
        const f32x4 d = acc[j] - mean;
        const float rstd = 1.0f / sqrtf(wave_sum((d.x * d.x + d.y * d.y) + (d.z * d.z + d.w * d.w)) * (1.0f / 256.0f) + EPS);
        const f32x4 y = d * rstd * gln + bln;
        u32x2 o; o.x = pk2(y.x * sigmoidf_(y.x), y.y * sigmoidf_(y.y)); o.y = pk2(y.z * sigmoidf_(y.z), y.w * sigmoidf_(y.w));
        *(u32x2*)(BR + (size_t)(t0 + j) * 1024 + 768 + 4 * lane) = o;
    }
}

__device__ __forceinline__ void win_item(int l, int r, LAS float* scr, int lane) {
    const cargs_t ap = get_args();
    transpose_item(ap->w_in + (size_t)l * 1024 * INC, INC, 80, (bf16_t*)(ap->ws + (l == 0 ? WS_WINT : WS_WINT1)), 1024, scr, r, lane, ap->g_mix + l * 1024);
}
__device__ __forceinline__ void wlat_chunk(int l, int c) {
    const cargs_t ap = get_args();
    const float* w_uq = ap->w_uq + (size_t)l * 256 * 384; const float* w_ukv = ap->w_ukv + (size_t)l * 128 * 512; const float* gq = ap->g_q_lat + l * 256; const float* gkv = ap->g_kv_lat + l * 128;
    const int n = c / 48, k0 = (c % 48) * 8; float v[8];
#pragma unroll
    for (int e = 0; e < 8; ++e) { const int k = k0 + e; v[e] = (n < 384 && k < 256) ? gq[k] * w_uq[(size_t)k * 384 + n] : ((n >= 512 && k >= 256) ? gkv[k - 256] * w_ukv[(size_t)(k - 256) * 512 + (n - 512)] : 0.f); }
    u32x4 o; o.x = pk2(v[0], v[1]); o.y = pk2(v[2], v[3]); o.z = pk2(v[4], v[5]); o.w = pk2(v[6], v[7]);
    *(u32x4*)((bf16_t*)(ap->ws + (l == 0 ? WS_WLT : WS_WLT1)) + (size_t)n * 384 + k0) = o;
}

#define XB_TMO      128
#define XB_XCNT(j)  (256  + 64 * (j))
#define XB_XSUB(j)  (1280 + 64 * (j))
#define XB_XGEN(j)  (2304 + 64 * (j))
#define XB_TOP      3328
#define XB_TOPGEN   3392
#define XCD_BAR_WORDS 3456
#define XB_SPIN_CAP (1u << 18)
__device__ __forceinline__ unsigned xb_ld(unsigned* p)              { return __hip_atomic_load(p, __ATOMIC_RELAXED, __HIP_MEMORY_SCOPE_AGENT); }
__device__ __forceinline__ unsigned xb_add(unsigned* p, unsigned v) { return __hip_atomic_fetch_add(p, v, __ATOMIC_RELAXED, __HIP_MEMORY_SCOPE_AGENT); }
__device__ __forceinline__ unsigned xb_xcc_id() { return (unsigned)__builtin_amdgcn_s_getreg((3 << 11) | 20) & 0xFu; }
#define XB_SPIN(cond, bar) do { unsigned _sp = 0; while (cond) { __builtin_amdgcn_s_sleep(1); \
    if ((++_sp & 255u) == 0u) { if (xb_ld(&(bar)[XB_TMO])) break; if (_sp > XB_SPIN_CAP) { atomicAdd(&(bar)[XB_TMO], 1u); break; } } } } while (0)
struct XcdBarrier { unsigned* bar; unsigned x; volatile LAS unsigned* st; };
__device__ __forceinline__ void xcd_barrier_complete(unsigned* bar, unsigned x, unsigned& nloc, unsigned& nx) {
    const unsigned G = gridDim.x * gridDim.y * gridDim.z;
    unsigned sum, cnt, mine, sp = 0u;
    for (;;) {
        sum = 0u; cnt = 0u; mine = 0u;
#pragma unroll
        for (unsigned j = 0; j < 16; ++j) { const unsigned c = xb_ld(&bar[XB_XCNT(j)]); sum += c; cnt += (c > 0u) ? 1u : 0u; mine = (j == x) ? c : mine; }
        if (sum == G) break;
        __builtin_amdgcn_s_sleep(1);
        if ((++sp & 255u) == 0u) { if (xb_ld(&bar[XB_TMO])) break; if (sp > XB_SPIN_CAP) { atomicAdd(&bar[XB_TMO], 1u); break; } }
    }
    nloc = mine > 0u ? mine : 1u; nx = cnt > 0u ? cnt : 1u;
}
__device__ __forceinline__ void xcd_barrier(const XcdBarrier& b) {
    asm volatile("s_waitcnt vmcnt(0)" ::: "memory");
    __syncthreads();
    if (threadIdx.x == 0) {
        unsigned* bar = b.bar;
        __builtin_amdgcn_s_waitcnt(0);
        unsigned nloc = b.st[0], nx = b.st[1];
        if (nloc == 0u) { xcd_barrier_complete(bar, b.x, nloc, nx); b.st[0] = nloc; b.st[1] = nx; }
        const unsigned old = xb_add(&bar[XB_XSUB(b.x)], 1u);
        const unsigned gen = old / nloc;
        if (old + 1u == (gen + 1u) * nloc) {
            __builtin_amdgcn_fence(__ATOMIC_RELEASE, "agent");
            asm volatile("s_waitcnt vmcnt(0)" ::: "memory");
            const unsigned og = xb_add(&bar[XB_TOP], 1u);
            const unsigned tg = og / nx;
            if (og + 1u == (tg + 1u) * nx) xb_add(&bar[XB_TOPGEN], 1u);
            else XB_SPIN(xb_ld(&bar[XB_TOPGEN]) == tg, bar);
            __builtin_amdgcn_fence(__ATOMIC_ACQUIRE, "agent");
            xb_add(&bar[XB_XGEN(b.x)], 1u);
            asm volatile("s_waitcnt vmcnt(0)" ::: "memory");
        } else {
            XB_SPIN(xb_ld(&bar[XB_XGEN(b.x)]) == gen, bar);
            __builtin_amdgcn_fence(__ATOMIC_ACQUIRE, "agent");
            asm volatile("s_waitcnt vmcnt(0)" ::: "memory");
        }
    }
    __syncthreads();
}
constexpr int CTL_BAR_WORD = 4096;
constexpr int LDS_MISC = 131072 + 128;
#define GRID_BAR() do { const cargs_t ap_ = get_args(); XcdBarrier b_; b_.bar = (unsigned*)(ap_->ws + WS_CTL) + CTL_BAR_WORD; b_.x = xb_xcc_id(); \
    b_.st = (volatile LAS unsigned*)(lds + LDS_MISC); xcd_barrier(b_); } while (0)

#define WSP(T, off) ((T*)(ws + (off)))
#define REP_P1 1
#define REP_P2 1
#define REP_P3 1
#define REP_P4 1
#define REP_P5 1
#define REP_P6 1
#define REP_P7 1
#define REP_P8 1
#define REP_P9 1
#define REP_P10 1
#define REP_SYNC 0
#define PHASE_BEGIN(R) _Pragma("unroll 1") for (int rep = 0; rep < (R); ++rep) {
#define PHASE_END GRID_BAR(); }
__global__ void __launch_bounds__(512, 2) fwd_megakernel(Args A_unused) {
    extern __shared__ __attribute__((aligned(16))) unsigned char lds_raw[];
    LAS unsigned char* lds = (LAS unsigned char*)lds_raw;
    {
        if (threadIdx.x < 8) ((LAS unsigned*)(lds + LDS_MISC))[threadIdx.x] = 0u;
        __syncthreads();
        const cargs_t ap = get_args();
        if (threadIdx.x == 0) (void)xb_add((unsigned*)(ap->ws + WS_CTL) + CTL_BAR_WORD + XB_XCNT(xb_xcc_id()), 1u);
    }
    cg::this_grid().sync();

#pragma unroll 1
    for (int l = 0; l < 2; ++l) {
        if (l == 0) {
        PHASE_BEGIN(REP_P1)
            const cargs_t ap = get_args(); unsigned char* const ws = ap->ws;
            const int tid = fresh_tid(), lane = tid & 63, wid = __builtin_amdgcn_readfirstlane(tid >> 6), G = gridDim.x, bx = blockIdx.x, gw = bx * 8 + wid, NGW = G * 8;
            LAS float* scr = (LAS float*)(lds + wid * 16384);
            for (int it = gw; it < 1280; it += NGW) win_item(0, it, scr, lane);
            for (int c = bx * 512 + tid; c < 1024 * 48; c += G * 512) wlat_chunk(0, c);
            const float* xin = ap->x; bf16_t* XN = WSP(bf16_t, WS_XN); float* rss = WSP(float, WS_ROWSS);
            for (int m = gw; m < TOK; m += NGW) prenorm_row(xin + (size_t)m * 1024, XN + (size_t)m * 1024, rss + (size_t)m * 16, lane);
        GRID_BAR(); }
        }
        PHASE_BEGIN(REP_P2)
            const cargs_t ap = get_args(); unsigned char* const ws = ap->ws;
            const char* hin = (l == 0) ? WSP(const char, WS_XN) : (const char*)ap->out;
            pg8::PlainOrder S{hin, (l == 0) ? WSP(const char, WS_WINT) : WSP(const char, WS_WINT1), 1024, 1024, 64, 10, 16, (int)gridDim.x, (int)blockIdx.x};
            const float* slots = WSP(const float, WS_ROWSS) + (size_t)(l * 2) * ROWSS_STRIDE;
            pg8::Unit u0; int pm0 = -1; if (S.next(0, u0)) { pm0 = u0.pm; fill_rinv_table(lds, slots, pm0); }
            pg8::EpiBf16<0, 1, true> E{WSP(bf16_t, WS_PROJ), PLD, slots, pm0, (unsigned)(uintptr_t)(lds + LDS_RINV), WSP(float, WS_LATSS)};
            pg8::gemm_phase(lds, 1024, 1024, S, E);
        PHASE_END
        PHASE_BEGIN(REP_P3)
            const cargs_t ap = get_args(); unsigned char* const ws = ap->ws;
            const int tid = fresh_tid(), lane = tid & 63, wid = __builtin_amdgcn_readfirstlane(tid >> 6), G = gridDim.x, bx = blockIdx.x, gw = bx * 8 + wid, NGW = G * 8;
            const bf16_t* PROJ = WSP(const bf16_t, WS_PROJ);
            if (bx < 16) {
                const int b = bx >> 2, h = bx & 3; const float bf = ap->b_forget[l * 4 + h];
                const bf16_t* src = PROJ + ((size_t)b * SEQ + tid * 8) * PLD + C_CF + h;
                float v[8];
#pragma unroll
                for (int i = 0; i < 8; ++i) v[i] = bf2f(src[(size_t)i * PLD]);
#pragma unroll
                for (int i = 0; i < 8; ++i) { v[i] = logsig(v[i] + bf); if (i) v[i] += v[i - 1]; }
                float incl = v[7];
#pragma unroll
                for (int o = 1; o < 64; o <<= 1) { const float u = __shfl_up(incl, o); if (lane >= o) incl += u; }
                LAS float* wtot = (LAS float*)(lds + 131072 + 64);
                if (lane == 63) wtot[wid] = incl;
                __syncthreads();
                float off = incl - v[7];
                for (int w = 0; w < wid; ++w) off += wtot[w];
                float* dst = WSP(float, WS_FCUM) + (size_t)(b * 4 + h) * SEQ + tid * 8;
                f32x4 o0 = {v[0] + off, v[1] + off, v[2] + off, v[3] + off}, o1 = {v[4] + off, v[5] + off, v[6] + off, v[7] + off};
                *(f32x4*)dst = o0; *(f32x4*)(dst + 4) = o1;
            }
            const int* posp = ap->pos;
            bf16_t* KROT = WSP(bf16_t, WS_KROT); bf16_t* U = WSP(bf16_t, WS_U);
            const float invf = exp2f(-(float)(lane & 15) * 0.8304820237218406f);
            for (int t0 = gw * 4; t0 < TOK; t0 += NGW * 4) {
                u32x2 dv4[4], dg4[4]; float x14[4], x24[4], pos4[4];
#pragma unroll
                for (int j = 0; j < 4; ++j) { const bf16_t* row = PROJ + (size_t)(t0 + j) * PLD;
                    dv4[j] = *(const u32x2*)(row + C_DV + 4 * lane); dg4[j] = *(const u32x2*)(row + C_DG + 4 * lane);
                    x14[j] = bf2f(row[C_BKR + (lane & 15)]); x24[j] = bf2f(row[C_BKR + 16 + (lane & 15)]); pos4[j] = (float)posp[t0 + j]; }
#pragma unroll
                for (int j = 0; j < 4; ++j) { const int t = t0 + j;
                    if (lane < 16) {
                        const float ang = pos4[j] * invf, kk = rintf(ang * 0.15915494309189535f);
                        float rem = fmaf(-kk, 6.2831854820251465f, ang); rem = fmaf(kk, 1.7484555e-7f, rem);
                        const float sn = __sinf(rem), cn = __cosf(rem);
                        const unsigned w = pk2(x14[j] * cn - x24[j] * sn, x24[j] * cn + x14[j] * sn);
                        KROT[(size_t)t * 32 + lane] = (bf16_t)(w & 0xffffu); KROT[(size_t)t * 32 + 16 + lane] = (bf16_t)(w >> 16);
                    }
                    {
                        const u32x2 v = dv4[j], gt = dg4[j];
                        u32x2 o; o.x = pk2(lo_f(v.x) * sigmoidf_(lo_f(gt.x)), hi_f(v.x) * sigmoidf_(hi_f(gt.x))); o.y = pk2(lo_f(v.y) * sigmoidf_(lo_f(gt.y)), hi_f(v.y) * sigmoidf_(hi_f(gt.y)));
                        *(u32x2*)(U + (size_t)t * 256 + 4 * lane) = o;
                    }
                }
            }
            { const cargs_t ap2 = get_args(); unsigned char* const ws = ap2->ws;
              pg8::PlainOrder S{WSP(const char, WS_PROJ) + C_BQL * 2, (l == 0) ? WSP(const char, WS_WLT) : WSP(const char, WS_WLT1), PLD, 384, 64, 4, 6, (int)gridDim.x, (int)blockIdx.x};
              pg8::EpiBf16<0, 2> E{WSP(bf16_t, WS_QKVB), 1024, nullptr, -1, 0u, WSP(float, WS_LATSS)};
              pg8::gemm_phase(lds, PLD, 384, S, E); }
        PHASE_END
        PHASE_BEGIN(REP_P5)
            LAS int* wq = (LAS int*)(lds + 131072);
            for (;;) {
                __syncthreads();
                if (threadIdx.x == 0) { const cargs_t ap = get_args(); wq[0] = atomicAdd((int*)(ap->ws + WS_CTL) + 16 * (l * 8 + rep), 1); }
                __syncthreads();
                const int it = wq[0];
                if (it >= 768 + 256 + N_LATE_ITEMS / 16 + (l == 0 ? 80 + 96 : 0)) break;
                if (it >= 768) {
                    const int tidq = fresh_tid(), laneq = tidq & 63, widq = __builtin_amdgcn_readfirstlane(tidq >> 6);
                    if (it < 1024) conv_tokens(l, ((it - 768) * 8 + widq) * 8, laneq);
                    else if (it >= 1024 + N_LATE_ITEMS / 16) {
                        const int e = it - (1024 + N_LATE_ITEMS / 16);
                        if (e < 80) { LAS float* scr = (LAS float*)(lds + widq * 16384); win_item(l + 1, e * 16 + widq * 2, scr, laneq); win_item(l + 1, e * 16 + widq * 2 + 1, scr, laneq); }
                        else wlat_chunk(l + 1, (e - 80) * 512 + tidq);
                    }
                    else { LAS float* scr = (LAS float*)(lds + widq * 16384); const int r0 = (it - 1024) * 16 + widq * 2; late_weight_item(l, r0, scr, laneq); late_weight_item(l, r0 + 1, scr, laneq); }
                    continue;
                }
                int mode, bh, qb;
                if (it >= 384 && it < 640) { const int a = it - 384; mode = 0; bh = a & 15; qb = a >> 4; }
                else { const int k = it < 384 ? it : it - 256; const int lvl = k >> 5, w = k & 31; qb = 15 - lvl; mode = (w < 16) ? 1 : 2; bh = w & 15; }
                if (mode == 0) att::unit<0>(l, bh >> 2, bh & 3, qb, lds);
                else if (mode == 1) att::unit<1>(l, bh >> 2, bh & 3, qb, lds);
                else att::unit<2>(l, bh >> 2, bh & 3, qb, lds);
            }
        PHASE_END
        PHASE_BEGIN(REP_P6)
            const cargs_t ap = get_args(); unsigned char* const ws = ap->ws;
            const char* hin = (l == 0) ? WSP(const char, WS_XN) : (const char*)ap->out;
            pg8::GateBranchOrder S{hin, WSP(const char, WS_BR), WSP(const char, WS_WGT), WSP(const char, WS_WBT), (int)gridDim.x, (int)blockIdx.x};
            const float* slots = WSP(const float, WS_ROWSS) + (size_t)(l * 2) * ROWSS_STRIDE; const float* bg = ap->b_gate + (size_t)l * 4096;
            pg8::Unit u0; int pm0 = -1, pd0 = -1;
            if (S.next(0, u0)) { pm0 = u0.pm; pd0 = u0.pn & 3; const int t = fresh_tid();
                ((LAS float*)(lds + LDS_BIAS))[t] = bg[(t >> 8) * 1024 + pd0 * 256 + (t & 255)]; ((LAS float*)(lds + LDS_BIAS))[t + 512] = bg[((t + 512) >> 8) * 1024 + pd0 * 256 + (t & 255)];
                fill_rinv_table(lds, slots, pm0); }
            pg8::EpiGateBranch E{WSP(bf16_t, WS_MIXED), bg, slots, (LAS unsigned*)(lds + 131072 + 1024), pm0, pd0, (unsigned)(uintptr_t)(lds + LDS_RINV), (unsigned)(uintptr_t)(lds + LDS_BIAS)};
            pg8::gemm_phase(lds, 1024, 1024, S, E);
        PHASE_END
        PHASE_BEGIN(REP_P7)
            const cargs_t ap = get_args(); unsigned char* const ws = ap->ws;
            pg8::PlainOrder S{WSP(const char, WS_MIXED), WSP(const char, WS_WOT), 1024, 1024, 64, 4, 16, (int)gridDim.x, (int)blockIdx.x};
            if (l == 0) { pg8::EpiRes<true> E{ap->x, WSP(bf16_t, WS_XA), WSP(float, WS_ROWSS) + (size_t)1 * ROWSS_STRIDE};
                pg8::gemm_phase(lds, 1024, 1024, S, E); }
            else { pg8::EpiRes<false> E{ap->out, WSP(bf16_t, WS_XA), WSP(float, WS_ROWSS) + (size_t)3 * ROWSS_STRIDE};
                pg8::gemm_phase(lds, 1024, 1024, S, E); }
        PHASE_END
        PHASE_BEGIN(REP_P9)
            const cargs_t ap = get_args(); unsigned char* const ws = ap->ws;
            pg8::PlainOrder S{WSP(const char, WS_XA), WSP(const char, WS_W1T), 1024, 1024, 64, 16, 16, (int)gridDim.x, (int)blockIdx.x};
            const float* slots = WSP(const float, WS_ROWSS) + (size_t)(l * 2 + 1) * ROWSS_STRIDE;
            pg8::Unit u0; int pm0 = -1; if (S.next(0, u0)) { pm0 = u0.pm; fill_rinv_table(lds, slots, pm0); }
            pg8::EpiBf16<2, 1> E{WSP(bf16_t, WS_H), 4096, slots, pm0, (unsigned)(uintptr_t)(lds + LDS_RINV), nullptr};
            pg8::gemm_phase(lds, 1024, 1024, S, E);
        PHASE_END
        PHASE_BEGIN(REP_P10)
            const cargs_t ap = get_args(); unsigned char* const ws = ap->ws;
            pg8::PlainOrder S{WSP(const char, WS_H), WSP(const char, WS_W2T), 4096, 4096, 64, 4, 64, (int)gridDim.x, (int)blockIdx.x};
            if (l == 0) { pg8::EpiRes<false> E{WSP(const bf16_t, WS_XA), (bf16_t*)ap->out, WSP(float, WS_ROWSS) + (size_t)2 * ROWSS_STRIDE};
                pg8::gemm_phase(lds, 4096, 4096, S, E); }
            else { pg8::EpiFinal E{WSP(const bf16_t, WS_XA), ap->out, WSP(float, WS_ROWSS) + (size_t)4 * ROWSS_STRIDE, ap->g_final, (unsigned*)(ws + WS_CTL) + 8192};
                pg8::gemm_phase(lds, 4096, 4096, S, E); }
        if (l == 0) GRID_BAR(); }
    }
    _Pragma("unroll 1") for (int i = 0; i < REP_SYNC; ++i) GRID_BAR();
}

extern "C" void kernel_launch(void* const* d_in, const int* in_sizes, int n_in, void* d_out, int out_size, void* d_ws, size_t ws_size, hipStream_t stream) {
    static int grid = 0;
    if (grid == 0) {
        if (n_in != 22 || out_size != TOK * DM || ws_size < WS_END) { fprintf(stderr, "kernel_launch: unexpected shapes (n_in %d out %d ws %zu)\n", n_in, out_size, ws_size); grid = -1; return; }
        int dev = 0, cus = 0, per_cu = 0;
        if (hipGetDevice(&dev) != hipSuccess || hipDeviceGetAttribute(&cus, hipDeviceAttributeMultiprocessorCount, dev) != hipSuccess) { grid = -1; return; }
        if (hipFuncSetAttribute((const void*)fwd_megakernel, hipFuncAttributeMaxDynamicSharedMemorySize, LDS_BYTES) != hipSuccess) { fprintf(stderr, "hipFuncSetAttribute failed\n"); grid = -1; return; }
        if (hipOccupancyMaxActiveBlocksPerMultiprocessor(&per_cu, (const void*)fwd_megakernel, 512, LDS_BYTES) != hipSuccess || per_cu < 1) { fprintf(stderr, "occupancy query: %d blocks per CU\n", per_cu); grid = -1; return; }
        grid = cus;
    }
    if (grid < 0) return;
    (void)hipMemsetAsync((char*)d_ws + WS_CTL, 0, 65536, stream);
    Args a{};
    a.x = (const float*)d_in[0]; a.pos = (const int*)d_in[1]; a.g_mix = (const float*)d_in[2]; a.w_in = (const float*)d_in[3]; a.w_gate = (const float*)d_in[4]; a.b_gate = (const float*)d_in[5];
    a.rel_bias = (const float*)d_in[6]; a.g_q_lat = (const float*)d_in[7]; a.w_uq = (const float*)d_in[8]; a.g_kv_lat = (const float*)d_in[9]; a.w_ukv = (const float*)d_in[10];
    a.b_forget = (const float*)d_in[11]; a.w_dw = (const float*)d_in[12]; a.b_dw = (const float*)d_in[13]; a.g_conv_ln = (const float*)d_in[14]; a.b_conv_ln = (const float*)d_in[15];
    a.w_branch = (const float*)d_in[16]; a.w_o = (const float*)d_in[17]; a.g_ffn = (const float*)d_in[18]; a.w_up = (const float*)d_in[19]; a.w_down = (const float*)d_in[20]; a.g_final = (const float*)d_in[21];
    a.out = (float*)d_out; a.ws = (unsigned char*)d_ws;
    void* args[] = {&a};
    hipError_t e = hipLaunchCooperativeKernel((const void*)fwd_megakernel, dim3(grid), dim3(512), args, LDS_BYTES, stream);
    if (e != hipSuccess) fprintf(stderr, "cooperative launch failed: %s (grid %d)\n", hipGetErrorString(e), grid);
}
```

```cpp
#include <hip/hip_runtime.h>
#include <hip/hip_cooperative_groups.h>
#include <cstdio>
#include <cstdint>
namespace cg = cooperative_groups;

#define LAS __attribute__((address_space(3)))
typedef unsigned short bf16_t;
typedef short bf16x8 __attribute__((ext_vector_type(8)));
typedef short s16x4 __attribute__((ext_vector_type(4)));
typedef float f32x4 __attribute__((ext_vector_type(4)));
typedef float f32x16 __attribute__((ext_vector_type(16)));
typedef unsigned u32x4 __attribute__((ext_vector_type(4)));
typedef unsigned u32x2 __attribute__((ext_vector_type(2)));
typedef float f32x2_t __attribute__((ext_vector_type(2)));
typedef __bf16 bf16x2_t __attribute__((ext_vector_type(2)));

constexpr int NB = 4, SEQ = 4096, DM = 1024, TOK = NB * SEQ, DFF = 4096, INC = 2468, PLD = 2560;
constexpr int C_AQ = 0, C_AK = 256, C_AV = 512, C_BQL = 768, C_BKVL = 1024, C_BKR = 1152, C_CQ = 1184, C_CK = 1440, C_CV = 1696, C_CF = 1952, C_DV = 1956, C_DG = 2212;
constexpr float LOG2E = 1.4426950408889634f;
constexpr float EPS = 1e-6f;
constexpr size_t MiB = 1u << 20;
constexpr size_t WS_W1T = 4 * MiB, WS_W2T = 12 * MiB, WS_XN = 20 * MiB, WS_PROJ = 52 * MiB, WS_XA = 52 * MiB, WS_H = 116 * MiB;
constexpr size_t WS_QKVB = 132 * MiB, WS_MIXED = 132 * MiB, WS_BR = 164 * MiB, WS_LAT = 196 * MiB, WS_U = 208 * MiB;
constexpr size_t WS_WINT = 216 * MiB, WS_WGT = 221 * MiB, WS_WLT = 229 * MiB, WS_WBT = 230 * MiB, WS_WOT = 238 * MiB;
constexpr size_t WS_CTL = 244 * MiB, WS_FCUM = 244 * MiB + 256 * 1024, WS_KROT = 245 * MiB, WS_END = 256 * MiB;
constexpr size_t WS_WINT1 = 251 * MiB, WS_WLT1 = 0, WS_LATSS = 1 * MiB;
constexpr size_t WS_ROWSS = 246 * MiB, ROWSS_STRIDE = (size_t)TOK * 16;
constexpr int LDS_RINV = 131072 + 1024 + 16384;
constexpr int LDS_BIAS = LDS_RINV + 1024;
constexpr int LDS_BYTES = LDS_BIAS + 4096;

struct Args {
    const float* x; const int* pos; const float* g_mix; const float* w_in; const float* w_gate; const float* b_gate; const float* rel_bias;
    const float* g_q_lat; const float* w_uq; const float* g_kv_lat; const float* w_ukv; const float* b_forget; const float* w_dw; const float* b_dw;
    const float* g_conv_ln; const float* b_conv_ln; const float* w_branch; const float* w_o; const float* g_ffn; const float* w_up; const float* w_down; const float* g_final;
    float* out; unsigned char* ws;
};

typedef const __attribute__((address_space(4))) Args* cargs_t;
__device__ __forceinline__ cargs_t get_args() { cargs_t p = (cargs_t)__builtin_amdgcn_kernarg_segment_ptr(); asm volatile("" : "+s"(p)); return p; }
__device__ __forceinline__ int fresh_tid() { int t = threadIdx.x; asm volatile("" : "+v"(t)); return t; }
__device__ __forceinline__ float bf2f(unsigned short b) { return __uint_as_float((unsigned)b << 16); }
__device__ __forceinline__ unsigned pk2(float lo, float hi) { f32x2_t v = {lo, hi}; bf16x2_t b = __builtin_convertvector(v, bf16x2_t); return __builtin_bit_cast(unsigned, b); }
__device__ __forceinline__ float lo_f(unsigned w) { return __uint_as_float(w << 16); }
__device__ __forceinline__ float hi_f(unsigned w) { return __uint_as_float(w & 0xffff0000u); }
__device__ __forceinline__ float wave_sum(float v) {
#pragma unroll
    for (int o = 1; o < 64; o <<= 1) v += __shfl_xor(v, o);
    return v;
}
__device__ __forceinline__ float sigmoidf_(float x) { return 1.0f / (1.0f + __expf(-x)); }
#define LDS_WAIT() asm volatile("s_waitcnt lgkmcnt(0)" ::: "memory")
__device__ __forceinline__ float row_rinv(const float* slots, int row, int fq) {
    const f32x4 a = *(const f32x4*)(slots + (size_t)row * 16 + 4 * fq);
    float s = (a.x + a.y) + (a.z + a.w);
    s += __shfl_xor(s, 16); s += __shfl_xor(s, 32);
    return __builtin_amdgcn_rsqf(s * (1.0f / 1024.0f) + EPS);
}
__device__ __forceinline__ void fill_rinv_table(LAS unsigned char* lds, const float* slots, int pm) {
    const int t = fresh_tid();
    if (t < 256) { const f32x4* p = (const f32x4*)(slots + (size_t)(pm * 256 + t) * 16); const f32x4 a = p[0], b = p[1], c = p[2], d = p[3];
        const float s = (((a.x + a.y) + (a.z + a.w)) + ((b.x + b.y) + (b.z + b.w))) + (((c.x + c.y) + (c.z + c.w)) + ((d.x + d.y) + (d.z + d.w)));
        ((LAS float*)(lds + LDS_RINV))[t] = __builtin_amdgcn_rsqf(s * (1.0f / 1024.0f) + EPS); }
    __syncthreads();
}
__device__ __forceinline__ float lds_rinv_read(unsigned addr) { float r; asm volatile("ds_read_b32 %0, %1" : "=v"(r) : "v"(addr)); return r; }
__device__ __forceinline__ f32x4 lds_read4(unsigned addr) { f32x4 r; asm volatile("ds_read_b128 %0, %1" : "=v"(r) : "v"(addr)); return r; }
namespace pg8 {
constexpr int BM = 256, BK = 64, HALF = 128, HTB = HALF * BK * 2, STAGE_BYTES = 8 * HTB, NXCD = 8, WGM = 8;
__host__ __device__ __forceinline__ int lds_byte(int r, int c) { const int st = (r >> 4) * 2 + (c >> 5), rr = r & 15, cc = c & 31, ob = rr * 64 + cc * 2; return st * 1024 + (ob ^ (((ob >> 9) & 1) << 5)); }
__host__ __device__ __forceinline__ void stage_rc(int b, int& R, int& C) { const int st = b / 1024, sb = b % 1024, swz = sb ^ (((sb >> 9) & 1) << 5); R = (st >> 1) * 16 + swz / 64; C = (st & 1) * 32 + (swz % 64) / 2; }
__host__ __device__ __forceinline__ int perm32(int rho) { const int n = rho >> 4, i = rho & 15; return 8 * (i >> 2) + 4 * n + (i & 3); }

struct Unit { int pm, pn, nt, kind; const char* a; const char* b; };

__device__ __forceinline__ bool tile_of(int L, int nM, int nN, int& pm, int& pn) {
    const int nwg = nM * nN; if (L >= nwg) return false;
    int wgid = L; { const int q = nwg / NXCD, r = nwg % NXCD, xcd = wgid % NXCD, off = wgid / NXCD; wgid = (xcd < r ? xcd * (q + 1) : r * (q + 1) + (xcd - r) * q) + off; }
    const int nig = WGM * nN, gid = wgid / nig, fm = gid * WGM, gsz = (nM - fm) < WGM ? (nM - fm) : WGM;
    pm = fm + ((wgid % nig) % gsz); pn = (wgid % nig) / gsz; return true;
}
struct PlainOrder {
    const char* A; const char* Bt; int lda, ldb, nM, nN, nt, G, c;
    __device__ __forceinline__ bool next(int i, Unit& u) const {
        int pm, pn; if (!tile_of(i * G + c, nM, nN, pm, pn)) return false;
        u.pm = pm; u.pn = pn; u.nt = nt; u.kind = 0; u.a = A + (size_t)pm * 256 * lda * 2; u.b = Bt + (size_t)pn * 256 * ldb * 2; return true;
    }
};
struct GateBranchOrder {
    const char* XN; const char* BR; const char* WgT; const char* WbT; int G, c;
    __device__ __forceinline__ bool next(int i, Unit& u) const {
        const int gi = i >> 3, j = i & 7; int pm, pd; if (!tile_of(gi * G + c, 64, 4, pm, pd)) return false;
        const int n = j >> 1, kind = j & 1; u.pm = pm; u.pn = n * 4 + pd; u.kind = kind;
        if (kind == 0) { u.nt = 16; u.a = XN + (size_t)pm * 256 * 1024 * 2; u.b = WgT + (size_t)u.pn * 256 * 1024 * 2; }
        else { u.nt = 4; u.a = BR + ((size_t)pm * 256 * 1024 + n * 256) * 2; u.b = WbT + ((size_t)u.pn * 256 * 1024 + n * 256) * 2; }
        return true;
    }
};

template <int ACT  , int RS  , bool LATSS = false  > struct EpiBf16 {
    static constexpr bool PERM = true; struct State {};
    bf16_t* O; int ldc; const float* rowss; int pm_tab; unsigned tab; float* latss;
    __device__ __forceinline__ void operator()(const f32x4 (&acc)[2][2][4][2], State&, const Unit& u, int wr, int wc, int fr, int fq) const {
        asm volatile("" : "+v"(fr), "+v"(fq));
        const int row0 = u.pm * BM + wr * 64 + fr, col0 = u.pn * BM + wc * 32 + 8 * fq;
        float rv[2][4];
        if (RS == 1) {
            if (u.pm == pm_tab) {
#pragma unroll
                for (int ai = 0; ai < 2; ++ai)
#pragma unroll
                    for (int m = 0; m < 4; ++m) rv[ai][m] = lds_rinv_read(tab + (unsigned)(wr * 64 + fr + ai * HALF + m * 16) * 4u);
                asm volatile("s_waitcnt lgkmcnt(0)" : "+v"(rv[0][0]), "+v"(rv[0][1]), "+v"(rv[0][2]), "+v"(rv[0][3]), "+v"(rv[1][0]), "+v"(rv[1][1]), "+v"(rv[1][2]), "+v"(rv[1][3]));
            } else {
#pragma unroll
                for (int ai = 0; ai < 2; ++ai)
#pragma unroll
                    for (int m = 0; m < 4; ++m) rv[ai][m] = row_rinv(rowss, row0 + ai * HALF + m * 16, fq);
            }
        }
#pragma unroll
        for (int ai = 0; ai < 2; ++ai)
#pragma unroll
            for (int m = 0; m < 4; ++m) { bf16_t* rowp = O + (size_t)(row0 + ai * HALF + m * 16) * ldc + col0;
                float rinv = 1.f; if (RS == 1) rinv = rv[ai][m];
                if (RS == 2) { const f32x4 a = *(const f32x4*)(latss + (size_t)(row0 + ai * HALF + m * 16) * 8 + (u.pn >= 2 ? 4 : 0));
                    rinv = __builtin_amdgcn_rsqf(((a.x + a.y) + (a.z + a.w)) * (u.pn >= 2 ? (1.0f / 128.0f) : (1.0f / 256.0f)) + EPS); }
                float lss = 0.f;
#pragma unroll
                for (int bj = 0; bj < 2; ++bj) { f32x4 v0 = acc[ai][bj][m][0], v1 = acc[ai][bj][m][1];
                    if (RS) { v0 = v0 * rinv; v1 = v1 * rinv; }
                    if (LATSS) { if (bj == 0 || u.pn == 3) lss += ((v0.x * v0.x + v0.y * v0.y) + (v0.z * v0.z + v0.w * v0.w)) + ((v1.x * v1.x + v1.y * v1.y) + (v1.z * v1.z + v1.w * v1.w)); }
                    if (ACT == 2) {
#pragma unroll
                        for (int e = 0; e < 4; ++e) { const float a0 = fmaxf(v0[e], 0.f), a1 = fmaxf(v1[e], 0.f); v0[e] = a0 * a0; v1[e] = a1 * a1; } }
                    u32x4 w; w.x = pk2(v0[0], v0[1]); w.y = pk2(v0[2], v0[3]); w.z = pk2(v1[0], v1[1]); w.w = pk2(v1[2], v1[3]);
                    *(u32x4*)(rowp + bj * HALF) = w; }
                if (LATSS) { if (u.pn == 3 || u.pn == 4) { lss += __shfl_xor(lss, 16); lss += __shfl_xor(lss, 32);
                    if (fq == 0) latss[(size_t)(row0 + ai * HALF + m * 16) * 8 + (u.pn == 4 ? 4 : 0) + wc] = lss; } } }
    }
};
template <bool BASEF32> struct EpiRes {
    static constexpr bool PERM = true; struct State {};
    const void* base; bf16_t* out; float* rowss;
    __device__ __forceinline__ void operator()(const f32x4 (&acc)[2][2][4][2], State&, const Unit& u, int wr, int wc, int fr, int fq) const {
        asm volatile("" : "+v"(fr), "+v"(fq));
        const int row0 = u.pm * BM + wr * 64 + fr, col0 = u.pn * BM + wc * 32 + 8 * fq;
#pragma unroll
        for (int ai = 0; ai < 2; ++ai) {
            f32x4 bs[4][2][2];
#pragma unroll
            for (int m = 0; m < 4; ++m) { const size_t off = (size_t)(row0 + ai * HALF + m * 16) * 1024 + col0;
#pragma unroll
                for (int bj = 0; bj < 2; ++bj) {
                    if (BASEF32) { bs[m][bj][0] = *(const f32x4*)((const float*)base + off + bj * HALF); bs[m][bj][1] = *(const f32x4*)((const float*)base + off + bj * HALF + 4); }
                    else { const u32x4 w = *(const u32x4*)((const bf16_t*)base + off + bj * HALF);
                        bs[m][bj][0] = (f32x4){lo_f(w.x), hi_f(w.x), lo_f(w.y), hi_f(w.y)}; bs[m][bj][1] = (f32x4){lo_f(w.z), hi_f(w.z), lo_f(w.w), hi_f(w.w)}; } } }
            asm volatile("" ::: "memory");
#pragma unroll
            for (int m = 0; m < 4; ++m) { const int row = row0 + ai * HALF + m * 16; const size_t off = (size_t)row * 1024 + col0; float ss = 0.f;
#pragma unroll
                for (int bj = 0; bj < 2; ++bj) { const f32x4 v0 = bs[m][bj][0] + acc[ai][bj][m][0], v1 = bs[m][bj][1] + acc[ai][bj][m][1];
                    u32x4 w; w.x = pk2(v0[0], v0[1]); w.y = pk2(v0[2], v0[3]); w.z = pk2(v1[0], v1[1]); w.w = pk2(v1[2], v1[3]); *(u32x4*)(out + off + bj * HALF) = w;
                    ss += ((v0.x * v0.x + v0.y * v0.y) + (v0.z * v0.z + v0.w * v0.w)) + ((v1.x * v1.x + v1.y * v1.y) + (v1.z * v1.z + v1.w * v1.w)); }
                ss += __shfl_xor(ss, 16); ss += __shfl_xor(ss, 32); if (fq == 0) rowss[(size_t)row * 16 + u.pn * 4 + wc] = ss; }
            asm volatile("" ::: "memory");
        }
    }
};
struct EpiFinal {
    static constexpr bool PERM = true; struct State {};
    const bf16_t* base; float* out; float* rowss; const float* g; unsigned* cnt;
    __device__ __forceinline__ void operator()(const f32x4 (&acc_)[2][2][4][2], State&, const Unit& u, int wr, int wc, int fr, int fq) const {
        asm volatile("" : "+v"(fr), "+v"(fq));
        f32x4 (&acc)[2][2][4][2] = const_cast<f32x4 (&)[2][2][4][2]>(acc_);
        const int row0 = u.pm * BM + wr * 64 + fr, col0 = u.pn * BM + wc * 32 + 8 * fq;
#pragma unroll
        for (int ai = 0; ai < 2; ++ai) {
            u32x4 bs[4][2];
#pragma unroll
            for (int m = 0; m < 4; ++m) { const size_t off = (size_t)(row0 + ai * HALF + m * 16) * 1024 + col0;
#pragma unroll
                for (int bj = 0; bj < 2; ++bj) bs[m][bj] = *(const u32x4*)(base + off + bj * HALF); }
            asm volatile("" ::: "memory");
#pragma unroll
            for (int m = 0; m < 4; ++m) { const int row = row0 + ai * HALF + m * 16; float ss = 0.f;
#pragma unroll
                for (int bj = 0; bj < 2; ++bj) { const u32x4 w = bs[m][bj];
                    const f32x4 v0 = acc[ai][bj][m][0] + (f32x4){lo_f(w.x), hi_f(w.x), lo_f(w.y), hi_f(w.y)}, v1 = acc[ai][bj][m][1] + (f32x4){lo_f(w.z), hi_f(w.z), lo_f(w.w), hi_f(w.w)};
                    acc[ai][bj][m][0] = v0; acc[ai][bj][m][1] = v1;
                    ss += ((v0.x * v0.x + v0.y * v0.y) + (v0.z * v0.z + v0.w * v0.w)) + ((v1.x * v1.x + v1.y * v1.y) + (v1.z * v1.z + v1.w * v1.w)); }
                ss += __shfl_xor(ss, 16); ss += __shfl_xor(ss, 32); if (fq == 0) rowss[(size_t)row * 16 + u.pn * 4 + wc] = ss; }
        }
        asm volatile("s_waitcnt vmcnt(0)" ::: "memory"); __builtin_amdgcn_s_barrier(); asm volatile("" ::: "memory");
        if (threadIdx.x == 0) {
            __builtin_amdgcn_fence(__ATOMIC_RELEASE, "agent"); asm volatile("s_waitcnt vmcnt(0)" ::: "memory");
            unsigned* c = cnt + 64 * u.pm;
            (void)__hip_atomic_fetch_add(c, 1u, __ATOMIC_RELAXED, __HIP_MEMORY_SCOPE_AGENT);
            unsigned sp = 0;
            while (__hip_atomic_load(c, __ATOMIC_RELAXED, __HIP_MEMORY_SCOPE_AGENT) < 4u) { __builtin_amdgcn_s_sleep(1); if (++sp > (1u << 16)) break; }
            __builtin_amdgcn_fence(__ATOMIC_ACQUIRE, "agent"); asm volatile("s_waitcnt vmcnt(0)" ::: "memory");
        }
        asm volatile("" ::: "memory"); __builtin_amdgcn_s_barrier(); asm volatile("" ::: "memory");
        f32x4 gv[2][2];
#pragma unroll
        for (int bj = 0; bj < 2; ++bj)
#pragma unroll
            for (int q = 0; q < 2; ++q) gv[bj][q] = *(const f32x4*)(g + col0 + bj * HALF + 4 * q);
#pragma unroll
        for (int ai = 0; ai < 2; ++ai)
#pragma unroll
            for (int m = 0; m < 4; ++m) { const int row = row0 + ai * HALF + m * 16; const float rinv = row_rinv(rowss, row, fq); float* op = out + (size_t)row * 1024 + col0;
#pragma unroll
                for (int bj = 0; bj < 2; ++bj) { *(f32x4*)(op + bj * HALF) = acc[ai][bj][m][0] * rinv * gv[bj][0]; *(f32x4*)(op + bj * HALF + 4) = acc[ai][bj][m][1] * rinv * gv[bj][1]; } }
    }
};
struct EpiGateBranch {
    static constexpr bool PERM = true;
    struct State { unsigned g8[2][2][4][2]; };
    bf16_t* mixed; const float* bgate; const float* rowss; LAS unsigned* glds; int pm_tab, pd_tab; unsigned tab, btab;
    __device__ __forceinline__ void operator()(const f32x4 (&acc)[2][2][4][2], State& st, const Unit& u, int wr, int wc, int fr, int fq) const {
        asm volatile("" : "+v"(fr), "+v"(fq));
        const int rl0 = wr * 64 + fr, cl0 = wc * 32 + 8 * fq, n = u.pn >> 2, pd = u.pn & 3;
        LAS unsigned* gl = glds + (wr * 4 + wc) * 512 + (fq * 16 + fr) * 8;
        if (u.kind == 0) {
            f32x4 bv[2][2]; float rv[2][4];
            if (u.pm == pm_tab && pd == pd_tab) {
#pragma unroll
                for (int bj = 0; bj < 2; ++bj)
#pragma unroll
                    for (int q = 0; q < 2; ++q) bv[bj][q] = lds_read4(btab + (unsigned)(n * 256 + cl0 + bj * HALF + 4 * q) * 4u);
#pragma unroll
                for (int ai = 0; ai < 2; ++ai)
#pragma unroll
                    for (int m = 0; m < 4; ++m) rv[ai][m] = lds_rinv_read(tab + (unsigned)(rl0 + ai * HALF + m * 16) * 4u);
                asm volatile("s_waitcnt lgkmcnt(0)" : "+v"(bv[0][0]), "+v"(bv[0][1]), "+v"(bv[1][0]), "+v"(bv[1][1]), "+v"(rv[0][0]), "+v"(rv[0][1]), "+v"(rv[0][2]), "+v"(rv[0][3]), "+v"(rv[1][0]), "+v"(rv[1][1]), "+v"(rv[1][2]), "+v"(rv[1][3]));
            } else {
#pragma unroll
                for (int bj = 0; bj < 2; ++bj)
#pragma unroll
                    for (int q = 0; q < 2; ++q) bv[bj][q] = *(const f32x4*)(bgate + u.pn * BM + cl0 + bj * HALF + 4 * q);
#pragma unroll
                for (int ai = 0; ai < 2; ++ai)
#pragma unroll
                    for (int m = 0; m < 4; ++m) rv[ai][m] = row_rinv(rowss, u.pm * BM + rl0 + ai * HALF + m * 16, fq);
            }
#pragma unroll
            for (int ai = 0; ai < 2; ++ai)
#pragma unroll
                for (int m = 0; m < 4; ++m) {
                    const float rinv = rv[ai][m];
#pragma unroll
                    for (int bj = 0; bj < 2; ++bj)
#pragma unroll
                        for (int q = 0; q < 2; ++q) { const f32x4 v = acc[ai][bj][m][q] * rinv + bv[bj][q]; unsigned w = 0u;
#pragma unroll
                            for (int e = 0; e < 4; ++e) w |= (unsigned)(sigmoidf_(v[e]) * 255.0f + 0.5f) << (8 * e);
                            if (ai == 1 && bj == 1) gl[m * 2 + q] = w; else st.g8[ai][bj][m][q] = w; } }
        } else {
#pragma unroll
            for (int ai = 0; ai < 2; ++ai) {
                u32x4 oo[4][2];
#pragma unroll
                for (int m = 0; m < 4; ++m) { const int rl = rl0 + ai * HALF + m * 16; const bf16_t* mp = mixed + (size_t)(u.pm * BM + rl) * 1024 + pd * 256 + cl0;
#pragma unroll
                    for (int bj = 0; bj < 2; ++bj) { oo[m][bj] = (u32x4){0u, 0u, 0u, 0u}; if (n > 0) oo[m][bj] = *(const u32x4*)(mp + bj * HALF); } }
                asm volatile("" ::: "memory");
#pragma unroll
                for (int m = 0; m < 4; ++m) { const int rl = rl0 + ai * HALF + m * 16; bf16_t* mp = mixed + (size_t)(u.pm * BM + rl) * 1024 + pd * 256 + cl0;
#pragma unroll
                    for (int bj = 0; bj < 2; ++bj) { const unsigned g0 = (ai == 1 && bj == 1) ? gl[m * 2] : st.g8[ai][bj][m][0], g1 = (ai == 1 && bj == 1) ? gl[m * 2 + 1] : st.g8[ai][bj][m][1]; const u32x4 o = oo[m][bj]; const f32x4 a0 = acc[ai][bj][m][0] * (1.0f / 255.0f), a1 = acc[ai][bj][m][1] * (1.0f / 255.0f);
                        float v[8];
                        v[0] = fmaf(a0[0], (float)(g0 & 255u), lo_f(o.x)); v[1] = fmaf(a0[1], (float)((g0 >> 8) & 255u), hi_f(o.x)); v[2] = fmaf(a0[2], (float)((g0 >> 16) & 255u), lo_f(o.y)); v[3] = fmaf(a0[3], (float)(g0 >> 24), hi_f(o.y));
                        v[4] = fmaf(a1[0], (float)(g1 & 255u), lo_f(o.z)); v[5] = fmaf(a1[1], (float)((g1 >> 8) & 255u), hi_f(o.z)); v[6] = fmaf(a1[2], (float)((g1 >> 16) & 255u), lo_f(o.w)); v[7] = fmaf(a1[3], (float)(g1 >> 24), hi_f(o.w));
                        u32x4 w; w.x = pk2(v[0], v[1]); w.y = pk2(v[2], v[3]); w.z = pk2(v[4], v[5]); w.w = pk2(v[6], v[7]);
                        *(u32x4*)(mp + bj * HALF) = w; } }
                asm volatile("" ::: "memory");
            }
        }
    }
};

template <class Epi, class Sched>
__device__ __forceinline__ void gemm_phase(LAS unsigned char* lds, const int lda, const int ldb, const Sched& S, const Epi& E) {
    const int tid = fresh_tid(), wid = __builtin_amdgcn_readfirstlane(tid >> 6), lane = tid & 63, wr = wid >> 2, wc = wid & 3, fr = lane & 15, fq = lane >> 4;
    unsigned voffA[2], voffB[2];
#pragma unroll
    for (int i = 0; i < 2; ++i) { int R, C; stage_rc(tid * 16 + i * 8192, R, C); const int Rb = Epi::PERM ? ((R & ~31) + perm32(R & 31)) : R;
        voffA[i] = (unsigned)(R * lda + C) * 2u; voffB[i] = (unsigned)(Rb * ldb + C) * 2u; }
    const size_t kstep = (size_t)(BK * 2);
    const size_t hstepA = (size_t)HALF * lda * 2, hstepB = (size_t)HALF * ldb * 2;
    const unsigned ldsw = (unsigned)wid * 1024u;
    const int aoff = lds_byte(wr * 64 + fr, fq * 8), boff = lds_byte(wc * 32 + fr, fq * 8);
#define PG8_SA(b, h) (((b) * 2 + (h)) * HTB)
#define PG8_SB(b, h) ((4 + (b) * 2 + (h)) * HTB)
#define PG8_STAGE(bufoff, gbase, voff) do { _Pragma("unroll") for (int _i = 0; _i < 2; ++_i) \
        __builtin_amdgcn_global_load_lds((const unsigned*)((const char*)(gbase) + (voff)[_i]), (LAS unsigned*)(lds + (bufoff) + ldsw + _i * 8192), 16, 0, 0); } while (0)
#define PG8_LDA(dst, b, h) do { _Pragma("unroll") for (int m = 0; m < 4; ++m) _Pragma("unroll") for (int k = 0; k < 2; ++k) dst[m][k] = *(const LAS bf16x8*)(lds + PG8_SA(b, h) + aoff + m * 2048 + k * 1024); } while (0)
#define PG8_LDB(dst, b, h) do { _Pragma("unroll") for (int n = 0; n < 2; ++n) _Pragma("unroll") for (int k = 0; k < 2; ++k) dst[n][k] = *(const LAS bf16x8*)(lds + PG8_SB(b, h) + boff + n * 2048 + k * 1024); } while (0)
#define PG8_MMA(ai, bj, At, Bt) do { __builtin_amdgcn_s_setprio(1); _Pragma("unroll") for (int m = 0; m < 4; ++m) _Pragma("unroll") for (int n = 0; n < 2; ++n) _Pragma("unroll") for (int k = 0; k < 2; ++k) \
        acc[ai][bj][m][n] = __builtin_amdgcn_mfma_f32_16x16x32_bf16(Bt[n][k], At[m][k], acc[ai][bj][m][n], 0, 0, 0); __builtin_amdgcn_s_setprio(0); } while (0)
#define PG8_WAIT_V(n) asm volatile("s_waitcnt vmcnt(" #n ")" ::: "memory")
#define PG8_WAIT_L(n) asm volatile("s_waitcnt lgkmcnt(" #n ")" ::: "memory")
#define PG8_BAR __builtin_amdgcn_s_barrier()
#define PG8_SCHED __builtin_amdgcn_sched_barrier(0)
    Unit cur, nxt; int ui = 0;
    if (!S.next(0, cur)) return;
    f32x4 acc[2][2][4][2];
#pragma unroll
    for (int a = 0; a < 2; ++a)
#pragma unroll
        for (int b = 0; b < 2; ++b)
#pragma unroll
            for (int m = 0; m < 4; ++m)
#pragma unroll
                for (int n = 0; n < 2; ++n) acc[a][b][m][n] = (f32x4){0.f, 0.f, 0.f, 0.f};
    bf16x8 At[4][2], B0[2][2], B1[2][2];
    typename Epi::State est;
    const char* cA = cur.a; const char* cB = cur.b;
    PG8_STAGE(PG8_SB(0, 0), cB, voffB); PG8_STAGE(PG8_SB(0, 1), cB + hstepB, voffB); PG8_STAGE(PG8_SA(0, 0), cA, voffA); PG8_STAGE(PG8_SA(0, 1), cA + hstepA, voffA);
    if (wr == 1) PG8_BAR;
    PG8_WAIT_V(2); PG8_BAR;
    PG8_STAGE(PG8_SB(1, 0), cB + kstep, voffB); PG8_STAGE(PG8_SA(1, 0), cA + kstep, voffA); PG8_STAGE(PG8_SB(1, 1), cB + hstepB + kstep, voffB);
    PG8_WAIT_V(6); PG8_BAR;
    for (;;) {
        const bool has_next = S.next(ui + 1, nxt);
        const char* nA = has_next ? nxt.a : cA; const char* nB = has_next ? nxt.b : cB;
        const int nt = cur.nt;
        for (int t = 0; t < nt; t += 2) {
            const bool last = (t == nt - 2);
            const char* a1 = cA + (size_t)(t + 1) * kstep;
            const char* a2 = last ? nA : cA + (size_t)(t + 2) * kstep; const char* b2 = last ? nB : cB + (size_t)(t + 2) * kstep;
            const char* a3 = a2 + kstep; const char* b3 = b2 + kstep;
            PG8_LDB(B0, 0, 0); PG8_LDB(B1, 0, 1); PG8_SCHED; PG8_LDA(At, 0, 0); PG8_STAGE(PG8_SA(1, 1), a1 + hstepA, voffA);
            PG8_WAIT_V(8); PG8_WAIT_L(0); PG8_BAR; PG8_MMA(0, 0, At, B0); PG8_MMA(0, 1, At, B1); PG8_BAR; PG8_SCHED;
            PG8_LDA(At, 0, 1); PG8_STAGE(PG8_SB(0, 0), b2, voffB); PG8_STAGE(PG8_SB(0, 1), b2 + hstepB, voffB); PG8_STAGE(PG8_SA(0, 0), a2, voffA);
            PG8_WAIT_V(8); PG8_WAIT_L(0); PG8_BAR; PG8_MMA(1, 0, At, B0); PG8_MMA(1, 1, At, B1); PG8_BAR; PG8_SCHED;
            PG8_LDB(B0, 1, 0); PG8_LDB(B1, 1, 1); PG8_SCHED; PG8_LDA(At, 1, 0); PG8_STAGE(PG8_SA(0, 1), a2 + hstepA, voffA);
            PG8_WAIT_V(8); PG8_WAIT_L(0); PG8_BAR; PG8_MMA(0, 0, At, B0); PG8_MMA(0, 1, At, B1); PG8_BAR; PG8_SCHED;
            PG8_LDA(At, 1, 1); PG8_STAGE(PG8_SB(1, 0), b3, voffB); PG8_STAGE(PG8_SB(1, 1), b3 + hstepB, voffB); PG8_STAGE(PG8_SA(1, 0), a3, voffA);
            PG8_WAIT_V(8); PG8_WAIT_L(0); PG8_BAR; PG8_MMA(1, 0, At, B0); PG8_MMA(1, 1, At, B1); PG8_BAR; PG8_SCHED;
        }
        if (wr == 0) PG8_BAR;
        E(acc, est, cur, wr, wc, fr, fq);
        if (!has_next) break;
#pragma unroll
        for (int a = 0; a < 2; ++a)
#pragma unroll
            for (int b = 0; b < 2; ++b)
#pragma unroll
                for (int m = 0; m < 4; ++m)
#pragma unroll
                    for (int n = 0; n < 2; ++n) acc[a][b][m][n] = (f32x4){0.f, 0.f, 0.f, 0.f};
        cur = nxt; cA = nA; cB = nB; ++ui;
        if (wr == 1) PG8_BAR;
    }
    PG8_WAIT_V(0);
    PG8_BAR;
#undef PG8_SA
#undef PG8_SB
#undef PG8_STAGE
#undef PG8_LDA
#undef PG8_LDB
#undef PG8_MMA
#undef PG8_WAIT_V
#undef PG8_WAIT_L
#undef PG8_BAR
#undef PG8_SCHED
}
}

namespace att {
constexpr int VP = 144;
typedef short v4i16_t __attribute__((ext_vector_type(4)));
__device__ __forceinline__ int crow(int i, int h) { return (i & 3) + 8 * (i >> 2) + 4 * h; }
__device__ __forceinline__ s16x4 vtr(const LAS unsigned char* p) { return __builtin_bit_cast(s16x4, __builtin_amdgcn_ds_read_tr16_b64_v4i16((LAS v4i16_t*)p)); }
#define MFMA32(a, b, c) __builtin_amdgcn_mfma_f32_32x32x16_bf16((a), (b), (c), 0, 0, 0)

template <int MODE>
__device__ __forceinline__ void unit(int layer, int b, int h, int qb, LAS unsigned char* lds) {
    const cargs_t ap = get_args();
    unsigned char* const ws_ = ap->ws;
    constexpr int DK = MODE == 1 ? 96 : 64, ND = DK / 16, KP = DK * 2 + 16, KBUF = 64 * KP, VBUF = 64 * VP;
    LAS unsigned char* Ks = lds; LAS unsigned char* Vs = lds + 2 * KBUF;
    LAS float* Fs = (LAS float*)(lds + 2 * KBUF + 2 * VBUF); LAS float* Tab = Fs + 128;
    const int tid = fresh_tid(), lane = tid & 63, wid = __builtin_amdgcn_readfirstlane(tid >> 6), r = lane & 31, hh = lane >> 5;
    const size_t tok0 = (size_t)b * SEQ;
    const int qw = qb * 256 + wid * 32, qc = qw >> 6;
    const bf16_t* PROJ = (const bf16_t*)(ws_ + WS_PROJ); const bf16_t* QKVB = (const bf16_t*)(ws_ + WS_QKVB); const bf16_t* KROT = (const bf16_t*)(ws_ + WS_KROT);
    const float* FCUM = (const float*)(ws_ + WS_FCUM) + (size_t)(b * 4 + h) * SEQ;
    bf16_t* BR = (bf16_t*)(ws_ + WS_BR);
    const bf16_t *Qp, *Kp, *Vp; int ldq, ldk;
    if (MODE == 0) { Qp = PROJ + C_AQ + h * 64; Kp = PROJ + C_AK + h * 64; Vp = PROJ + C_AV + h * 64; ldq = PLD; ldk = PLD; }
    else if (MODE == 2) { Qp = PROJ + C_CQ + h * 64; Kp = PROJ + C_CK + h * 64; Vp = PROJ + C_CV + h * 64; ldq = PLD; ldk = PLD; }
    else { Qp = QKVB + h * 96; Kp = QKVB + 512 + h * 128; Vp = Kp + 64; ldq = 1024; ldk = 1024; }
    const int t_lo = (MODE == 0) ? (qb * 4 - 8 > 0 ? qb * 4 - 8 : 0) : 0, t_hi = qb * 4 + 4;
    const float cs = (MODE == 1 ? 0.10206207261596577f : 0.125f) * LOG2E;

    u32x4 kregA, vregA, kr2A, kregB, vregB, kr2B; float fregA = 0.f, fregB = 0.f;
    const int srow = tid >> 3, sch = tid & 7;
#define ATT_LOAD(j, X) do { const int jl_ = (j) < t_lo ? t_lo : (j); const size_t trow = tok0 + (size_t)jl_ * 64; \
        kreg##X = *(const u32x4*)(Kp + (trow + srow) * ldk + sch * 8); vreg##X = *(const u32x4*)(Vp + (trow + srow) * ldk + sch * 8); \
        if (MODE == 1) { kr2##X = *(const u32x4*)(KROT + (trow + ((tid >> 2) & 63)) * 32 + (tid & 3) * 8); } \
        if (MODE == 2) { freg##X = FCUM[jl_ * 64 + (tid & 63)]; } } while (0)
#define ATT_STORE(s, X) do { *(LAS u32x4*)(Ks + (s) * KBUF + srow * KP + sch * 16) = kreg##X; *(LAS u32x4*)(Vs + (s) * VBUF + srow * VP + sch * 16) = vreg##X; \
        if (MODE == 1) { if (tid < 256) *(LAS u32x4*)(Ks + (s) * KBUF + (tid >> 2) * KP + 128 + (tid & 3) * 16) = kr2##X; } \
        if (MODE == 2) { if (tid < 64) Fs[(s) * 64 + tid] = freg##X * LOG2E; } } while (0)

    ATT_LOAD(t_hi - 1, A);
    ATT_LOAD(t_hi - 2, B);
    if (MODE == 0) { if (tid < 257) Tab[tid] = ap->rel_bias[(size_t)(layer * 4 + h) * 257 + tid] * LOG2E; }
    bf16x8 qf[ND];
    { const bf16_t* qrow = Qp + (tok0 + qw + r) * ldq;
#pragma unroll
      for (int d0 = 0; d0 < ND; ++d0) qf[d0] = *(const bf16x8*)(qrow + d0 * 16 + hh * 8); }
    if (MODE == 1) {
        const float pos = (float)ap->pos[tok0 + qw + r];
#pragma unroll
        for (int j = 0; j < 8; ++j) {
            const float invf = exp2f(-(float)(8 * hh + j) * 0.8304820237218406f);
            const float ang = pos * invf, kk = rintf(ang * 0.15915494309189535f);
            float rem = fmaf(-kk, 6.2831854820251465f, ang); rem = fmaf(kk, 1.7484555e-7f, rem);
            const float sn = __sinf(rem), cn = __cosf(rem);
            const float x1 = bf2f((unsigned short)qf[4][j]), x2 = bf2f((unsigned short)qf[5][j]);
            const unsigned w = pk2(x1 * cn - x2 * sn, x2 * cn + x1 * sn);
            qf[4][j] = (short)(w & 0xffffu); qf[5][j] = (short)(w >> 16);
        }
    }
    float fq = 0.f;
    if (MODE == 2) fq = FCUM[qw + r] * LOG2E;
    float m_run = -INFINITY, l_run = 0.f;
    float ub = 0.f; LAS int* wv = (LAS int*)(lds + 131072 + 768);
    if (MODE == 2) {
        float q2 = 0.f;
#pragma unroll
        for (int d0 = 0; d0 < 4; ++d0)
#pragma unroll
            for (int e = 0; e < 8; ++e) { const float x = bf2f((unsigned short)qf[d0][e]); q2 = fmaf(x, x, q2); }
        { auto rr = __builtin_amdgcn_permlane32_swap(__float_as_uint(q2), __float_as_uint(q2), false, false); q2 = __uint_as_float(rr[0]) + __uint_as_float(rr[1]); }
        const unsigned kbits = ((const unsigned*)(ws_ + WS_CTL))[1024 + b * 4 + h];
        ub = sqrtf(q2) * sqrtf(__uint_as_float(kbits)) * cs * 1.0001f + 0.01f;
    }
    f32x16 o0, o1;
#pragma unroll
    for (int i = 0; i < 16; ++i) { o0[i] = 0.f; o1[i] = 0.f; }
    ATT_STORE(0, A);
    __syncthreads();
    const int i16 = lane & 15, vq = i16 >> 2, vp = i16 & 3, vblk = (lane >> 4) & 1;
    const int voff = (4 * hh + vq) * VP + vblk * 32 + vp * 8;

    auto compute = [&](const int j, const int s) __attribute__((always_inline)) {
        const bool active = (MODE == 0) ? (j <= qc && j >= qc - 8) : (j <= qc);
        if (active) {
            const LAS unsigned char* kb = Ks + s * KBUF + r * KP + hh * 16;
            f32x16 p0, p1;
#pragma unroll
            for (int i = 0; i < 16; ++i) { p0[i] = 0.f; p1[i] = 0.f; }
#pragma unroll
            for (int d0 = 0; d0 < ND; ++d0) {
                const bf16x8 kf0 = *(const LAS bf16x8*)(kb + d0 * 32), kf1 = *(const LAS bf16x8*)(kb + 32 * KP + d0 * 32);
                p0 = MFMA32(kf0, qf[d0], p0); p1 = MFMA32(kf1, qf[d0], p1);
            }
            if (MODE == 0) {
                const int delta = qc - j;
                if (delta >= 3) { const float cb = Tab[256];
#pragma unroll
                    for (int i = 0; i < 16; ++i) { p0[i] = fmaf(p0[i], cs, cb); p1[i] = fmaf(p1[i], cs, cb); }
                } else { const int brel = 64 * delta + (qw & 63) + r + 128;
#pragma unroll
                    for (int i = 0; i < 16; ++i) { const int kj = crow(i, hh); int i0 = brel - kj, i1 = brel - kj - 32;
                        i0 = i0 < 0 ? 0 : (i0 > 256 ? 256 : i0); i1 = i1 < 0 ? 0 : (i1 > 256 ? 256 : i1);
                        p0[i] = fmaf(p0[i], cs, Tab[i0]); p1[i] = fmaf(p1[i], cs, Tab[i1]); }
                }
            } else if (MODE == 1) {
#pragma unroll
                for (int i = 0; i < 16; ++i) { p0[i] *= cs; p1[i] *= cs; }
            } else {
                const LAS float* fs = Fs + s * 64 + 4 * hh;
#pragma unroll
                for (int g = 0; g < 4; ++g) { const f32x4 f0 = *(const LAS f32x4*)(fs + 8 * g), f1 = *(const LAS f32x4*)(fs + 32 + 8 * g);
#pragma unroll
                    for (int e = 0; e < 4; ++e) { p0[4 * g + e] = fmaf(p0[4 * g + e], cs, fq - f0[e]); p1[4 * g + e] = fmaf(p1[4 * g + e], cs, fq - f1[e]); } }
                if (j == qc) { const int qrel = (qw & 63) + r;
#pragma unroll
                    for (int i = 0; i < 16; ++i) { const int kj = crow(i, hh); if (kj > qrel) p0[i] = -INFINITY; if (kj + 32 > qrel) p1[i] = -INFINITY; } }
            }
            float mx = p0[0];
#pragma unroll
            for (int i = 1; i < 16; ++i) mx = fmaxf(mx, p0[i]);
#pragma unroll
            for (int i = 0; i < 16; ++i) mx = fmaxf(mx, p1[i]);
            { auto rr = __builtin_amdgcn_permlane32_swap(__float_as_uint(mx), __float_as_uint(mx), false, false); mx = fmaxf(__uint_as_float(rr[0]), __uint_as_float(rr[1])); }
            if (__all(mx < m_run - 40.f)) return;
            if (__any(mx > m_run)) {
                const float m_new = fmaxf(m_run, mx);
                const float alpha = __builtin_amdgcn_exp2f(m_run - m_new);
                m_run = m_new; l_run *= alpha;
#pragma unroll
                for (int i = 0; i < 16; ++i) { o0[i] *= alpha; o1[i] *= alpha; }
            }
            float sum = 0.f;
#pragma unroll
            for (int i = 0; i < 16; ++i) { p0[i] = __builtin_amdgcn_exp2f(p0[i] - m_run); p1[i] = __builtin_amdgcn_exp2f(p1[i] - m_run); sum += p0[i] + p1[i]; }
            l_run += sum;
            const LAS unsigned char* vb = Vs + s * VBUF + voff;
#pragma unroll
            for (int kbk = 0; kbk < 2; ++kbk)
#pragma unroll
                for (int st = 0; st < 2; ++st) {
                    const f32x16& pp = kbk ? p1 : p0;
                    u32x4 pw; pw.x = pk2(pp[8 * st + 0], pp[8 * st + 1]); pw.y = pk2(pp[8 * st + 2], pp[8 * st + 3]); pw.z = pk2(pp[8 * st + 4], pp[8 * st + 5]); pw.w = pk2(pp[8 * st + 6], pp[8 * st + 7]);
                    const bf16x8 pf = __builtin_bit_cast(bf16x8, pw);
                    const LAS unsigned char* vr = vb + (32 * kbk + 16 * st) * VP;
                    const s16x4 a_lo = vtr(vr), a_hi = vtr(vr + 8 * VP), b_lo = vtr(vr + 64), b_hi = vtr(vr + 8 * VP + 64);
                    const bf16x8 v0 = __builtin_shufflevector(a_lo, a_hi, 0, 1, 2, 3, 4, 5, 6, 7), v1 = __builtin_shufflevector(b_lo, b_hi, 0, 1, 2, 3, 4, 5, 6, 7);
                    o0 = MFMA32(v0, pf, o0); o1 = MFMA32(v1, pf, o1);
                }
        }
    };
    for (int j = t_hi - 1; j >= t_lo; j -= 2) {
        ATT_LOAD(j - 2, A);
        compute(j, 0);
        if (MODE == 2) { const int vote = (j <= qc) ? (int)__all(ub + fq - Fs[0] < m_run - 40.f) : 0; if (lane == 0) wv[wid] = vote; }
        ATT_STORE(1, B);
        __syncthreads();
        if (MODE == 2) { int all = 1;
#pragma unroll
            for (int w = 0; w < 8; ++w) all &= wv[w];
            if (all) break; }
        ATT_LOAD(j - 3, B);
        compute(j - 1, 1);
        if (MODE == 2) { const int vote = (j - 1 <= qc) ? (int)__all(ub + fq - Fs[64] < m_run - 40.f) : 0; if (lane == 0) wv[8 + wid] = vote; }
        ATT_STORE(0, A);
        __syncthreads();
        if (MODE == 2) { int all = 1;
#pragma unroll
            for (int w = 0; w < 8; ++w) all &= wv[8 + w];
            if (all) break; }
    }
    const float l_tot = l_run + __shfl_xor(l_run, 32);
    const float inv = 1.0f / l_tot;
    bf16_t* dst = BR + (tok0 + qw + r) * 1024 + (MODE == 0 ? 0 : (MODE == 1 ? 256 : 512)) + h * 64 + 4 * hh;
#pragma unroll
    for (int g = 0; g < 4; ++g) {
        u32x2 w0, w1;
        w0.x = pk2(o0[4 * g] * inv, o0[4 * g + 1] * inv); w0.y = pk2(o0[4 * g + 2] * inv, o0[4 * g + 3] * inv);
        w1.x = pk2(o1[4 * g] * inv, o1[4 * g + 1] * inv); w1.y = pk2(o1[4 * g + 2] * inv, o1[4 * g + 3] * inv);
        *(u32x2*)(dst + 8 * g) = w0; *(u32x2*)(dst + 32 + 8 * g) = w1;
    }
#undef ATT_LOAD
#undef ATT_STORE
}
}

__device__ __forceinline__ void transpose_item(const float* W, int N, int nblk, bf16_t* WT, int ldt, LAS float* scr, int item, int lane, const float* gk = nullptr) {
    const int kb = item / nblk, nb = item % nblk, k0 = 64 * kb, n0 = 32 * nb;
    const int nn = n0 + (lane & 31); const bool ok = nn < N;
    float tmp[32];
#pragma unroll
    for (int i = 0; i < 32; ++i) { const int kk = 2 * i + (lane >> 5); tmp[i] = ok ? W[(size_t)(k0 + kk) * N + nn] : 0.f; }
#pragma unroll
    for (int i = 0; i < 32; ++i) { const int kk = 2 * i + (lane >> 5); scr[kk * 33 + (lane & 31)] = tmp[i]; }
    LDS_WAIT(); asm volatile("" ::: "memory");
    const int c = lane & 7;
    f32x4 ga = {1.f, 1.f, 1.f, 1.f}, gb = ga;
    if (gk) { ga = *(const f32x4*)(gk + k0 + 8 * c); gb = *(const f32x4*)(gk + k0 + 8 * c + 4); }
#pragma unroll
    for (int j = 0; j < 4; ++j) { const int n = (lane >> 3) + 8 * j; const LAS float* s = scr + (8 * c) * 33 + n;
        u32x4 o; o.x = pk2(s[0 * 33] * ga.x, s[1 * 33] * ga.y); o.y = pk2(s[2 * 33] * ga.z, s[3 * 33] * ga.w); o.z = pk2(s[4 * 33] * gb.x, s[5 * 33] * gb.y); o.w = pk2(s[6 * 33] * gb.z, s[7 * 33] * gb.w);
        *(u32x4*)(WT + (size_t)(n0 + n) * ldt + k0 + 8 * c) = o; }
    LDS_WAIT(); asm volatile("" ::: "memory");
}
__device__ __forceinline__ void prenorm_row(const float* xrow, bf16_t* orow, float* rowss, int lane) {
    const f32x4* xr = (const f32x4*)xrow + lane;
    f32x4 v[4]; float s = 0.f;
#pragma unroll
    for (int j = 0; j < 4; ++j) { v[j] = xr[64 * j]; s += (v[j].x * v[j].x + v[j].y * v[j].y) + (v[j].z * v[j].z + v[j].w * v[j].w); }
    s = wave_sum(s); if (lane < 16) rowss[lane] = (lane == 0) ? s : 0.f;
#pragma unroll
    for (int j = 0; j < 4; ++j) { u32x2 w; w.x = pk2(v[j].x, v[j].y); w.y = pk2(v[j].z, v[j].w); ((u32x2*)orow)[lane + 64 * j] = w; }
}
__device__ __forceinline__ float logsig(float z) { return fminf(z, 0.f) - __logf(1.0f + __expf(-fabsf(z))); }


constexpr int I_G = 16 * 128, I_B = 4 * 32, I_O = 16 * 32, I_U = 16 * 128, I_D = 64 * 32, N_LATE_ITEMS = I_G + 4 * I_B + I_O + I_U + I_D;
__device__ __forceinline__ void late_weight_item(int l, int r, LAS float* scr, int lane) {
    const cargs_t ap = get_args(); unsigned char* const ws = ap->ws;
    if (r < I_G) { transpose_item(ap->w_gate + (size_t)l * 1024 * 4096, 4096, 128, (bf16_t*)(ws + WS_WGT), 1024, scr, r, lane, ap->g_mix + l * 1024); return; } r -= I_G;
    if (r < 4 * I_B) { const int n = r / I_B; transpose_item(ap->w_branch + (size_t)l * 4 * 256 * 1024 + (size_t)n * 256 * 1024, 1024, 32, (bf16_t*)(ws + WS_WBT) + (size_t)n * 1024 * 1024 + n * 256, 1024, scr, r % I_B, lane); return; } r -= 4 * I_B;
    if (r < I_O) { transpose_item(ap->w_o + (size_t)l * 1024 * 1024, 1024, 32, (bf16_t*)(ws + WS_WOT), 1024, scr, r, lane); return; } r -= I_O;
    if (r < I_U) { transpose_item(ap->w_up + (size_t)l * 1024 * 4096, 4096, 128, (bf16_t*)(ws + WS_W1T), 1024, scr, r, lane, ap->g_ffn + l * 1024); return; } r -= I_U;
    transpose_item(ap->w_down + (size_t)l * 4096 * 1024, 1024, 32, (bf16_t*)(ws + WS_W2T), 4096, scr, r, lane);
}
__device__ __forceinline__ void conv_tokens(int l, int t0, int lane) {
    const cargs_t ap = get_args(); unsigned char* const ws = ap->ws;
    const bf16_t* U = (const bf16_t*)(ws + WS_U); bf16_t* BR = (bf16_t*)(ws + WS_BR);
    const float* wdw = ap->w_dw + (size_t)l * 31 * 256; const f32x4 bdw = *(const f32x4*)(ap->b_dw + l * 256 + 4 * lane);
    const f32x4 gln = *(const f32x4*)(ap->g_conv_ln + l * 256 + 4 * lane), bln = *(const f32x4*)(ap->b_conv_ln + l * 256 + 4 * lane);
    const int ts0 = t0 & (SEQ - 1);
    const float* wl = wdw + 4 * lane; asm volatile("" : "+v"(wl));
    u32x2 ur[38];
#pragma unroll
    for (int i = 0; i < 38; ++i) { const int tt = ts0 - 30 + i; ur[i] = (u32x2){0u, 0u}; if (tt >= 0) ur[i] = *(const u32x2*)(U + (size_t)(t0 - 30 + i) * 256 + 4 * lane); }
    f32x4 acc[8];
#pragma unroll
    for (int j = 0; j < 8; ++j) acc[j] = bdw;
#pragma unroll
    for (int k = 0; k < 31; ++k) { const f32x4 w = *(const f32x4*)(wl + k * 256);
#pragma unroll
        for (int j = 0; j < 8; ++j) { const u32x2 u = ur[j + k];
            acc[j].x = fmaf(lo_f(u.x), w.x, acc[j].x); acc[j].y = fmaf(hi_f(u.x), w.y, acc[j].y); acc[j].z = fmaf(lo_f(u.y), w.z, acc[j].z); acc[j].w = fmaf(hi_f(u.y), w.w, acc[j].w); } }
#pragma unroll
    for (int j = 0; j < 8; ++j) {
        const float mean = wave_sum((acc[j].x + acc[j].y) + (acc[j].z + acc[j].w)) * (1.0f / 256.0f);
        const f32x4 d = acc[j] - mean;
        const float rstd = 1.0f / sqrtf(wave_sum((d.x * d.x + d.y * d.y) + (d.z * d.z + d.w * d.w)) * (1.0f / 256.0f) + EPS);
        const f32x4 y = d * rstd * gln + bln;
        u32x2 o; o.x = pk2(y.x * sigmoidf_(y.x), y.y * sigmoidf_(y.y)); o.y = pk2(y.z * sigmoidf_(y.z), y.w * sigmoidf_(y.w));
        *(u32x2*)(BR + (size_t)(t0 + j) * 1024 + 768 + 4 * lane) = o;
    }
}

__device__ __forceinline__ void win_item(int l, int r, LAS float* scr, int lane) {
    const cargs_t ap = get_args();
    transpose_item(ap->w_in + (size_t)l * 1024 * INC, INC, 80, (bf16_t*)(ap->ws + (l == 0 ? WS_WINT : WS_WINT1)), 1024, scr, r, lane, ap->g_mix + l * 1024);
}
__device__ __forceinline__ void wlat_chunk(int l, int c) {
    const cargs_t ap = get_args();
    const float* w_uq = ap->w_uq + (size_t)l * 256 * 384; const float* w_ukv = ap->w_ukv + (size_t)l * 128 * 512; const float* gq = ap->g_q_lat + l * 256; const float* gkv = ap->g_kv_lat + l * 128;
    const int n = c / 48, k0 = (c % 48) * 8; float v[8];
#pragma unroll
    for (int e = 0; e < 8; ++e) { const int k = k0 + e; v[e] = (n < 384 && k < 256) ? gq[k] * w_uq[(size_t)k * 384 + n] : ((n >= 512 && k >= 256) ? gkv[k - 256] * w_ukv[(size_t)(k - 256) * 512 + (n - 512)] : 0.f); }
    u32x4 o; o.x = pk2(v[0], v[1]); o.y = pk2(v[2], v[3]); o.z = pk2(v[4], v[5]); o.w = pk2(v[6], v[7]);
    *(u32x4*)((bf16_t*)(ap->ws + (l == 0 ? WS_WLT : WS_WLT1)) + (size_t)n * 384 + k0) = o;
}

#define XB_TMO      128
#define XB_XCNT(j)  (256  + 64 * (j))
#define XB_XSUB(j)  (1280 + 64 * (j))
#define XB_XGEN(j)  (2304 + 64 * (j))
#define XB_TOP      3328
#define XB_TOPGEN   3392
#define XCD_BAR_WORDS 3456
#define XB_SPIN_CAP (1u << 18)
__device__ __forceinline__ unsigned xb_ld(unsigned* p)              { return __hip_atomic_load(p, __ATOMIC_RELAXED, __HIP_MEMORY_SCOPE_AGENT); }
__device__ __forceinline__ unsigned xb_add(unsigned* p, unsigned v) { return __hip_atomic_fetch_add(p, v, __ATOMIC_RELAXED, __HIP_MEMORY_SCOPE_AGENT); }
__device__ __forceinline__ unsigned xb_xcc_id() { return (unsigned)__builtin_amdgcn_s_getreg((3 << 11) | 20) & 0xFu; }
#define XB_SPIN(cond, bar) do { unsigned _sp = 0; while (cond) { __builtin_amdgcn_s_sleep(1); \
    if ((++_sp & 255u) == 0u) { if (xb_ld(&(bar)[XB_TMO])) break; if (_sp > XB_SPIN_CAP) { atomicAdd(&(bar)[XB_TMO], 1u); break; } } } } while (0)
struct XcdBarrier { unsigned* bar; unsigned x; volatile LAS unsigned* st; };
__device__ __forceinline__ void xcd_barrier_complete(unsigned* bar, unsigned x, unsigned& nloc, unsigned& nx) {
    const unsigned G = gridDim.x * gridDim.y * gridDim.z;
    unsigned sum, cnt, mine, sp = 0u;
    for (;;) {
        sum = 0u; cnt = 0u; mine = 0u;
#pragma unroll
        for (unsigned j = 0; j < 16; ++j) { const unsigned c = xb_ld(&bar[XB_XCNT(j)]); sum += c; cnt += (c > 0u) ? 1u : 0u; mine = (j == x) ? c : mine; }
        if (sum == G) break;
        __builtin_amdgcn_s_sleep(1);
        if ((++sp & 255u) == 0u) { if (xb_ld(&bar[XB_TMO])) break; if (sp > XB_SPIN_CAP) { atomicAdd(&bar[XB_TMO], 1u); break; } }
    }
    nloc = mine > 0u ? mine : 1u; nx = cnt > 0u ? cnt : 1u;
}
__device__ __forceinline__ void xcd_barrier(const XcdBarrier& b) {
    asm volatile("s_waitcnt vmcnt(0)" ::: "memory");
    __syncthreads();
    if (threadIdx.x == 0) {
        unsigned* bar = b.bar;
        __builtin_amdgcn_s_waitcnt(0);
        unsigned nloc = b.st[0], nx = b.st[1];
        if (nloc == 0u) { xcd_barrier_complete(bar, b.x, nloc, nx); b.st[0] = nloc; b.st[1] = nx; }
        const unsigned old = xb_add(&bar[XB_XSUB(b.x)], 1u);
        const unsigned gen = old / nloc;
        if (old + 1u == (gen + 1u) * nloc) {
            __builtin_amdgcn_fence(__ATOMIC_RELEASE, "agent");
            asm volatile("s_waitcnt vmcnt(0)" ::: "memory");
            const unsigned og = xb_add(&bar[XB_TOP], 1u);
            const unsigned tg = og / nx;
            if (og + 1u == (tg + 1u) * nx) xb_add(&bar[XB_TOPGEN], 1u);
            else XB_SPIN(xb_ld(&bar[XB_TOPGEN]) == tg, bar);
            __builtin_amdgcn_fence(__ATOMIC_ACQUIRE, "agent");
            xb_add(&bar[XB_XGEN(b.x)], 1u);
            asm volatile("s_waitcnt vmcnt(0)" ::: "memory");
        } else {
            XB_SPIN(xb_ld(&bar[XB_XGEN(b.x)]) == gen, bar);
            __builtin_amdgcn_fence(__ATOMIC_ACQUIRE, "agent");
            asm volatile("s_waitcnt vmcnt(0)" ::: "memory");
        }
    }
    __syncthreads();
}
constexpr int CTL_BAR_WORD = 4096;
constexpr int LDS_MISC = 131072 + 128;
#define GRID_BAR() do { const cargs_t ap_ = get_args(); XcdBarrier b_; b_.bar = (unsigned*)(ap_->ws + WS_CTL) + CTL_BAR_WORD; b_.x = xb_xcc_id(); \
    b_.st = (volatile LAS unsigned*)(lds + LDS_MISC); xcd_barrier(b_); } while (0)

#define WSP(T, off) ((T*)(ws + (off)))
#define REP_P1 1
#define REP_P2 1
#define REP_P3 1
#define REP_P4 1
#define REP_P5 1
#define REP_P6 1
#define REP_P7 1
#define REP_P8 1
#define REP_P9 1
#define REP_P10 1
#define REP_SYNC 0
#define PHASE_BEGIN(R) _Pragma("unroll 1") for (int rep = 0; rep < (R); ++rep) {
#define PHASE_END GRID_BAR(); }
__global__ void __launch_bounds__(512, 2) fwd_megakernel(Args A_unused) {
    extern __shared__ __attribute__((aligned(16))) unsigned char lds_raw[];
    LAS unsigned char* lds = (LAS unsigned char*)lds_raw;
    {
        if (threadIdx.x < 8) ((LAS unsigned*)(lds + LDS_MISC))[threadIdx.x] = 0u;
        __syncthreads();
        const cargs_t ap = get_args();
        if (threadIdx.x == 0) (void)xb_add((unsigned*)(ap->ws + WS_CTL) + CTL_BAR_WORD + XB_XCNT(xb_xcc_id()), 1u);
    }
    cg::this_grid().sync();

#pragma unroll 1
    for (int l = 0; l < 2; ++l) {
        if (l == 0) {
        PHASE_BEGIN(REP_P1)
            const cargs_t ap = get_args(); unsigned char* const ws = ap->ws;
            const int tid = fresh_tid(), lane = tid & 63, wid = __builtin_amdgcn_readfirstlane(tid >> 6), G = gridDim.x, bx = blockIdx.x, gw = bx * 8 + wid, NGW = G * 8;
            LAS float* scr = (LAS float*)(lds + wid * 16384);
            for (int it = gw; it < 1280; it += NGW) win_item(0, it, scr, lane);
            for (int c = bx * 512 + tid; c < 1024 * 48; c += G * 512) wlat_chunk(0, c);
            const float* xin = ap->x; bf16_t* XN = WSP(bf16_t, WS_XN); float* rss = WSP(float, WS_ROWSS);
            for (int m = gw; m < TOK; m += NGW) prenorm_row(xin + (size_t)m * 1024, XN + (size_t)m * 1024, rss + (size_t)m * 16, lane);
        GRID_BAR(); }
        }
        PHASE_BEGIN(REP_P2)
            const cargs_t ap = get_args(); unsigned char* const ws = ap->ws;
            const char* hin = (l == 0) ? WSP(const char, WS_XN) : (const char*)ap->out;
            pg8::PlainOrder S{hin, (l == 0) ? WSP(const char, WS_WINT) : WSP(const char, WS_WINT1), 1024, 1024, 64, 10, 16, (int)gridDim.x, (int)blockIdx.x};
            const float* slots = WSP(const float, WS_ROWSS) + (size_t)(l * 2) * ROWSS_STRIDE;
            pg8::Unit u0; int pm0 = -1; if (S.next(0, u0)) { pm0 = u0.pm; fill_rinv_table(lds, slots, pm0); }
            pg8::EpiBf16<0, 1, true> E{WSP(bf16_t, WS_PROJ), PLD, slots, pm0, (unsigned)(uintptr_t)(lds + LDS_RINV), WSP(float, WS_LATSS)};
            pg8::gemm_phase(lds, 1024, 1024, S, E);
        PHASE_END
        PHASE_BEGIN(REP_P3)
            const cargs_t ap = get_args(); unsigned char* const ws = ap->ws;
            const int tid = fresh_tid(), lane = tid & 63, wid = __builtin_amdgcn_readfirstlane(tid >> 6), G = gridDim.x, bx = blockIdx.x, gw = bx * 8 + wid, NGW = G * 8;
            const bf16_t* PROJ = WSP(const bf16_t, WS_PROJ);
            if (bx < 16) {
                const int b = bx >> 2, h = bx & 3; const float bf = ap->b_forget[l * 4 + h];
                const bf16_t* src = PROJ + ((size_t)b * SEQ + tid * 8) * PLD + C_CF + h;
                float v[8];
#pragma unroll
                for (int i = 0; i < 8; ++i) v[i] = bf2f(src[(size_t)i * PLD]);
#pragma unroll
                for (int i = 0; i < 8; ++i) { v[i] = logsig(v[i] + bf); if (i) v[i] += v[i - 1]; }
                float incl = v[7];
#pragma unroll
                for (int o = 1; o < 64; o <<= 1) { const float u = __shfl_up(incl, o); if (lane >= o) incl += u; }
                LAS float* wtot = (LAS float*)(lds + 131072 + 64);
                if (lane == 63) wtot[wid] = incl;
                __syncthreads();
                float off = incl - v[7];
                for (int w = 0; w < wid; ++w) off += wtot[w];
                float* dst = WSP(float, WS_FCUM) + (size_t)(b * 4 + h) * SEQ + tid * 8;
                f32x4 o0 = {v[0] + off, v[1] + off, v[2] + off, v[3] + off}, o1 = {v[4] + off, v[5] + off, v[6] + off, v[7] + off};
                *(f32x4*)dst = o0; *(f32x4*)(dst + 4) = o1;
            }
            const int* posp = ap->pos;
            bf16_t* KROT = WSP(bf16_t, WS_KROT); bf16_t* U = WSP(bf16_t, WS_U);
            const float invf = exp2f(-(float)(lane & 15) * 0.8304820237218406f);
            const bool kx = (gridDim.x == 256); unsigned* KMAXp = (unsigned*)(ws + WS_CTL) + 1024; LAS float* kred = (LAS float*)(lds + 131072 + 512); int kiter = 0;
            if (!kx && bx == 0 && tid < 16) atomicMax(KMAXp + tid, 0x7f7fffffu);
            for (int t0 = gw * 4; t0 < TOK; t0 += NGW * 4) {
                u32x2 dv4[4], dg4[4], ck4[4]; float x14[4], x24[4], pos4[4];
#pragma unroll
                for (int j = 0; j < 4; ++j) { const bf16_t* row = PROJ + (size_t)(t0 + j) * PLD;
                    dv4[j] = *(const u32x2*)(row + C_DV + 4 * lane); dg4[j] = *(const u32x2*)(row + C_DG + 4 * lane); ck4[j] = *(const u32x2*)(row + C_CK + 4 * lane);
                    x14[j] = bf2f(row[C_BKR + (lane & 15)]); x24[j] = bf2f(row[C_BKR + 16 + (lane & 15)]); pos4[j] = (float)posp[t0 + j]; }
#pragma unroll
                for (int j = 0; j < 4; ++j) { const int t = t0 + j;
                    if (lane < 16) {
                        const float ang = pos4[j] * invf, kk = rintf(ang * 0.15915494309189535f);
                        float rem = fmaf(-kk, 6.2831854820251465f, ang); rem = fmaf(kk, 1.7484555e-7f, rem);
                        const float sn = __sinf(rem), cn = __cosf(rem);
                        const unsigned w = pk2(x14[j] * cn - x24[j] * sn, x24[j] * cn + x14[j] * sn);
                        KROT[(size_t)t * 32 + lane] = (bf16_t)(w & 0xffffu); KROT[(size_t)t * 32 + 16 + lane] = (bf16_t)(w >> 16);
                    }
                    {
                        const u32x2 v = dv4[j], gt = dg4[j];
                        u32x2 o; o.x = pk2(lo_f(v.x) * sigmoidf_(lo_f(gt.x)), hi_f(v.x) * sigmoidf_(hi_f(gt.x))); o.y = pk2(lo_f(v.y) * sigmoidf_(lo_f(gt.y)), hi_f(v.y) * sigmoidf_(hi_f(gt.y)));
                        *(u32x2*)(U + (size_t)t * 256 + 4 * lane) = o;
                    }
                }
                if (kx) {
                    float km = 0.f;
#pragma unroll
                    for (int j = 0; j < 4; ++j) { const float a0 = lo_f(ck4[j].x), a1 = hi_f(ck4[j].x), a2 = lo_f(ck4[j].y), a3 = hi_f(ck4[j].y); float q = (a0 * a0 + a1 * a1) + (a2 * a2 + a3 * a3);
                        q += __shfl_xor(q, 1); q += __shfl_xor(q, 2); q += __shfl_xor(q, 4); q += __shfl_xor(q, 8); km = fmaxf(km, q); }
                    const int par = kiter & 1; ++kiter;
                    if ((lane & 15) == 0) kred[par * 32 + wid * 4 + (lane >> 4)] = km;
                    __syncthreads();
                    if (tid < 4) { float m = kred[par * 32 + tid];
#pragma unroll
                        for (int w = 1; w < 8; ++w) m = fmaxf(m, kred[par * 32 + w * 4 + tid]);
                        atomicMax(KMAXp + (t0 >> 12) * 4 + tid, __float_as_uint(m)); }
                }
            }
            { const cargs_t ap2 = get_args(); unsigned char* const ws = ap2->ws;
              pg8::PlainOrder S{WSP(const char, WS_PROJ) + C_BQL * 2, (l == 0) ? WSP(const char, WS_WLT) : WSP(const char, WS_WLT1), PLD, 384, 64, 4, 6, (int)gridDim.x, (int)blockIdx.x};
              pg8::EpiBf16<0, 2> E{WSP(bf16_t, WS_QKVB), 1024, nullptr, -1, 0u, WSP(float, WS_LATSS)};
              pg8::gemm_phase(lds, PLD, 384, S, E); }
        PHASE_END
        PHASE_BEGIN(REP_P5)
            LAS int* wq = (LAS int*)(lds + 131072);
            for (;;) {
                __syncthreads();
                if (threadIdx.x == 0) { const cargs_t ap = get_args(); wq[0] = atomicAdd((int*)(ap->ws + WS_CTL) + 16 * (l * 8 + rep), 1); }
                __syncthreads();
                const int it = wq[0];
                if (it >= 768 + 256 + N_LATE_ITEMS / 16 + (l == 0 ? 80 + 96 : 0)) break;
                if (it >= 768) {
                    const int tidq = fresh_tid(), laneq = tidq & 63, widq = __builtin_amdgcn_readfirstlane(tidq >> 6);
                    if (it < 1024) conv_tokens(l, ((it - 768) * 8 + widq) * 8, laneq);
                    else if (it >= 1024 + N_LATE_ITEMS / 16) {
                        const int e = it - (1024 + N_LATE_ITEMS / 16);
                        if (e < 80) { LAS float* scr = (LAS float*)(lds + widq * 16384); win_item(l + 1, e * 16 + widq * 2, scr, laneq); win_item(l + 1, e * 16 + widq * 2 + 1, scr, laneq); }
                        else wlat_chunk(l + 1, (e - 80) * 512 + tidq);
                    }
                    else { LAS float* scr = (LAS float*)(lds + widq * 16384); const int r0 = (it - 1024) * 16 + widq * 2; late_weight_item(l, r0, scr, laneq); late_weight_item(l, r0 + 1, scr, laneq); }
                    continue;
                }
                int mode, bh, qb;
                if (it >= 384 && it < 640) { const int a = it - 384; mode = 0; bh = a & 15; qb = a >> 4; }
                else { const int k = it < 384 ? it : it - 256; const int lvl = k >> 5, w = k & 31; qb = 15 - lvl; mode = (w < 16) ? 1 : 2; bh = w & 15; }
                if (mode == 0) att::unit<0>(l, bh >> 2, bh & 3, qb, lds);
                else if (mode == 1) att::unit<1>(l, bh >> 2, bh & 3, qb, lds);
                else att::unit<2>(l, bh >> 2, bh & 3, qb, lds);
            }
        PHASE_END
        PHASE_BEGIN(REP_P6)
            const cargs_t ap = get_args(); unsigned char* const ws = ap->ws;
            const char* hin = (l == 0) ? WSP(const char, WS_XN) : (const char*)ap->out;
            pg8::GateBranchOrder S{hin, WSP(const char, WS_BR), WSP(const char, WS_WGT), WSP(const char, WS_WBT), (int)gridDim.x, (int)blockIdx.x};
            const float* slots = WSP(const float, WS_ROWSS) + (size_t)(l * 2) * ROWSS_STRIDE; const float* bg = ap->b_gate + (size_t)l * 4096;
            pg8::Unit u0; int pm0 = -1, pd0 = -1;
            if (S.next(0, u0)) { pm0 = u0.pm; pd0 = u0.pn & 3; const int t = fresh_tid();
                ((LAS float*)(lds + LDS_BIAS))[t] = bg[(t >> 8) * 1024 + pd0 * 256 + (t & 255)]; ((LAS float*)(lds + LDS_BIAS))[t + 512] = bg[((t + 512) >> 8) * 1024 + pd0 * 256 + (t & 255)];
                fill_rinv_table(lds, slots, pm0); }
            pg8::EpiGateBranch E{WSP(bf16_t, WS_MIXED), bg, slots, (LAS unsigned*)(lds + 131072 + 1024), pm0, pd0, (unsigned)(uintptr_t)(lds + LDS_RINV), (unsigned)(uintptr_t)(lds + LDS_BIAS)};
            pg8::gemm_phase(lds, 1024, 1024, S, E);
        PHASE_END
        PHASE_BEGIN(REP_P7)
            const cargs_t ap = get_args(); unsigned char* const ws = ap->ws;
            pg8::PlainOrder S{WSP(const char, WS_MIXED), WSP(const char, WS_WOT), 1024, 1024, 64, 4, 16, (int)gridDim.x, (int)blockIdx.x};
            if (l == 0) { pg8::EpiRes<true> E{ap->x, WSP(bf16_t, WS_XA), WSP(float, WS_ROWSS) + (size_t)1 * ROWSS_STRIDE};
                pg8::gemm_phase(lds, 1024, 1024, S, E); }
            else { pg8::EpiRes<false> E{ap->out, WSP(bf16_t, WS_XA), WSP(float, WS_ROWSS) + (size_t)3 * ROWSS_STRIDE};
                pg8::gemm_phase(lds, 1024, 1024, S, E); }
        PHASE_END
        PHASE_BEGIN(REP_P9)
            const cargs_t ap = get_args(); unsigned char* const ws = ap->ws;
            pg8::PlainOrder S{WSP(const char, WS_XA), WSP(const char, WS_W1T), 1024, 1024, 64, 16, 16, (int)gridDim.x, (int)blockIdx.x};
            const float* slots = WSP(const float, WS_ROWSS) + (size_t)(l * 2 + 1) * ROWSS_STRIDE;
            pg8::Unit u0; int pm0 = -1; if (S.next(0, u0)) { pm0 = u0.pm; fill_rinv_table(lds, slots, pm0); }
            pg8::EpiBf16<2, 1> E{WSP(bf16_t, WS_H), 4096, slots, pm0, (unsigned)(uintptr_t)(lds + LDS_RINV), nullptr};
            pg8::gemm_phase(lds, 1024, 1024, S, E);
        PHASE_END
        PHASE_BEGIN(REP_P10)
            const cargs_t ap = get_args(); unsigned char* const ws = ap->ws;
            pg8::PlainOrder S{WSP(const char, WS_H), WSP(const char, WS_W2T), 4096, 4096, 64, 4, 64, (int)gridDim.x, (int)blockIdx.x};
            if (l == 0) { pg8::EpiRes<false> E{WSP(const bf16_t, WS_XA), (bf16_t*)ap->out, WSP(float, WS_ROWSS) + (size_t)2 * ROWSS_STRIDE};
                pg8::gemm_phase(lds, 4096, 4096, S, E); }
            else { pg8::EpiFinal E{WSP(const bf16_t, WS_XA), ap->out, WSP(float, WS_ROWSS) + (size_t)4 * ROWSS_STRIDE, ap->g_final, (unsigned*)(ws + WS_CTL) + 8192};
                pg8::gemm_phase(lds, 4096, 4096, S, E); }
        if (l == 0) GRID_BAR(); }
    }
    _Pragma("unroll 1") for (int i = 0; i < REP_SYNC; ++i) GRID_BAR();
}

extern "C" void kernel_launch(void* const* d_in, const int* in_sizes, int n_in, void* d_out, int out_size, void* d_ws, size_t ws_size, hipStream_t stream) {
    static int grid = 0;
    if (grid == 0) {
        if (n_in != 22 || out_size != TOK * DM || ws_size < WS_END) { fprintf(stderr, "kernel_launch: unexpected shapes (n_in %d out %d ws %zu)\n", n_in, out_size, ws_size); grid = -1; return; }
        int dev = 0, cus = 0, per_cu = 0;
        if (hipGetDevice(&dev) != hipSuccess || hipDeviceGetAttribute(&cus, hipDeviceAttributeMultiprocessorCount, dev) != hipSuccess) { grid = -1; return; }
        if (hipFuncSetAttribute((const void*)fwd_megakernel, hipFuncAttributeMaxDynamicSharedMemorySize, LDS_BYTES) != hipSuccess) { fprintf(stderr, "hipFuncSetAttribute failed\n"); grid = -1; return; }
        if (hipOccupancyMaxActiveBlocksPerMultiprocessor(&per_cu, (const void*)fwd_megakernel, 512, LDS_BYTES) != hipSuccess || per_cu < 1) { fprintf(stderr, "occupancy query: %d blocks per CU\n", per_cu); grid = -1; return; }
        grid = cus;
    }
    if (grid < 0) return;
    (void)hipMemsetAsync((char*)d_ws + WS_CTL, 0, 65536, stream);
    Args a{};
    a.x = (const float*)d_in[0]; a.pos = (const int*)d_in[1]; a.g_mix = (const float*)d_in[2]; a.w_in = (const float*)d_in[3]; a.w_gate = (const float*)d_in[4]; a.b_gate = (const float*)d_in[5];
    a.rel_bias = (const float*)d_in[6]; a.g_q_lat = (const float*)d_in[7]; a.w_uq = (const float*)d_in[8]; a.g_kv_lat = (const float*)d_in[9]; a.w_ukv = (const float*)d_in[10];
    a.b_forget = (const float*)d_in[11]; a.w_dw = (const float*)d_in[12]; a.b_dw = (const float*)d_in[13]; a.g_conv_ln = (const float*)d_in[14]; a.b_conv_ln = (const float*)d_in[15];
    a.w_branch = (const float*)d_in[16]; a.w_o = (const float*)d_in[17]; a.g_ffn = (const float*)d_in[18]; a.w_up = (const float*)d_in[19]; a.w_down = (const float*)d_in[20]; a.g_final = (const float*)d_in[21];
    a.out = (float*)d_out; a.ws = (unsigned char*)d_ws;
    void* args[] = {&a};
    hipError_t e = hipLaunchCooperativeKernel((const void*)fwd_megakernel, dim3(grid), dim3(512), args, LDS_BYTES, stream);
    if (e != hipSuccess) fprintf(stderr, "cooperative launch failed: %s (grid %d)\n", hipGetErrorString(e), grid);
}
```

```cpp
#include <hip/hip_runtime.h>
#include <hip/hip_cooperative_groups.h>
#include <cstdio>
#include <cstdint>
namespace cg = cooperative_groups;

#define LAS __attribute__((address_space(3)))
typedef unsigned short bf16_t;
typedef short bf16x8 __attribute__((ext_vector_type(8)));
typedef short s16x4 __attribute__((ext_vector_type(4)));
typedef float f32x4 __attribute__((ext_vector_type(4)));
typedef float f32x16 __attribute__((ext_vector_type(16)));
typedef unsigned u32x4 __attribute__((ext_vector_type(4)));
typedef unsigned u32x2 __attribute__((ext_vector_type(2)));
typedef float f32x2_t __attribute__((ext_vector_type(2)));
typedef __bf16 bf16x2_t __attribute__((ext_vector_type(2)));

constexpr int NB = 4, SEQ = 4096, DM = 1024, TOK = NB * SEQ, DFF = 4096, INC = 2468, PLD = 2560;
constexpr int C_AQ = 0, C_AK = 256, C_AV = 512, C_BQL = 768, C_BKVL = 1024, C_BKR = 1152, C_CQ = 1184, C_CK = 1440, C_CV = 1696, C_CF = 1952, C_DV = 1956, C_DG = 2212;
constexpr float LOG2E = 1.4426950408889634f;
constexpr float EPS = 1e-6f;
constexpr size_t MiB = 1u << 20;
constexpr size_t WS_W1T = 4 * MiB, WS_W2T = 12 * MiB, WS_XN = 20 * MiB, WS_PROJ = 52 * MiB, WS_XA = 52 * MiB, WS_H = 116 * MiB;
constexpr size_t WS_QKVB = 132 * MiB, WS_MIXED = 132 * MiB, WS_BR = 164 * MiB, WS_LAT = 196 * MiB, WS_U = 208 * MiB;
constexpr size_t WS_WINT = 216 * MiB, WS_WGT = 221 * MiB, WS_WLT = 229 * MiB, WS_WBT = 230 * MiB, WS_WOT = 238 * MiB;
constexpr size_t WS_CTL = 244 * MiB, WS_FCUM = 244 * MiB + 256 * 1024, WS_KROT = 245 * MiB, WS_END = 256 * MiB;
constexpr size_t WS_WINT1 = 251 * MiB, WS_WLT1 = 0, WS_LATSS = 1 * MiB;
constexpr size_t WS_ROWSS = 246 * MiB, ROWSS_STRIDE = (size_t)TOK * 16;
constexpr int LDS_RINV = 131072 + 1024 + 16384;
constexpr int LDS_BIAS = LDS_RINV + 1024;
constexpr int LDS_BYTES = LDS_BIAS + 4096;

struct Args {
    const float* x; const int* pos; const float* g_mix; const float* w_in; const float* w_gate; const float* b_gate; const float* rel_bias;
    const float* g_q_lat; const float* w_uq; const float* g_kv_lat; const float* w_ukv; const float* b_forget; const float* w_dw; const float* b_dw;
    const float* g_conv_ln; const float* b_conv_ln; const float* w_branch; const float* w_o; const float* g_ffn; const float* w_up; const float* w_down; const float* g_final;
    float* out; unsigned char* ws;
};

typedef const __attribute__((address_space(4))) Args* cargs_t;
__device__ __forceinline__ cargs_t get_args() { cargs_t p = (cargs_t)__builtin_amdgcn_kernarg_segment_ptr(); asm volatile("" : "+s"(p)); return p; }
__device__ __forceinline__ int fresh_tid() { int t = threadIdx.x; asm volatile("" : "+v"(t)); return t; }
__device__ __forceinline__ float bf2f(unsigned short b) { return __uint_as_float((unsigned)b << 16); }
__device__ __forceinline__ unsigned pk2(float lo, float hi) { f32x2_t v = {lo, hi}; bf16x2_t b = __builtin_convertvector(v, bf16x2_t); return __builtin_bit_cast(unsigned, b); }
__device__ __forceinline__ float lo_f(unsigned w) { return __uint_as_float(w << 16); }
__device__ __forceinline__ float hi_f(unsigned w) { return __uint_as_float(w & 0xffff0000u); }
__device__ __forceinline__ float wave_sum(float v) {
#pragma unroll
    for (int o = 1; o < 64; o <<= 1) v += __shfl_xor(v, o);
    return v;
}
__device__ __forceinline__ float sigmoidf_(float x) { return 1.0f / (1.0f + __expf(-x)); }
#define LDS_WAIT() asm volatile("s_waitcnt lgkmcnt(0)" ::: "memory")
__device__ __forceinline__ float row_rinv(const float* slots, int row, int fq) {
    const f32x4 a = *(const f32x4*)(slots + (size_t)row * 16 + 4 * fq);
    float s = (a.x + a.y) + (a.z + a.w);
    s += __shfl_xor(s, 16); s += __shfl_xor(s, 32);
    return __builtin_amdgcn_rsqf(s * (1.0f / 1024.0f) + EPS);
}
__device__ __forceinline__ void fill_rinv_table(LAS unsigned char* lds, const float* slots, int pm) {
    const int t = fresh_tid();
    if (t < 256) { const f32x4* p = (const f32x4*)(slots + (size_t)(pm * 256 + t) * 16); const f32x4 a = p[0], b = p[1], c = p[2], d = p[3];
        const float s = (((a.x + a.y) + (a.z + a.w)) + ((b.x + b.y) + (b.z + b.w))) + (((c.x + c.y) + (c.z + c.w)) + ((d.x + d.y) + (d.z + d.w)));
        ((LAS float*)(lds + LDS_RINV))[t] = __builtin_amdgcn_rsqf(s * (1.0f / 1024.0f) + EPS); }
    __syncthreads();
}
__device__ __forceinline__ float lds_rinv_read(unsigned addr) { float r; asm volatile("ds_read_b32 %0, %1" : "=v"(r) : "v"(addr)); return r; }
__device__ __forceinline__ f32x4 lds_read4(unsigned addr) { f32x4 r; asm volatile("ds_read_b128 %0, %1" : "=v"(r) : "v"(addr)); return r; }
namespace pg8 {
constexpr int BM = 256, BK = 64, HALF = 128, HTB = HALF * BK * 2, STAGE_BYTES = 8 * HTB, NXCD = 8, WGM = 8;
__host__ __device__ __forceinline__ int lds_byte(int r, int c) { const int st = (r >> 4) * 2 + (c >> 5), rr = r & 15, cc = c & 31, ob = rr * 64 + cc * 2; return st * 1024 + (ob ^ (((ob >> 9) & 1) << 5)); }
__host__ __device__ __forceinline__ void stage_rc(int b, int& R, int& C) { const int st = b / 1024, sb = b % 1024, swz = sb ^ (((sb >> 9) & 1) << 5); R = (st >> 1) * 16 + swz / 64; C = (st & 1) * 32 + (swz % 64) / 2; }
__host__ __device__ __forceinline__ int perm32(int rho) { const int n = rho >> 4, i = rho & 15; return 8 * (i >> 2) + 4 * n + (i & 3); }

struct Unit { int pm, pn, nt, kind; const char* a; const char* b; };

__device__ __forceinline__ bool tile_of(int L, int nM, int nN, int& pm, int& pn) {
    const int nwg = nM * nN; if (L >= nwg) return false;
    int wgid = L; { const int q = nwg / NXCD, r = nwg % NXCD, xcd = wgid % NXCD, off = wgid / NXCD; wgid = (xcd < r ? xcd * (q + 1) : r * (q + 1) + (xcd - r) * q) + off; }
    const int nig = WGM * nN, gid = wgid / nig, fm = gid * WGM, gsz = (nM - fm) < WGM ? (nM - fm) : WGM;
    pm = fm + ((wgid % nig) % gsz); pn = (wgid % nig) / gsz; return true;
}
struct PlainOrder {
    const char* A; const char* Bt; int lda, ldb, nM, nN, nt, G, c;
    __device__ __forceinline__ bool next(int i, Unit& u) const {
        int pm, pn; if (!tile_of(i * G + c, nM, nN, pm, pn)) return false;
        u.pm = pm; u.pn = pn; u.nt = nt; u.kind = 0; u.a = A + (size_t)pm * 256 * lda * 2; u.b = Bt + (size_t)pn * 256 * ldb * 2; return true;
    }
};
struct GateBranchOrder {
    const char* XN; const char* BR; const char* WgT; const char* WbT; int G, c;
    __device__ __forceinline__ bool next(int i, Unit& u) const {
        const int gi = i >> 3, j = i & 7; int pm, pd; if (!tile_of(gi * G + c, 64, 4, pm, pd)) return false;
        const int n = j >> 1, kind = j & 1; u.pm = pm; u.pn = n * 4 + pd; u.kind = kind;
        if (kind == 0) { u.nt = 16; u.a = XN + (size_t)pm * 256 * 1024 * 2; u.b = WgT + (size_t)u.pn * 256 * 1024 * 2; }
        else { u.nt = 4; u.a = BR + ((size_t)pm * 256 * 1024 + n * 256) * 2; u.b = WbT + ((size_t)u.pn * 256 * 1024 + n * 256) * 2; }
        return true;
    }
};

template <int ACT  , int RS  , bool LATSS = false  > struct EpiBf16 {
    static constexpr bool PERM = true; struct State {};
    bf16_t* O; int ldc; const float* rowss; int pm_tab; unsigned tab; float* latss;
    __device__ __forceinline__ void operator()(const f32x4 (&acc)[2][2][4][2], State&, const Unit& u, int wr, int wc, int fr, int fq) const {
        asm volatile("" : "+v"(fr), "+v"(fq));
        const int row0 = u.pm * BM + wr * 64 + fr, col0 = u.pn * BM + wc * 32 + 8 * fq;
        float rv[2][4];
        if (RS == 1) {
            if (u.pm == pm_tab) {
#pragma unroll
                for (int ai = 0; ai < 2; ++ai)
#pragma unroll
                    for (int m = 0; m < 4; ++m) rv[ai][m] = lds_rinv_read(tab + (unsigned)(wr * 64 + fr + ai * HALF + m * 16) * 4u);
                asm volatile("s_waitcnt lgkmcnt(0)" : "+v"(rv[0][0]), "+v"(rv[0][1]), "+v"(rv[0][2]), "+v"(rv[0][3]), "+v"(rv[1][0]), "+v"(rv[1][1]), "+v"(rv[1][2]), "+v"(rv[1][3]));
            } else {
#pragma unroll
                for (int ai = 0; ai < 2; ++ai)
#pragma unroll
                    for (int m = 0; m < 4; ++m) rv[ai][m] = row_rinv(rowss, row0 + ai * HALF + m * 16, fq);
            }
        }
#pragma unroll
        for (int ai = 0; ai < 2; ++ai)
#pragma unroll
            for (int m = 0; m < 4; ++m) { bf16_t* rowp = O + (size_t)(row0 + ai * HALF + m * 16) * ldc + col0;
                float rinv = 1.f; if (RS == 1) rinv = rv[ai][m];
                if (RS == 2) { const f32x4 a = *(const f32x4*)(latss + (size_t)(row0 + ai * HALF + m * 16) * 8 + (u.pn >= 2 ? 4 : 0));
                    rinv = __builtin_amdgcn_rsqf(((a.x + a.y) + (a.z + a.w)) * (u.pn >= 2 ? (1.0f / 128.0f) : (1.0f / 256.0f)) + EPS); }
                float lss = 0.f;
#pragma unroll
                for (int bj = 0; bj < 2; ++bj) { f32x4 v0 = acc[ai][bj][m][0], v1 = acc[ai][bj][m][1];
                    if (RS) { v0 = v0 * rinv; v1 = v1 * rinv; }
                    if (LATSS) { if (bj == 0 || u.pn == 3) lss += ((v0.x * v0.x + v0.y * v0.y) + (v0.z * v0.z + v0.w * v0.w)) + ((v1.x * v1.x + v1.y * v1.y) + (v1.z * v1.z + v1.w * v1.w)); }
                    if (ACT == 2) {
#pragma unroll
                        for (int e = 0; e < 4; ++e) { const float a0 = fmaxf(v0[e], 0.f), a1 = fmaxf(v1[e], 0.f); v0[e] = a0 * a0; v1[e] = a1 * a1; } }
                    u32x4 w; w.x = pk2(v0[0], v0[1]); w.y = pk2(v0[2], v0[3]); w.z = pk2(v1[0], v1[1]); w.w = pk2(v1[2], v1[3]);
                    *(u32x4*)(rowp + bj * HALF) = w; }
                if (LATSS) { if (u.pn == 3 || u.pn == 4) { lss += __shfl_xor(lss, 16); lss += __shfl_xor(lss, 32);
                    if (fq == 0) latss[(size_t)(row0 + ai * HALF + m * 16) * 8 + (u.pn == 4 ? 4 : 0) + wc] = lss; } } }
    }
};
template <bool BASEF32> struct EpiRes {
    static constexpr bool PERM = true; struct State {};
    const void* base; bf16_t* out; float* rowss;
    __device__ __forceinline__ void operator()(const f32x4 (&acc)[2][2][4][2], State&, const Unit& u, int wr, int wc, int fr, int fq) const {
        asm volatile("" : "+v"(fr), "+v"(fq));
        const int row0 = u.pm * BM + wr * 64 + fr, col0 = u.pn * BM + wc * 32 + 8 * fq;
#pragma unroll
        for (int ai = 0; ai < 2; ++ai) {
            f32x4 bs[4][2][2];
#pragma unroll
            for (int m = 0; m < 4; ++m) { const size_t off = (size_t)(row0 + ai * HALF + m * 16) * 1024 + col0;
#pragma unroll
                for (int bj = 0; bj < 2; ++bj) {
                    if (BASEF32) { bs[m][bj][0] = *(const f32x4*)((const float*)base + off + bj * HALF); bs[m][bj][1] = *(const f32x4*)((const float*)base + off + bj * HALF + 4); }
                    else { const u32x4 w = *(const u32x4*)((const bf16_t*)base + off + bj * HALF);
                        bs[m][bj][0] = (f32x4){lo_f(w.x), hi_f(w.x), lo_f(w.y), hi_f(w.y)}; bs[m][bj][1] = (f32x4){lo_f(w.z), hi_f(w.z), lo_f(w.w), hi_f(w.w)}; } } }
            asm volatile("" ::: "memory");
#pragma unroll
            for (int m = 0; m < 4; ++m) { const int row = row0 + ai * HALF + m * 16; const size_t off = (size_t)row * 1024 + col0; float ss = 0.f;
#pragma unroll
                for (int bj = 0; bj < 2; ++bj) { const f32x4 v0 = bs[m][bj][0] + acc[ai][bj][m][0], v1 = bs[m][bj][1] + acc[ai][bj][m][1];
                    u32x4 w; w.x = pk2(v0[0], v0[1]); w.y = pk2(v0[2], v0[3]); w.z = pk2(v1[0], v1[1]); w.w = pk2(v1[2], v1[3]); *(u32x4*)(out + off + bj * HALF) = w;
                    ss += ((v0.x * v0.x + v0.y * v0.y) + (v0.z * v0.z + v0.w * v0.w)) + ((v1.x * v1.x + v1.y * v1.y) + (v1.z * v1.z + v1.w * v1.w)); }
                ss += __shfl_xor(ss, 16); ss += __shfl_xor(ss, 32); if (fq == 0) rowss[(size_t)row * 16 + u.pn * 4 + wc] = ss; }
            asm volatile("" ::: "memory");
        }
    }
};
struct EpiFinal {
    static constexpr bool PERM = true; struct State {};
    const bf16_t* base; float* out; float* rowss; const float* g; unsigned* cnt;
    __device__ __forceinline__ void operator()(const f32x4 (&acc_)[2][2][4][2], State&, const Unit& u, int wr, int wc, int fr, int fq) const {
        asm volatile("" : "+v"(fr), "+v"(fq));
        f32x4 (&acc)[2][2][4][2] = const_cast<f32x4 (&)[2][2][4][2]>(acc_);
        const int row0 = u.pm * BM + wr * 64 + fr, col0 = u.pn * BM + wc * 32 + 8 * fq;
#pragma unroll
        for (int ai = 0; ai < 2; ++ai) {
            u32x4 bs[4][2];
#pragma unroll
            for (int m = 0; m < 4; ++m) { const size_t off = (size_t)(row0 + ai * HALF + m * 16) * 1024 + col0;
#pragma unroll
                for (int bj = 0; bj < 2; ++bj) bs[m][bj] = *(const u32x4*)(base + off + bj * HALF); }
            asm volatile("" ::: "memory");
#pragma unroll
            for (int m = 0; m < 4; ++m) { const int row = row0 + ai * HALF + m * 16; float ss = 0.f;
#pragma unroll
                for (int bj = 0; bj < 2; ++bj) { const u32x4 w = bs[m][bj];
                    const f32x4 v0 = acc[ai][bj][m][0] + (f32x4){lo_f(w.x), hi_f(w.x), lo_f(w.y), hi_f(w.y)}, v1 = acc[ai][bj][m][1] + (f32x4){lo_f(w.z), hi_f(w.z), lo_f(w.w), hi_f(w.w)};
                    acc[ai][bj][m][0] = v0; acc[ai][bj][m][1] = v1;
                    ss += ((v0.x * v0.x + v0.y * v0.y) + (v0.z * v0.z + v0.w * v0.w)) + ((v1.x * v1.x + v1.y * v1.y) + (v1.z * v1.z + v1.w * v1.w)); }
                ss += __shfl_xor(ss, 16); ss += __shfl_xor(ss, 32); if (fq == 0) rowss[(size_t)row * 16 + u.pn * 4 + wc] = ss; }
        }
        asm volatile("s_waitcnt vmcnt(0)" ::: "memory"); __builtin_amdgcn_s_barrier(); asm volatile("" ::: "memory");
        if (threadIdx.x == 0) {
            __builtin_amdgcn_fence(__ATOMIC_RELEASE, "agent"); asm volatile("s_waitcnt vmcnt(0)" ::: "memory");
            unsigned* c = cnt + 64 * u.pm;
            (void)__hip_atomic_fetch_add(c, 1u, __ATOMIC_RELAXED, __HIP_MEMORY_SCOPE_AGENT);
            unsigned sp = 0;
            while (__hip_atomic_load(c, __ATOMIC_RELAXED, __HIP_MEMORY_SCOPE_AGENT) < 4u) { __builtin_amdgcn_s_sleep(1); if (++sp > (1u << 16)) break; }
            __builtin_amdgcn_fence(__ATOMIC_ACQUIRE, "agent"); asm volatile("s_waitcnt vmcnt(0)" ::: "memory");
        }
        asm volatile("" ::: "memory"); __builtin_amdgcn_s_barrier(); asm volatile("" ::: "memory");
        f32x4 gv[2][2];
#pragma unroll
        for (int bj = 0; bj < 2; ++bj)
#pragma unroll
            for (int q = 0; q < 2; ++q) gv[bj][q] = *(const f32x4*)(g + col0 + bj * HALF + 4 * q);
#pragma unroll
        for (int ai = 0; ai < 2; ++ai)
#pragma unroll
            for (int m = 0; m < 4; ++m) { const int row = row0 + ai * HALF + m * 16; const float rinv = row_rinv(rowss, row, fq); float* op = out + (size_t)row * 1024 + col0;
#pragma unroll
                for (int bj = 0; bj < 2; ++bj) { *(f32x4*)(op + bj * HALF) = acc[ai][bj][m][0] * rinv * gv[bj][0]; *(f32x4*)(op + bj * HALF + 4) = acc[ai][bj][m][1] * rinv * gv[bj][1]; } }
    }
};
struct EpiGateBranch {
    static constexpr bool PERM = true;
    struct State { unsigned g8[2][2][4][2]; };
    bf16_t* mixed; const float* bgate; const float* rowss; LAS unsigned* glds; int pm_tab, pd_tab; unsigned tab, btab;
    __device__ __forceinline__ void operator()(const f32x4 (&acc)[2][2][4][2], State& st, const Unit& u, int wr, int wc, int fr, int fq) const {
        asm volatile("" : "+v"(fr), "+v"(fq));
        const int rl0 = wr * 64 + fr, cl0 = wc * 32 + 8 * fq, n = u.pn >> 2, pd = u.pn & 3;
        LAS unsigned* gl = glds + (wr * 4 + wc) * 512 + (fq * 16 + fr) * 8;
        if (u.kind == 0) {
            f32x4 bv[2][2]; float rv[2][4];
            if (u.pm == pm_tab && pd == pd_tab) {
#pragma unroll
                for (int bj = 0; bj < 2; ++bj)
#pragma unroll
                    for (int q = 0; q < 2; ++q) bv[bj][q] = lds_read4(btab + (unsigned)(n * 256 + cl0 + bj * HALF + 4 * q) * 4u);
#pragma unroll
                for (int ai = 0; ai < 2; ++ai)
#pragma unroll
                    for (int m = 0; m < 4; ++m) rv[ai][m] = lds_rinv_read(tab + (unsigned)(rl0 + ai * HALF + m * 16) * 4u);
                asm volatile("s_waitcnt lgkmcnt(0)" : "+v"(bv[0][0]), "+v"(bv[0][1]), "+v"(bv[1][0]), "+v"(bv[1][1]), "+v"(rv[0][0]), "+v"(rv[0][1]), "+v"(rv[0][2]), "+v"(rv[0][3]), "+v"(rv[1][0]), "+v"(rv[1][1]), "+v"(rv[1][2]), "+v"(rv[1][3]));
            } else {
#pragma unroll
                for (int bj = 0; bj < 2; ++bj)
#pragma unroll
                    for (int q = 0; q < 2; ++q) bv[bj][q] = *(const f32x4*)(bgate + u.pn * BM + cl0 + bj * HALF + 4 * q);
#pragma unroll
                for (int ai = 0; ai < 2; ++ai)
#pragma unroll
                    for (int m = 0; m < 4; ++m) rv[ai][m] = row_rinv(rowss, u.pm * BM + rl0 + ai * HALF + m * 16, fq);
            }
#pragma unroll
            for (int ai = 0; ai < 2; ++ai)
#pragma unroll
                for (int m = 0; m < 4; ++m) {
                    const float rinv = rv[ai][m];
#pragma unroll
                    for (int bj = 0; bj < 2; ++bj)
#pragma unroll
                        for (int q = 0; q < 2; ++q) { const f32x4 v = acc[ai][bj][m][q] * rinv + bv[bj][q]; unsigned w = 0u;
#pragma unroll
                            for (int e = 0; e < 4; ++e) w |= (unsigned)(sigmoidf_(v[e]) * 255.0f + 0.5f) << (8 * e);
                            if (ai == 1 && bj == 1) gl[m * 2 + q] = w; else st.g8[ai][bj][m][q] = w; } }
        } else {
#pragma unroll
            for (int ai = 0; ai < 2; ++ai) {
                u32x4 oo[4][2];
#pragma unroll
                for (int m = 0; m < 4; ++m) { const int rl = rl0 + ai * HALF + m * 16; const bf16_t* mp = mixed + (size_t)(u.pm * BM + rl) * 1024 + pd * 256 + cl0;
#pragma unroll
                    for (int bj = 0; bj < 2; ++bj) { oo[m][bj] = (u32x4){0u, 0u, 0u, 0u}; if (n > 0) oo[m][bj] = *(const u32x4*)(mp + bj * HALF); } }
                asm volatile("" ::: "memory");
#pragma unroll
                for (int m = 0; m < 4; ++m) { const int rl = rl0 + ai * HALF + m * 16; bf16_t* mp = mixed + (size_t)(u.pm * BM + rl) * 1024 + pd * 256 + cl0;
#pragma unroll
                    for (int bj = 0; bj < 2; ++bj) { const unsigned g0 = (ai == 1 && bj == 1) ? gl[m * 2] : st.g8[ai][bj][m][0], g1 = (ai == 1 && bj == 1) ? gl[m * 2 + 1] : st.g8[ai][bj][m][1]; const u32x4 o = oo[m][bj]; const f32x4 a0 = acc[ai][bj][m][0] * (1.0f / 255.0f), a1 = acc[ai][bj][m][1] * (1.0f / 255.0f);
                        float v[8];
                        v[0] = fmaf(a0[0], (float)(g0 & 255u), lo_f(o.x)); v[1] = fmaf(a0[1], (float)((g0 >> 8) & 255u), hi_f(o.x)); v[2] = fmaf(a0[2], (float)((g0 >> 16) & 255u), lo_f(o.y)); v[3] = fmaf(a0[3], (float)(g0 >> 24), hi_f(o.y));
                        v[4] = fmaf(a1[0], (float)(g1 & 255u), lo_f(o.z)); v[5] = fmaf(a1[1], (float)((g1 >> 8) & 255u), hi_f(o.z)); v[6] = fmaf(a1[2], (float)((g1 >> 16) & 255u), lo_f(o.w)); v[7] = fmaf(a1[3], (float)(g1 >> 24), hi_f(o.w));
                        u32x4 w; w.x = pk2(v[0], v[1]); w.y = pk2(v[2], v[3]); w.z = pk2(v[4], v[5]); w.w = pk2(v[6], v[7]);
                        *(u32x4*)(mp + bj * HALF) = w; } }
                asm volatile("" ::: "memory");
            }
        }
    }
};

template <class Epi, class Sched>
__device__ __forceinline__ void gemm_phase(LAS unsigned char* lds, const int lda, const int ldb, const Sched& S, const Epi& E) {
    const int tid = fresh_tid(), wid = __builtin_amdgcn_readfirstlane(tid >> 6), lane = tid & 63, wr = wid >> 2, wc = wid & 3, fr = lane & 15, fq = lane >> 4;
    unsigned voffA[2], voffB[2];
#pragma unroll
    for (int i = 0; i < 2; ++i) { int R, C; stage_rc(tid * 16 + i * 8192, R, C); const int Rb = Epi::PERM ? ((R & ~31) + perm32(R & 31)) : R;
        voffA[i] = (unsigned)(R * lda + C) * 2u; voffB[i] = (unsigned)(Rb * ldb + C) * 2u; }
    const size_t kstep = (size_t)(BK * 2);
    const size_t hstepA = (size_t)HALF * lda * 2, hstepB = (size_t)HALF * ldb * 2;
    const unsigned ldsw = (unsigned)wid * 1024u;
    const int aoff = lds_byte(wr * 64 + fr, fq * 8), boff = lds_byte(wc * 32 + fr, fq * 8);
#define PG8_SA(b, h) (((b) * 2 + (h)) * HTB)
#define PG8_SB(b, h) ((4 + (b) * 2 + (h)) * HTB)
#define PG8_STAGE(bufoff, gbase, voff) do { _Pragma("unroll") for (int _i = 0; _i < 2; ++_i) \
        __builtin_amdgcn_global_load_lds((const unsigned*)((const char*)(gbase) + (voff)[_i]), (LAS unsigned*)(lds + (bufoff) + ldsw + _i * 8192), 16, 0, 0); } while (0)
#define PG8_LDA(dst, b, h) do { _Pragma("unroll") for (int m = 0; m < 4; ++m) _Pragma("unroll") for (int k = 0; k < 2; ++k) dst[m][k] = *(const LAS bf16x8*)(lds + PG8_SA(b, h) + aoff + m * 2048 + k * 1024); } while (0)
#define PG8_LDB(dst, b, h) do { _Pragma("unroll") for (int n = 0; n < 2; ++n) _Pragma("unroll") for (int k = 0; k < 2; ++k) dst[n][k] = *(const LAS bf16x8*)(lds + PG8_SB(b, h) + boff + n * 2048 + k * 1024); } while (0)
#define PG8_MMA(ai, bj, At, Bt) do { __builtin_amdgcn_s_setprio(1); _Pragma("unroll") for (int m = 0; m < 4; ++m) _Pragma("unroll") for (int n = 0; n < 2; ++n) _Pragma("unroll") for (int k = 0; k < 2; ++k) \
        acc[ai][bj][m][n] = __builtin_amdgcn_mfma_f32_16x16x32_bf16(Bt[n][k], At[m][k], acc[ai][bj][m][n], 0, 0, 0); __builtin_amdgcn_s_setprio(0); } while (0)
#define PG8_WAIT_V(n) asm volatile("s_waitcnt vmcnt(" #n ")" ::: "memory")
#define PG8_WAIT_L(n) asm volatile("s_waitcnt lgkmcnt(" #n ")" ::: "memory")
#define PG8_BAR __builtin_amdgcn_s_barrier()
#define PG8_SCHED __builtin_amdgcn_sched_barrier(0)
    Unit cur, nxt; int ui = 0;
    if (!S.next(0, cur)) return;
    f32x4 acc[2][2][4][2];
#pragma unroll
    for (int a = 0; a < 2; ++a)
#pragma unroll
        for (int b = 0; b < 2; ++b)
#pragma unroll
            for (int m = 0; m < 4; ++m)
#pragma unroll
                for (int n = 0; n < 2; ++n) acc[a][b][m][n] = (f32x4){0.f, 0.f, 0.f, 0.f};
    bf16x8 At[4][2], B0[2][2], B1[2][2];
    typename Epi::State est;
    const char* cA = cur.a; const char* cB = cur.b;
    PG8_STAGE(PG8_SB(0, 0), cB, voffB); PG8_STAGE(PG8_SB(0, 1), cB + hstepB, voffB); PG8_STAGE(PG8_SA(0, 0), cA, voffA); PG8_STAGE(PG8_SA(0, 1), cA + hstepA, voffA);
    if (wr == 1) PG8_BAR;
    PG8_WAIT_V(2); PG8_BAR;
    PG8_STAGE(PG8_SB(1, 0), cB + kstep, voffB); PG8_STAGE(PG8_SA(1, 0), cA + kstep, voffA); PG8_STAGE(PG8_SB(1, 1), cB + hstepB + kstep, voffB);
    PG8_WAIT_V(6); PG8_BAR;
    for (;;) {
        const bool has_next = S.next(ui + 1, nxt);
        const char* nA = has_next ? nxt.a : cA; const char* nB = has_next ? nxt.b : cB;
        const int nt = cur.nt;
        for (int t = 0; t < nt; t += 2) {
            const bool last = (t == nt - 2);
            const char* a1 = cA + (size_t)(t + 1) * kstep;
            const char* a2 = last ? nA : cA + (size_t)(t + 2) * kstep; const char* b2 = last ? nB : cB + (size_t)(t + 2) * kstep;
            const char* a3 = a2 + kstep; const char* b3 = b2 + kstep;
            PG8_LDB(B0, 0, 0); PG8_LDB(B1, 0, 1); PG8_SCHED; PG8_LDA(At, 0, 0); PG8_STAGE(PG8_SA(1, 1), a1 + hstepA, voffA);
            PG8_WAIT_V(8); PG8_WAIT_L(0); PG8_BAR; PG8_MMA(0, 0, At, B0); PG8_MMA(0, 1, At, B1); PG8_BAR; PG8_SCHED;
            PG8_LDA(At, 0, 1); PG8_STAGE(PG8_SB(0, 0), b2, voffB); PG8_STAGE(PG8_SB(0, 1), b2 + hstepB, voffB); PG8_STAGE(PG8_SA(0, 0), a2, voffA);
            PG8_WAIT_V(8); PG8_WAIT_L(0); PG8_BAR; PG8_MMA(1, 0, At, B0); PG8_MMA(1, 1, At, B1); PG8_BAR; PG8_SCHED;
            PG8_LDB(B0, 1, 0); PG8_LDB(B1, 1, 1); PG8_SCHED; PG8_LDA(At, 1, 0); PG8_STAGE(PG8_SA(0, 1), a2 + hstepA, voffA);
            PG8_WAIT_V(8); PG8_WAIT_L(0); PG8_BAR; PG8_MMA(0, 0, At, B0); PG8_MMA(0, 1, At, B1); PG8_BAR; PG8_SCHED;
            PG8_LDA(At, 1, 1); PG8_STAGE(PG8_SB(1, 0), b3, voffB); PG8_STAGE(PG8_SB(1, 1), b3 + hstepB, voffB); PG8_STAGE(PG8_SA(1, 0), a3, voffA);
            PG8_WAIT_V(8); PG8_WAIT_L(0); PG8_BAR; PG8_MMA(1, 0, At, B0); PG8_MMA(1, 1, At, B1); PG8_BAR; PG8_SCHED;
        }
        if (wr == 0) PG8_BAR;
        E(acc, est, cur, wr, wc, fr, fq);
        if (!has_next) break;
#pragma unroll
        for (int a = 0; a < 2; ++a)
#pragma unroll
            for (int b = 0; b < 2; ++b)
#pragma unroll
                for (int m = 0; m < 4; ++m)
#pragma unroll
                    for (int n = 0; n < 2; ++n) acc[a][b][m][n] = (f32x4){0.f, 0.f, 0.f, 0.f};
        cur = nxt; cA = nA; cB = nB; ++ui;
        if (wr == 1) PG8_BAR;
    }
    PG8_WAIT_V(0);
    PG8_BAR;
#undef PG8_SA
#undef PG8_SB
#undef PG8_STAGE
#undef PG8_LDA
#undef PG8_LDB
#undef PG8_MMA
#undef PG8_WAIT_V
#undef PG8_WAIT_L
#undef PG8_BAR
#undef PG8_SCHED
}
}

namespace att {
constexpr int VP = 144;
typedef short v4i16_t __attribute__((ext_vector_type(4)));
__device__ __forceinline__ int crow(int i, int h) { return (i & 3) + 8 * (i >> 2) + 4 * h; }
__device__ __forceinline__ s16x4 vtr(const LAS unsigned char* p) { return __builtin_bit_cast(s16x4, __builtin_amdgcn_ds_read_tr16_b64_v4i16((LAS v4i16_t*)p)); }
#define MFMA32(a, b, c) __builtin_amdgcn_mfma_f32_32x32x16_bf16((a), (b), (c), 0, 0, 0)

template <int MODE>
__device__ __forceinline__ void unit(int layer, int b, int h, int qb, LAS unsigned char* lds) {
    const cargs_t ap = get_args();
    unsigned char* const ws_ = ap->ws;
    constexpr int DK = MODE == 1 ? 96 : 64, ND = DK / 16, KP = DK * 2 + 16, KBUF = 64 * KP, VBUF = 64 * VP;
    LAS unsigned char* Ks = lds; LAS unsigned char* Vs = lds + 2 * KBUF;
    LAS float* Fs = (LAS float*)(lds + 2 * KBUF + 2 * VBUF); LAS float* Tab = Fs + 128;
    const int tid = fresh_tid(), lane = tid & 63, wid = __builtin_amdgcn_readfirstlane(tid >> 6), r = lane & 31, hh = lane >> 5;
    const size_t tok0 = (size_t)b * SEQ;
    const int qw = qb * 256 + wid * 32, qc = qw >> 6;
    const bf16_t* PROJ = (const bf16_t*)(ws_ + WS_PROJ); const bf16_t* QKVB = (const bf16_t*)(ws_ + WS_QKVB); const bf16_t* KROT = (const bf16_t*)(ws_ + WS_KROT);
    const float* FCUM = (const float*)(ws_ + WS_FCUM) + (size_t)(b * 4 + h) * SEQ;
    bf16_t* BR = (bf16_t*)(ws_ + WS_BR);
    const bf16_t *Qp, *Kp, *Vp; int ldq, ldk;
    if (MODE == 0) { Qp = PROJ + C_AQ + h * 64; Kp = PROJ + C_AK + h * 64; Vp = PROJ + C_AV + h * 64; ldq = PLD; ldk = PLD; }
    else if (MODE == 2) { Qp = PROJ + C_CQ + h * 64; Kp = PROJ + C_CK + h * 64; Vp = PROJ + C_CV + h * 64; ldq = PLD; ldk = PLD; }
    else { Qp = QKVB + h * 96; Kp = QKVB + 512 + h * 128; Vp = Kp + 64; ldq = 1024; ldk = 1024; }
    const int t_lo = (MODE == 0) ? (qb * 4 - 8 > 0 ? qb * 4 - 8 : 0) : 0, t_hi = qb * 4 + 4;
    const float cs = (MODE == 1 ? 0.10206207261596577f : 0.125f) * LOG2E;

    u32x4 kregA, vregA, kr2A, kregB, vregB, kr2B; float fregA = 0.f, fregB = 0.f;
    const int srow = tid >> 3, sch = tid & 7;
#define ATT_LOAD(j, X) do { const int jl_ = (j) < t_lo ? t_lo : (j); const size_t trow = tok0 + (size_t)jl_ * 64; \
        kreg##X = *(const u32x4*)(Kp + (trow + srow) * ldk + sch * 8); vreg##X = *(const u32x4*)(Vp + (trow + srow) * ldk + sch * 8); \
        if (MODE == 1) { kr2##X = *(const u32x4*)(KROT + (trow + ((tid >> 2) & 63)) * 32 + (tid & 3) * 8); } \
        if (MODE == 2) { freg##X = FCUM[jl_ * 64 + (tid & 63)]; } } while (0)
#define ATT_STORE(s, X) do { *(LAS u32x4*)(Ks + (s) * KBUF + srow * KP + sch * 16) = kreg##X; *(LAS u32x4*)(Vs + (s) * VBUF + srow * VP + sch * 16) = vreg##X; \
        if (MODE == 1) { if (tid < 256) *(LAS u32x4*)(Ks + (s) * KBUF + (tid >> 2) * KP + 128 + (tid & 3) * 16) = kr2##X; } \
        if (MODE == 2) { if (tid < 64) Fs[(s) * 64 + tid] = freg##X * LOG2E; } } while (0)

    ATT_LOAD(t_hi - 1, A);
    ATT_LOAD(t_hi - 2, B);
    if (MODE == 0) { if (tid < 257) Tab[tid] = ap->rel_bias[(size_t)(layer * 4 + h) * 257 + tid] * LOG2E; }
    bf16x8 qf[ND];
    { const bf16_t* qrow = Qp + (tok0 + qw + r) * ldq;
#pragma unroll
      for (int d0 = 0; d0 < ND; ++d0) qf[d0] = *(const bf16x8*)(qrow + d0 * 16 + hh * 8); }
    if (MODE == 1) {
        const float pos = (float)ap->pos[tok0 + qw + r];
#pragma unroll
        for (int j = 0; j < 8; ++j) {
            const float invf = exp2f(-(float)(8 * hh + j) * 0.8304820237218406f);
            const float ang = pos * invf, kk = rintf(ang * 0.15915494309189535f);
            float rem = fmaf(-kk, 6.2831854820251465f, ang); rem = fmaf(kk, 1.7484555e-7f, rem);
            const float sn = __sinf(rem), cn = __cosf(rem);
            const float x1 = bf2f((unsigned short)qf[4][j]), x2 = bf2f((unsigned short)qf[5][j]);
            const unsigned w = pk2(x1 * cn - x2 * sn, x2 * cn + x1 * sn);
            qf[4][j] = (short)(w & 0xffffu); qf[5][j] = (short)(w >> 16);
        }
    }
    float fq = 0.f;
    if (MODE == 2) fq = FCUM[qw + r] * LOG2E;
    float m_run = -INFINITY, l_run = 0.f;
    float ub = 0.f; LAS int* wv = (LAS int*)(lds + 131072 + 768);
    if (MODE == 2) {
        float q2 = 0.f;
#pragma unroll
        for (int d0 = 0; d0 < 4; ++d0)
#pragma unroll
            for (int e = 0; e < 8; ++e) { const float x = bf2f((unsigned short)qf[d0][e]); q2 = fmaf(x, x, q2); }
        { auto rr = __builtin_amdgcn_permlane32_swap(__float_as_uint(q2), __float_as_uint(q2), false, false); q2 = __uint_as_float(rr[0]) + __uint_as_float(rr[1]); }
        const unsigned kbits = ((const unsigned*)(ws_ + WS_CTL))[1024 + b * 4 + h];
        ub = sqrtf(q2) * sqrtf(__uint_as_float(kbits)) * cs * 1.0001f + 0.01f;
    }
    f32x16 o0, o1;
#pragma unroll
    for (int i = 0; i < 16; ++i) { o0[i] = 0.f; o1[i] = 0.f; }
    ATT_STORE(0, A);
    __syncthreads();
    const int i16 = lane & 15, vq = i16 >> 2, vp = i16 & 3, vblk = (lane >> 4) & 1;
    const int voff = (4 * hh + vq) * VP + vblk * 32 + vp * 8;

    auto compute = [&](const int j, const int s) __attribute__((always_inline)) {
        const bool active = (MODE == 0) ? (j <= qc && j >= qc - 8) : (j <= qc);
        if (active) {
            const LAS unsigned char* kb = Ks + s * KBUF + r * KP + hh * 16;
            f32x16 p0, p1;
#pragma unroll
            for (int i = 0; i < 16; ++i) { p0[i] = 0.f; p1[i] = 0.f; }
#pragma unroll
            for (int d0 = 0; d0 < ND; ++d0) {
                const bf16x8 kf0 = *(const LAS bf16x8*)(kb + d0 * 32), kf1 = *(const LAS bf16x8*)(kb + 32 * KP + d0 * 32);
                p0 = MFMA32(kf0, qf[d0], p0); p1 = MFMA32(kf1, qf[d0], p1);
            }
            if (MODE == 0) {
                const int delta = qc - j;
                if (delta >= 3) { const float cb = Tab[256];
#pragma unroll
                    for (int i = 0; i < 16; ++i) { p0[i] = fmaf(p0[i], cs, cb); p1[i] = fmaf(p1[i], cs, cb); }
                } else { const int brel = 64 * delta + (qw & 63) + r + 128;
#pragma unroll
                    for (int i = 0; i < 16; ++i) { const int kj = crow(i, hh); int i0 = brel - kj, i1 = brel - kj - 32;
                        i0 = i0 < 0 ? 0 : (i0 > 256 ? 256 : i0); i1 = i1 < 0 ? 0 : (i1 > 256 ? 256 : i1);
                        p0[i] = fmaf(p0[i], cs, Tab[i0]); p1[i] = fmaf(p1[i], cs, Tab[i1]); }
                }
            } else if (MODE == 1) {
#pragma unroll
                for (int i = 0; i < 16; ++i) { p0[i] *= cs; p1[i] *= cs; }
            } else {
                const LAS float* fs = Fs + s * 64 + 4 * hh;
#pragma unroll
                for (int g = 0; g < 4; ++g) { const f32x4 f0 = *(const LAS f32x4*)(fs + 8 * g), f1 = *(const LAS f32x4*)(fs + 32 + 8 * g);
#pragma unroll
                    for (int e = 0; e < 4; ++e) { p0[4 * g + e] = fmaf(p0[4 * g + e], cs, fq - f0[e]); p1[4 * g + e] = fmaf(p1[4 * g + e], cs, fq - f1[e]); } }
                if (j == qc) { const int qrel = (qw & 63) + r;
#pragma unroll
                    for (int i = 0; i < 16; ++i) { const int kj = crow(i, hh); if (kj > qrel) p0[i] = -INFINITY; if (kj + 32 > qrel) p1[i] = -INFINITY; } }
            }
            float mx = p0[0];
#pragma unroll
            for (int i = 1; i < 16; ++i) mx = fmaxf(mx, p0[i]);
#pragma unroll
            for (int i = 0; i < 16; ++i) mx = fmaxf(mx, p1[i]);
            { auto rr = __builtin_amdgcn_permlane32_swap(__float_as_uint(mx), __float_as_uint(mx), false, false); mx = fmaxf(__uint_as_float(rr[0]), __uint_as_float(rr[1])); }
            if (__all(mx < m_run - 40.f)) return;
            if (__any(mx > m_run)) {
                const float m_new = fmaxf(m_run, mx);
                const float alpha = __builtin_amdgcn_exp2f(m_run - m_new);
                m_run = m_new; l_run *= alpha;
#pragma unroll
                for (int i = 0; i < 16; ++i) { o0[i] *= alpha; o1[i] *= alpha; }
            }
            float sum = 0.f;
#pragma unroll
            for (int i = 0; i < 16; ++i) { p0[i] = __builtin_amdgcn_exp2f(p0[i] - m_run); p1[i] = __builtin_amdgcn_exp2f(p1[i] - m_run); sum += p0[i] + p1[i]; }
            l_run += sum;
            const LAS unsigned char* vb = Vs + s * VBUF + voff;
#pragma unroll
            for (int kbk = 0; kbk < 2; ++kbk)
#pragma unroll
                for (int st = 0; st < 2; ++st) {
                    const f32x16& pp = kbk ? p1 : p0;
                    u32x4 pw; pw.x = pk2(pp[8 * st + 0], pp[8 * st + 1]); pw.y = pk2(pp[8 * st + 2], pp[8 * st + 3]); pw.z = pk2(pp[8 * st + 4], pp[8 * st + 5]); pw.w = pk2(pp[8 * st + 6], pp[8 * st + 7]);
                    const bf16x8 pf = __builtin_bit_cast(bf16x8, pw);
                    const LAS unsigned char* vr = vb + (32 * kbk + 16 * st) * VP;
                    const s16x4 a_lo = vtr(vr), a_hi = vtr(vr + 8 * VP), b_lo = vtr(vr + 64), b_hi = vtr(vr + 8 * VP + 64);
                    const bf16x8 v0 = __builtin_shufflevector(a_lo, a_hi, 0, 1, 2, 3, 4, 5, 6, 7), v1 = __builtin_shufflevector(b_lo, b_hi, 0, 1, 2, 3, 4, 5, 6, 7);
                    o0 = MFMA32(v0, pf, o0); o1 = MFMA32(v1, pf, o1);
                }
        }
    };
    for (int j = t_hi - 1; j >= t_lo; j -= 2) {
        ATT_LOAD(j - 2, A);
        compute(j, 0);
        if (MODE == 2) { const int vote = (j <= qc) ? (int)__all(ub + fq - Fs[0] < m_run - 40.f) : 0; if (lane == 0) wv[wid] = vote; }
        ATT_STORE(1, B);
        __syncthreads();
        if (MODE == 2) { int all = 1;
#pragma unroll
            for (int w = 0; w < 8; ++w) all &= wv[w];
            if (all) break; }
        ATT_LOAD(j - 3, B);
        compute(j - 1, 1);
        if (MODE == 2) { const int vote = (j - 1 <= qc) ? (int)__all(ub + fq - Fs[64] < m_run - 40.f) : 0; if (lane == 0) wv[8 + wid] = vote; }
        ATT_STORE(0, A);
        __syncthreads();
        if (MODE == 2) { int all = 1;
#pragma unroll
            for (int w = 0; w < 8; ++w) all &= wv[8 + w];
            if (all) break; }
    }
    const float l_tot = l_run + __shfl_xor(l_run, 32);
    const float inv = 1.0f / l_tot;
    bf16_t* dst = BR + (tok0 + qw + r) * 1024 + (MODE == 0 ? 0 : (MODE == 1 ? 256 : 512)) + h * 64 + 4 * hh;
#pragma unroll
    for (int g = 0; g < 4; ++g) {
        u32x2 w0, w1;
        w0.x = pk2(o0[4 * g] * inv, o0[4 * g + 1] * inv); w0.y = pk2(o0[4 * g + 2] * inv, o0[4 * g + 3] * inv);
        w1.x = pk2(o1[4 * g] * inv, o1[4 * g + 1] * inv); w1.y = pk2(o1[4 * g + 2] * inv, o1[4 * g + 3] * inv);
        *(u32x2*)(dst + 8 * g) = w0; *(u32x2*)(dst + 32 + 8 * g) = w1;
    }
#undef ATT_LOAD
#undef ATT_STORE
}
}

__device__ __forceinline__ void transpose_item(const float* W, int N, int nblk, bf16_t* WT, int ldt, LAS float* scr, int item, int lane, const float* gk = nullptr) {
    const int kb = item / nblk, nb = item % nblk, k0 = 64 * kb, n0 = 32 * nb;
    const int nn = n0 + (lane & 31); const bool ok = nn < N;
    float tmp[32];
#pragma unroll
    for (int i = 0; i < 32; ++i) { const int kk = 2 * i + (lane >> 5); tmp[i] = ok ? W[(size_t)(k0 + kk) * N + nn] : 0.f; }
#pragma unroll
    for (int i = 0; i < 32; ++i) { const int kk = 2 * i + (lane >> 5); scr[kk * 33 + (lane & 31)] = tmp[i]; }
    LDS_WAIT(); asm volatile("" ::: "memory");
    const int c = lane & 7;
    f32x4 ga = {1.f, 1.f, 1.f, 1.f}, gb = ga;
    if (gk) { ga = *(const f32x4*)(gk + k0 + 8 * c); gb = *(const f32x4*)(gk + k0 + 8 * c + 4); }
#pragma unroll
    for (int j = 0; j < 4; ++j) { const int n = (lane >> 3) + 8 * j; const LAS float* s = scr + (8 * c) * 33 + n;
        u32x4 o; o.x = pk2(s[0 * 33] * ga.x, s[1 * 33] * ga.y); o.y = pk2(s[2 * 33] * ga.z, s[3 * 33] * ga.w); o.z = pk2(s[4 * 33] * gb.x, s[5 * 33] * gb.y); o.w = pk2(s[6 * 33] * gb.z, s[7 * 33] * gb.w);
        *(u32x4*)(WT + (size_t)(n0 + n) * ldt + k0 + 8 * c) = o; }
    LDS_WAIT(); asm volatile("" ::: "memory");
}
__device__ __forceinline__ void prenorm_row(const float* xrow, bf16_t* orow, float* rowss, int lane) {
    const f32x4* xr = (const f32x4*)xrow + lane;
    f32x4 v[4]; float s = 0.f;
#pragma unroll
    for (int j = 0; j < 4; ++j) { v[j] = xr[64 * j]; s += (v[j].x * v[j].x + v[j].y * v[j].y) + (v[j].z * v[j].z + v[j].w * v[j].w); }
    s = wave_sum(s); if (lane < 16) rowss[lane] = (lane == 0) ? s : 0.f;
#pragma unroll
    for (int j = 0; j < 4; ++j) { u32x2 w; w.x = pk2(v[j].x, v[j].y); w.y = pk2(v[j].z, v[j].w); ((u32x2*)orow)[lane + 64 * j] = w; }
}
__device__ __forceinline__ float logsig(float z) { return fminf(z, 0.f) - __logf(1.0f + __expf(-fabsf(z))); }


constexpr int I_G = 16 * 128, I_B = 4 * 32, I_O = 16 * 32, I_U = 16 * 128, I_D = 64 * 32, N_LATE_ITEMS = I_G + 4 * I_B + I_O + I_U + I_D;
__device__ __forceinline__ void late_weight_item(int l, int r, LAS float* scr, int lane) {
    const cargs_t ap = get_args(); unsigned char* const ws = ap->ws;
    if (r < I_G) { transpose_item(ap->w_gate + (size_t)l * 1024 * 4096, 4096, 128, (bf16_t*)(ws + WS_WGT), 1024, scr, r, lane, ap->g_mix + l * 1024); return; } r -= I_G;
    if (r < 4 * I_B) { const int n = r / I_B; transpose_item(ap->w_branch + (size_t)l * 4 * 256 * 1024 + (size_t)n * 256 * 1024, 1024, 32, (bf16_t*)(ws + WS_WBT) + (size_t)n * 1024 * 1024 + n * 256, 1024, scr, r % I_B, lane); return; } r -= 4 * I_B;
    if (r < I_O) { transpose_item(ap->w_o + (size_t)l * 1024 * 1024, 1024, 32, (bf16_t*)(ws + WS_WOT), 1024, scr, r, lane); return; } r -= I_O;
    if (r < I_U) { transpose_item(ap->w_up + (size_t)l * 1024 * 4096, 4096, 128, (bf16_t*)(ws + WS_W1T), 1024, scr, r, lane, ap->g_ffn + l * 1024); return; } r -= I_U;
    transpose_item(ap->w_down + (size_t)l * 4096 * 1024, 1024, 32, (bf16_t*)(ws + WS_W2T), 4096, scr, r, lane);
}
__device__ __forceinline__ void conv_tokens(int l, int t0, int lane) {
    const cargs_t ap = get_args(); unsigned char* const ws = ap->ws;
    const bf16_t* U = (const bf16_t*)(ws + WS_U); bf16_t* BR = (bf16_t*)(ws + WS_BR);
    const float* wdw = ap->w_dw + (size_t)l * 31 * 256; const f32x4 bdw = *(const f32x4*)(ap->b_dw + l * 256 + 4 * lane);
    const f32x4 gln = *(const f32x4*)(ap->g_conv_ln + l * 256 + 4 * lane), bln = *(const f32x4*)(ap->b_conv_ln + l * 256 + 4 * lane);
    const int ts0 = t0 & (SEQ - 1);
    const float* wl = wdw + 4 * lane; asm volatile("" : "+v"(wl));
    u32x2 ur[38];
#pragma unroll
    for (int i = 0; i < 38; ++i) { const int tt = ts0 - 30 + i; ur[i] = (u32x2){0u, 0u}; if (tt >= 0) ur[i] = *(const u32x2*)(U + (size_t)(t0 - 30 + i) * 256 + 4 * lane); }
    f32x4 acc[8];
#pragma unroll
    for (int j = 0; j < 8; ++j) acc[j] = bdw;
#pragma unroll
    for (int k = 0; k < 31; ++k) { const f32x4 w = *(const f32x4*)(wl + k * 256);
#pragma unroll
        for (int j = 0; j < 8; ++j) { const u32x2 u = ur[j + k];
            acc[j].x = fmaf(lo_f(u.x), w.x, acc[j].x); acc[j].y = fmaf(hi_f(u.x), w.y, acc[j].y); acc[j].z = fmaf(lo_f(u.y), w.z, acc[j].z); acc[j].w = fmaf(hi_f(u.y), w.w, acc[j].w); } }
#pragma unroll
    for (int j = 0; j < 8; ++j) {
        const float mean = wave_sum((acc[j].x + acc[j].y) + (acc[j].z + acc[j].w)) * (1.0f / 256.0f);
        const f32x4 d = acc[j] - mean;
        const float rstd = 1.0f / sqrtf(wave_sum((d.x * d.x + d.y * d.y) + (d.z * d.z + d.w * d.w)) * (1.0f / 256.0f) + EPS);
        const f32x4 y = d * rstd * gln + bln;
        u32x2 o; o.x = pk2(y.x * sigmoidf_(y.x), y.y * sigmoidf_(y.y)); o.y = pk2(y.z * sigmoidf_(y.z), y.w * sigmoidf_(y.w));
        *(u32x2*)(BR + (size_t)(t0 + j) * 1024 + 768 + 4 * lane) = o;
    }
}

__device__ __forceinline__ void win_item(int l, int r, LAS float* scr, int lane) {
    const cargs_t ap = get_args();
    transpose_item(ap->w_in + (size_t)l * 1024 * INC, INC, 80, (bf16_t*)(ap->ws + (l == 0 ? WS_WINT : WS_WINT1)), 1024, scr, r, lane, ap->g_mix + l * 1024);
}
__device__ __forceinline__ void wlat_chunk(int l, int c) {
    const cargs_t ap = get_args();
    const float* w_uq = ap->w_uq + (size_t)l * 256 * 384; const float* w_ukv = ap->w_ukv + (size_t)l * 128 * 512; const float* gq = ap->g_q_lat + l * 256; const float* gkv = ap->g_kv_lat + l * 128;
    const int n = c / 48, k0 = (c % 48) * 8; float v[8];
#pragma unroll
    for (int e = 0; e < 8; ++e) { const int k = k0 + e; v[e] = (n < 384 && k < 256) ? gq[k] * w_uq[(size_t)k * 384 + n] : ((n >= 512 && k >= 256) ? gkv[k - 256] * w_ukv[(size_t)(k - 256) * 512 + (n - 512)] : 0.f); }
    u32x4 o; o.x = pk2(v[0], v[1]); o.y = pk2(v[2], v[3]); o.z = pk2(v[4], v[5]); o.w = pk2(v[6], v[7]);
    *(u32x4*)((bf16_t*)(ap->ws + (l == 0 ? WS_WLT : WS_WLT1)) + (size_t)n * 384 + k0) = o;
}

#define XB_TMO      128
#define XB_XCNT(j)  (256  + 64 * (j))
#define XB_XSUB(j)  (1280 + 64 * (j))
#define XB_XGEN(j)  (2304 + 64 * (j))
#define XB_TOP      3328
#define XB_TOPGEN   3392
#define XCD_BAR_WORDS 3456
#define XB_SPIN_CAP (1u << 18)
__device__ __forceinline__ unsigned xb_ld(unsigned* p)              { return __hip_atomic_load(p, __ATOMIC_RELAXED, __HIP_MEMORY_SCOPE_AGENT); }
__device__ __forceinline__ unsigned xb_add(unsigned* p, unsigned v) { return __hip_atomic_fetch_add(p, v, __ATOMIC_RELAXED, __HIP_MEMORY_SCOPE_AGENT); }
__device__ __forceinline__ unsigned xb_xcc_id() { return (unsigned)__builtin_amdgcn_s_getreg((3 << 11) | 20) & 0xFu; }
#define XB_SPIN(cond, bar) do { unsigned _sp = 0; while (cond) { __builtin_amdgcn_s_sleep(1); \
    if ((++_sp & 255u) == 0u) { if (xb_ld(&(bar)[XB_TMO])) break; if (_sp > XB_SPIN_CAP) { atomicAdd(&(bar)[XB_TMO], 1u); break; } } } } while (0)
struct XcdBarrier { unsigned* bar; unsigned x; volatile LAS unsigned* st; };
__device__ __forceinline__ void xcd_barrier_complete(unsigned* bar, unsigned x, unsigned& nloc, unsigned& nx) {
    const unsigned G = gridDim.x * gridDim.y * gridDim.z;
    unsigned sum, cnt, mine, sp = 0u;
    for (;;) {
        sum = 0u; cnt = 0u; mine = 0u;
#pragma unroll
        for (unsigned j = 0; j < 16; ++j) { const unsigned c = xb_ld(&bar[XB_XCNT(j)]); sum += c; cnt += (c > 0u) ? 1u : 0u; mine = (j == x) ? c : mine; }
        if (sum == G) break;
        __builtin_amdgcn_s_sleep(1);
        if ((++sp & 255u) == 0u) { if (xb_ld(&bar[XB_TMO])) break; if (sp > XB_SPIN_CAP) { atomicAdd(&bar[XB_TMO], 1u); break; } }
    }
    nloc = mine > 0u ? mine : 1u; nx = cnt > 0u ? cnt : 1u;
}
__device__ __forceinline__ void xcd_barrier(const XcdBarrier& b) {
    asm volatile("s_waitcnt vmcnt(0)" ::: "memory");
    __syncthreads();
    if (threadIdx.x == 0) {
        unsigned* bar = b.bar;
        __builtin_amdgcn_s_waitcnt(0);
        unsigned nloc = b.st[0], nx = b.st[1];
        if (nloc == 0u) { xcd_barrier_complete(bar, b.x, nloc, nx); b.st[0] = nloc; b.st[1] = nx; }
        const unsigned old = xb_add(&bar[XB_XSUB(b.x)], 1u);
        const unsigned gen = old / nloc;
        if (old + 1u == (gen + 1u) * nloc) {
            __builtin_amdgcn_fence(__ATOMIC_RELEASE, "agent");
            asm volatile("s_waitcnt vmcnt(0)" ::: "memory");
            const unsigned og = xb_add(&bar[XB_TOP], 1u);
            const unsigned tg = og / nx;
            if (og + 1u == (tg + 1u) * nx) xb_add(&bar[XB_TOPGEN], 1u);
            else XB_SPIN(xb_ld(&bar[XB_TOPGEN]) == tg, bar);
            __builtin_amdgcn_fence(__ATOMIC_ACQUIRE, "agent");
            xb_add(&bar[XB_XGEN(b.x)], 1u);
            asm volatile("s_waitcnt vmcnt(0)" ::: "memory");
        } else {
            XB_SPIN(xb_ld(&bar[XB_XGEN(b.x)]) == gen, bar);
            __builtin_amdgcn_fence(__ATOMIC_ACQUIRE, "agent");
            asm volatile("s_waitcnt vmcnt(0)" ::: "memory");
        }
    }
    __syncthreads();
}
constexpr int CTL_BAR_WORD = 4096;
constexpr int LDS_MISC = 131072 + 128;
#define GRID_BAR() do { const cargs_t ap_ = get_args(); XcdBarrier b_; b_.bar = (unsigned*)(ap_->ws + WS_CTL) + CTL_BAR_WORD; b_.x = xb_xcc_id(); \
    b_.st = (volatile LAS unsigned*)(lds + LDS_MISC); xcd_barrier(b_); } while (0)

#define WSP(T, off) ((T*)(ws + (off)))
#define REP_P1 1
#define REP_P2 1
#define REP_P3 1
#define REP_P4 1
#define REP_P5 1
#define REP_P6 1
#define REP_P7 1
#define REP_P8 1
#define REP_P9 1
#define REP_P10 1
#define REP_SYNC 0
#define PHASE_BEGIN(R) _Pragma("unroll 1") for (int rep = 0; rep < (R); ++rep) {
#define PHASE_END GRID_BAR(); }
__global__ void __launch_bounds__(512, 2) fwd_megakernel(Args A_unused) {
    extern __shared__ __attribute__((aligned(16))) unsigned char lds_raw[];
    LAS unsigned char* lds = (LAS unsigned char*)lds_raw;
    {
        if (threadIdx.x < 8) ((LAS unsigned*)(lds + LDS_MISC))[threadIdx.x] = 0u;
        __syncthreads();
        const cargs_t ap = get_args();
        if (threadIdx.x == 0) (void)xb_add((unsigned*)(ap->ws + WS_CTL) + CTL_BAR_WORD + XB_XCNT(xb_xcc_id()), 1u);
    }
    cg::this_grid().sync();

#pragma unroll 1
    for (int l = 0; l < 2; ++l) {
        if (l == 0) {
        PHASE_BEGIN(REP_P1)
            const cargs_t ap = get_args(); unsigned char* const ws = ap->ws;
            const int tid = fresh_tid(), lane = tid & 63, wid = __builtin_amdgcn_readfirstlane(tid >> 6), G = gridDim.x, bx = blockIdx.x, gw = bx * 8 + wid, NGW = G * 8;
            LAS float* scr = (LAS float*)(lds + wid * 16384);
            for (int it = gw; it < 1280; it += NGW) win_item(0, it, scr, lane);
            for (int c = bx * 512 + tid; c < 1024 * 48; c += G * 512) wlat_chunk(0, c);
            const float* xin = ap->x; bf16_t* XN = WSP(bf16_t, WS_XN); float* rss = WSP(float, WS_ROWSS);
            for (int m = gw; m < TOK; m += NGW) prenorm_row(xin + (size_t)m * 1024, XN + (size_t)m * 1024, rss + (size_t)m * 16, lane);
        GRID_BAR(); }
        }
        PHASE_BEGIN(REP_P2)
            const cargs_t ap = get_args(); unsigned char* const ws = ap->ws;
            const char* hin = (l == 0) ? WSP(const char, WS_XN) : (const char*)ap->out;
            pg8::PlainOrder S{hin, (l == 0) ? WSP(const char, WS_WINT) : WSP(const char, WS_WINT1), 1024, 1024, 64, 10, 16, (int)gridDim.x, (int)blockIdx.x};
            const float* slots = WSP(const float, WS_ROWSS) + (size_t)(l * 2) * ROWSS_STRIDE;
            pg8::Unit u0; int pm0 = -1; if (S.next(0, u0)) { pm0 = u0.pm; fill_rinv_table(lds, slots, pm0); }
            pg8::EpiBf16<0, 1, true> E{WSP(bf16_t, WS_PROJ), PLD, slots, pm0, (unsigned)(uintptr_t)(lds + LDS_RINV), WSP(float, WS_LATSS)};
            pg8::gemm_phase(lds, 1024, 1024, S, E);
        PHASE_END
        PHASE_BEGIN(REP_P3)
            const cargs_t ap = get_args(); unsigned char* const ws = ap->ws;
            const int tid = fresh_tid(), lane = tid & 63, wid = __builtin_amdgcn_readfirstlane(tid >> 6), G = gridDim.x, bx = blockIdx.x, gw = bx * 8 + wid, NGW = G * 8;
            const bf16_t* PROJ = WSP(const bf16_t, WS_PROJ);
            if (bx < 16) {
                const int b = bx >> 2, h = bx & 3; const float bf = ap->b_forget[l * 4 + h];
                const bf16_t* src = PROJ + ((size_t)b * SEQ + tid * 8) * PLD + C_CF + h;
                float v[8];
#pragma unroll
                for (int i = 0; i < 8; ++i) v[i] = bf2f(src[(size_t)i * PLD]);
#pragma unroll
                for (int i = 0; i < 8; ++i) { v[i] = logsig(v[i] + bf); if (i) v[i] += v[i - 1]; }
                float incl = v[7];
#pragma unroll
                for (int o = 1; o < 64; o <<= 1) { const float u = __shfl_up(incl, o); if (lane >= o) incl += u; }
                LAS float* wtot = (LAS float*)(lds + 131072 + 64);
                if (lane == 63) wtot[wid] = incl;
                __syncthreads();
                float off = incl - v[7];
                for (int w = 0; w < wid; ++w) off += wtot[w];
                float* dst = WSP(float, WS_FCUM) + (size_t)(b * 4 + h) * SEQ + tid * 8;
                f32x4 o0 = {v[0] + off, v[1] + off, v[2] + off, v[3] + off}, o1 = {v[4] + off, v[5] + off, v[6] + off, v[7] + off};
                *(f32x4*)dst = o0; *(f32x4*)(dst + 4) = o1;
            }
            const int* posp = ap->pos;
            bf16_t* KROT = WSP(bf16_t, WS_KROT); bf16_t* U = WSP(bf16_t, WS_U);
            const float invf = exp2f(-(float)(lane & 15) * 0.8304820237218406f);
            const bool kx = (gridDim.x == 256); unsigned* KMAXp = (unsigned*)(ws + WS_CTL) + 1024; LAS float* kred = (LAS float*)(lds + 131072 + 512); int kiter = 0;
            if (!kx && bx == 0 && tid < 16) atomicMax(KMAXp + tid, 0x7f7fffffu);
            for (int t0 = gw * 4; t0 < TOK; t0 += NGW * 4) {
                u32x2 dv4[4], dg4[4], ck4[4]; float x14[4], x24[4], pos4[4];
#pragma unroll
                for (int j = 0; j < 4; ++j) { const bf16_t* row = PROJ + (size_t)(t0 + j) * PLD;
                    dv4[j] = *(const u32x2*)(row + C_DV + 4 * lane); dg4[j] = *(const u32x2*)(row + C_DG + 4 * lane); ck4[j] = *(const u32x2*)(row + C_CK + 4 * lane);
                    x14[j] = bf2f(row[C_BKR + (lane & 15)]); x24[j] = bf2f(row[C_BKR + 16 + (lane & 15)]); pos4[j] = (float)posp[t0 + j]; }
#pragma unroll
                for (int j = 0; j < 4; ++j) { const int t = t0 + j;
                    if (lane < 16) {
                        const float ang = pos4[j] * invf, kk = rintf(ang * 0.15915494309189535f);
                        float rem = fmaf(-kk, 6.2831854820251465f, ang); rem = fmaf(kk, 1.7484555e-7f, rem);
                        const float sn = __sinf(rem), cn = __cosf(rem);
                        const unsigned w = pk2(x14[j] * cn - x24[j] * sn, x24[j] * cn + x14[j] * sn);
                        KROT[(size_t)t * 32 + lane] = (bf16_t)(w & 0xffffu); KROT[(size_t)t * 32 + 16 + lane] = (bf16_t)(w >> 16);
                    }
                    {
                        const u32x2 v = dv4[j], gt = dg4[j];
                        u32x2 o; o.x = pk2(lo_f(v.x) * sigmoidf_(lo_f(gt.x)), hi_f(v.x) * sigmoidf_(hi_f(gt.x))); o.y = pk2(lo_f(v.y) * sigmoidf_(lo_f(gt.y)), hi_f(v.y) * sigmoidf_(hi_f(gt.y)));
                        *(u32x2*)(U + (size_t)t * 256 + 4 * lane) = o;
                    }
                }
                if (kx) {
                    float km = 0.f;
#pragma unroll
                    for (int j = 0; j < 4; ++j) { const float a0 = lo_f(ck4[j].x), a1 = hi_f(ck4[j].x), a2 = lo_f(ck4[j].y), a3 = hi_f(ck4[j].y); float q = (a0 * a0 + a1 * a1) + (a2 * a2 + a3 * a3);
                        q += __shfl_xor(q, 1); q += __shfl_xor(q, 2); q += __shfl_xor(q, 4); q += __shfl_xor(q, 8); km = fmaxf(km, q); }
                    const int par = kiter & 1; ++kiter;
                    if ((lane & 15) == 0) kred[par * 32 + wid * 4 + (lane >> 4)] = km;
                    __syncthreads();
                    if (tid < 4) { float m = kred[par * 32 + tid];
#pragma unroll
                        for (int w = 1; w < 8; ++w) m = fmaxf(m, kred[par * 32 + w * 4 + tid]);
                        atomicMax(KMAXp + (t0 >> 12) * 4 + tid, __float_as_uint(m)); }
                }
            }
            { const cargs_t ap2 = get_args(); unsigned char* const ws = ap2->ws;
              pg8::PlainOrder S{WSP(const char, WS_PROJ) + C_BQL * 2, (l == 0) ? WSP(const char, WS_WLT) : WSP(const char, WS_WLT1), PLD, 384, 64, 4, 6, (int)gridDim.x, (int)blockIdx.x};
              pg8::EpiBf16<0, 2> E{WSP(bf16_t, WS_QKVB), 1024, nullptr, -1, 0u, WSP(float, WS_LATSS)};
              pg8::gemm_phase(lds, PLD, 384, S, E); }
            if (gridDim.x == 256 && blockIdx.x >= 16) { const int tidq = fresh_tid(), laneq = tidq & 63, widq = __builtin_amdgcn_readfirstlane(tidq >> 6);
                late_weight_item(l, ((int)blockIdx.x - 16) * 8 + widq, (LAS float*)(lds + widq * 16384), laneq); }
        PHASE_END
        PHASE_BEGIN(REP_P5)
            LAS int* wq = (LAS int*)(lds + 131072);
            const int NP3 = (gridDim.x == 256) ? 1920 : 0, NLB = (N_LATE_ITEMS - NP3) / 16;
            for (;;) {
                __syncthreads();
                if (threadIdx.x == 0) { const cargs_t ap = get_args(); wq[0] = atomicAdd((int*)(ap->ws + WS_CTL) + 16 * (l * 8 + rep), 1); }
                __syncthreads();
                const int it = wq[0];
                if (it >= 768 + 256 + NLB + (l == 0 ? 80 + 96 : 0)) break;
                if (it >= 768) {
                    const int tidq = fresh_tid(), laneq = tidq & 63, widq = __builtin_amdgcn_readfirstlane(tidq >> 6);
                    if (it < 1024) conv_tokens(l, ((it - 768) * 8 + widq) * 8, laneq);
                    else if (it >= 1024 + NLB) {
                        const int e = it - (1024 + NLB);
                        if (e < 80) { LAS float* scr = (LAS float*)(lds + widq * 16384); win_item(l + 1, e * 16 + widq * 2, scr, laneq); win_item(l + 1, e * 16 + widq * 2 + 1, scr, laneq); }
                        else wlat_chunk(l + 1, (e - 80) * 512 + tidq);
                    }
                    else { LAS float* scr = (LAS float*)(lds + widq * 16384); const int r0 = NP3 + (it - 1024) * 16 + widq * 2; late_weight_item(l, r0, scr, laneq); late_weight_item(l, r0 + 1, scr, laneq); }
                    continue;
                }
                int mode, bh, qb;
                if (it >= 384 && it < 640) { const int a = it - 384; mode = 0; bh = a & 15; qb = a >> 4; }
                else { const int k = it < 384 ? it : it - 256; const int lvl = k >> 5, w = k & 31; qb = 15 - lvl; mode = (w < 16) ? 1 : 2; bh = w & 15; }
                if (mode == 0) att::unit<0>(l, bh >> 2, bh & 3, qb, lds);
                else if (mode == 1) att::unit<1>(l, bh >> 2, bh & 3, qb, lds);
                else att::unit<2>(l, bh >> 2, bh & 3, qb, lds);
            }
        PHASE_END
        PHASE_BEGIN(REP_P6)
            const cargs_t ap = get_args(); unsigned char* const ws = ap->ws;
            const char* hin = (l == 0) ? WSP(const char, WS_XN) : (const char*)ap->out;
            pg8::GateBranchOrder S{hin, WSP(const char, WS_BR), WSP(const char, WS_WGT), WSP(const char, WS_WBT), (int)gridDim.x, (int)blockIdx.x};
            const float* slots = WSP(const float, WS_ROWSS) + (size_t)(l * 2) * ROWSS_STRIDE; const float* bg = ap->b_gate + (size_t)l * 4096;
            pg8::Unit u0; int pm0 = -1, pd0 = -1;
            if (S.next(0, u0)) { pm0 = u0.pm; pd0 = u0.pn & 3; const int t = fresh_tid();
                ((LAS float*)(lds + LDS_BIAS))[t] = bg[(t >> 8) * 1024 + pd0 * 256 + (t & 255)]; ((LAS float*)(lds + LDS_BIAS))[t + 512] = bg[((t + 512) >> 8) * 1024 + pd0 * 256 + (t & 255)];
                fill_rinv_table(lds, slots, pm0); }
            pg8::EpiGateBranch E{WSP(bf16_t, WS_MIXED), bg, slots, (LAS unsigned*)(lds + 131072 + 1024), pm0, pd0, (unsigned)(uintptr_t)(lds + LDS_RINV), (unsigned)(uintptr_t)(lds + LDS_BIAS)};
            pg8::gemm_phase(lds, 1024, 1024, S, E);
        PHASE_END
        PHASE_BEGIN(REP_P7)
            const cargs_t ap = get_args(); unsigned char* const ws = ap->ws;
            pg8::PlainOrder S{WSP(const char, WS_MIXED), WSP(const char, WS_WOT), 1024, 1024, 64, 4, 16, (int)gridDim.x, (int)blockIdx.x};
            if (l == 0) { pg8::EpiRes<true> E{ap->x, WSP(bf16_t, WS_XA), WSP(float, WS_ROWSS) + (size_t)1 * ROWSS_STRIDE};
                pg8::gemm_phase(lds, 1024, 1024, S, E); }
            else { pg8::EpiRes<false> E{ap->out, WSP(bf16_t, WS_XA), WSP(float, WS_ROWSS) + (size_t)3 * ROWSS_STRIDE};
                pg8::gemm_phase(lds, 1024, 1024, S, E); }
        PHASE_END
        PHASE_BEGIN(REP_P9)
            const cargs_t ap = get_args(); unsigned char* const ws = ap->ws;
            pg8::PlainOrder S{WSP(const char, WS_XA), WSP(const char, WS_W1T), 1024, 1024, 64, 16, 16, (int)gridDim.x, (int)blockIdx.x};
            const float* slots = WSP(const float, WS_ROWSS) + (size_t)(l * 2 + 1) * ROWSS_STRIDE;
            pg8::Unit u0; int pm0 = -1; if (S.next(0, u0)) { pm0 = u0.pm; fill_rinv_table(lds, slots, pm0); }
            pg8::EpiBf16<2, 1> E{WSP(bf16_t, WS_H), 4096, slots, pm0, (unsigned)(uintptr_t)(lds + LDS_RINV), nullptr};
            pg8::gemm_phase(lds, 1024, 1024, S, E);
        PHASE_END
        PHASE_BEGIN(REP_P10)
            const cargs_t ap = get_args(); unsigned char* const ws = ap->ws;
            pg8::PlainOrder S{WSP(const char, WS_H), WSP(const char, WS_W2T), 4096, 4096, 64, 4, 64, (int)gridDim.x, (int)blockIdx.x};
            if (l == 0) { pg8::EpiRes<false> E{WSP(const bf16_t, WS_XA), (bf16_t*)ap->out, WSP(float, WS_ROWSS) + (size_t)2 * ROWSS_STRIDE};
                pg8::gemm_phase(lds, 4096, 4096, S, E); }
            else { pg8::EpiFinal E{WSP(const bf16_t, WS_XA), ap->out, WSP(float, WS_ROWSS) + (size_t)4 * ROWSS_STRIDE, ap->g_final, (unsigned*)(ws + WS_CTL) + 8192};
                pg8::gemm_phase(lds, 4096, 4096, S, E); }
        if (l == 0) GRID_BAR(); }
    }
    _Pragma("unroll 1") for (int i = 0; i < REP_SYNC; ++i) GRID_BAR();
}

extern "C" void kernel_launch(void* const* d_in, const int* in_sizes, int n_in, void* d_out, int out_size, void* d_ws, size_t ws_size, hipStream_t stream) {
    static int grid = 0;
    if (grid == 0) {
        if (n_in != 22 || out_size != TOK * DM || ws_size < WS_END) { fprintf(stderr, "kernel_launch: unexpected shapes (n_in %d out %d ws %zu)\n", n_in, out_size, ws_size); grid = -1; return; }
        int dev = 0, cus = 0, per_cu = 0;
        if (hipGetDevice(&dev) != hipSuccess || hipDeviceGetAttribute(&cus, hipDeviceAttributeMultiprocessorCount, dev) != hipSuccess) { grid = -1; return; }
        if (hipFuncSetAttribute((const void*)fwd_megakernel, hipFuncAttributeMaxDynamicSharedMemorySize, LDS_BYTES) != hipSuccess) { fprintf(stderr, "hipFuncSetAttribute failed\n"); grid = -1; return; }
        if (hipOccupancyMaxActiveBlocksPerMultiprocessor(&per_cu, (const void*)fwd_megakernel, 512, LDS_BYTES) != hipSuccess || per_cu < 1) { fprintf(stderr, "occupancy query: %d blocks per CU\n", per_cu); grid = -1; return; }
        grid = cus;
    }
    if (grid < 0) return;
    (void)hipMemsetAsync((char*)d_ws + WS_CTL, 0, 65536, stream);
    Args a{};
    a.x = (const float*)d_in[0]; a.pos = (const int*)d_in[1]; a.g_mix = (const float*)d_in[2]; a.w_in = (const float*)d_in[3]; a.w_gate = (const float*)d_in[4]; a.b_gate = (const float*)d_in[5];
    a.rel_bias = (const float*)d_in[6]; a.g_q_lat = (const float*)d_in[7]; a.w_uq = (const float*)d_in[8]; a.g_kv_lat = (const float*)d_in[9]; a.w_ukv = (const float*)d_in[10];
    a.b_forget = (const float*)d_in[11]; a.w_dw = (const float*)d_in[12]; a.b_dw = (const float*)d_in[13]; a.g_conv_ln = (const float*)d_in[14]; a.b_conv_ln = (const float*)d_in[15];
    a.w_branch = (const float*)d_in[16]; a.w_o = (const float*)d_in[17]; a.g_ffn = (const float*)d_in[18]; a.w_up = (const float*)d_in[19]; a.w_down = (const float*)d_in[20]; a.g_final = (const float*)d_in[21];
    a.out = (float*)d_out; a.ws = (unsigned char*)d_ws;
    void* args[] = {&a};
    hipError_t e = hipLaunchCooperativeKernel((const void*)fwd_megakernel, dim3(grid), dim3(512), args, LDS_BYTES, stream);
    if (e != hipSuccess) fprintf(stderr, "cooperative launch failed: %s (grid %d)\n", hipGetErrorString(e), grid);
}
```

```cpp
#include <hip/hip_runtime.h>
#include <hip/hip_cooperative_groups.h>
#include <cstdio>
#include <cstdint>
namespace cg = cooperative_groups;

#define LAS __attribute__((address_space(3)))
typedef unsigned short bf16_t;
typedef short bf16x8 __attribute__((ext_vector_type(8)));
typedef short s16x4 __attribute__((ext_vector_type(4)));
typedef float f32x4 __attribute__((ext_vector_type(4)));
typedef float f32x16 __attribute__((ext_vector_type(16)));
typedef unsigned u32x4 __attribute__((ext_vector_type(4)));
typedef unsigned u32x2 __attribute__((ext_vector_type(2)));
typedef float f32x2_t __attribute__((ext_vector_type(2)));
typedef __bf16 bf16x2_t __attribute__((ext_vector_type(2)));

constexpr int NB = 4, SEQ = 4096, DM = 1024, TOK = NB * SEQ, DFF = 4096, INC = 2468, PLD = 2560;
constexpr int C_AQ = 0, C_AK = 256, C_AV = 512, C_BQL = 768, C_BKVL = 1024, C_BKR = 1152, C_CQ = 1184, C_CK = 1440, C_CV = 1696, C_CF = 1952, C_DV = 1956, C_DG = 2212;
constexpr float LOG2E = 1.4426950408889634f;
constexpr float EPS = 1e-6f;
constexpr size_t MiB = 1u << 20;
constexpr size_t WS_W1T = 4 * MiB, WS_W2T = 12 * MiB, WS_XN = 20 * MiB, WS_PROJ = 52 * MiB, WS_XA = 52 * MiB, WS_H = 116 * MiB;
constexpr size_t WS_QKVB = 132 * MiB, WS_MIXED = 132 * MiB, WS_BR = 164 * MiB, WS_LAT = 196 * MiB, WS_U = 208 * MiB;
constexpr size_t WS_WINT = 216 * MiB, WS_WGT = 221 * MiB, WS_WLT = 229 * MiB, WS_WBT = 230 * MiB, WS_WOT = 238 * MiB;
constexpr size_t WS_CTL = 244 * MiB, WS_FCUM = 244 * MiB + 256 * 1024, WS_KROT = 245 * MiB, WS_END = 256 * MiB;
constexpr size_t WS_WINT1 = 251 * MiB, WS_WLT1 = 0, WS_LATSS = 1 * MiB;
constexpr size_t WS_ROWSS = 246 * MiB, ROWSS_STRIDE = (size_t)TOK * 16;
constexpr int LDS_RINV = 131072 + 1024 + 16384;
constexpr int LDS_BIAS = LDS_RINV + 1024;
constexpr int LDS_BYTES = LDS_BIAS + 4096;

struct Args {
    const float* x; const int* pos; const float* g_mix; const float* w_in; const float* w_gate; const float* b_gate; const float* rel_bias;
    const float* g_q_lat; const float* w_uq; const float* g_kv_lat; const float* w_ukv; const float* b_forget; const float* w_dw; const float* b_dw;
    const float* g_conv_ln; const float* b_conv_ln; const float* w_branch; const float* w_o; const float* g_ffn; const float* w_up; const float* w_down; const float* g_final;
    float* out; unsigned char* ws;
};

typedef const __attribute__((address_space(4))) Args* cargs_t;
__device__ __forceinline__ cargs_t get_args() { cargs_t p = (cargs_t)__builtin_amdgcn_kernarg_segment_ptr(); asm volatile("" : "+s"(p)); return p; }
__device__ __forceinline__ int fresh_tid() { int t = threadIdx.x; asm volatile("" : "+v"(t)); return t; }
__device__ __forceinline__ float bf2f(unsigned short b) { return __uint_as_float((unsigned)b << 16); }
__device__ __forceinline__ unsigned pk2(float lo, float hi) { f32x2_t v = {lo, hi}; bf16x2_t b = __builtin_convertvector(v, bf16x2_t); return __builtin_bit_cast(unsigned, b); }
__device__ __forceinline__ float lo_f(unsigned w) { return __uint_as_float(w << 16); }
__device__ __forceinline__ float hi_f(unsigned w) { return __uint_as_float(w & 0xffff0000u); }
__device__ __forceinline__ float wave_sum(float v) {
#pragma unroll
    for (int o = 1; o < 64; o <<= 1) v += __shfl_xor(v, o);
    return v;
}
__device__ __forceinline__ float sigmoidf_(float x) { return 1.0f / (1.0f + __expf(-x)); }
#define LDS_WAIT() asm volatile("s_waitcnt lgkmcnt(0)" ::: "memory")
__device__ __forceinline__ float row_rinv(const float* slots, int row, int fq) {
    const f32x4 a = *(const f32x4*)(slots + (size_t)row * 16 + 4 * fq);
    float s = (a.x + a.y) + (a.z + a.w);
    s += __shfl_xor(s, 16); s += __shfl_xor(s, 32);
    return __builtin_amdgcn_rsqf(s * (1.0f / 1024.0f) + EPS);
}
__device__ __forceinline__ void fill_rinv_table(LAS unsigned char* lds, const float* slots, int pm) {
    const int t = fresh_tid();
    if (t < 256) { const f32x4* p = (const f32x4*)(slots + (size_t)(pm * 256 + t) * 16); const f32x4 a = p[0], b = p[1], c = p[2], d = p[3];
        const float s = (((a.x + a.y) + (a.z + a.w)) + ((b.x + b.y) + (b.z + b.w))) + (((c.x + c.y) + (c.z + c.w)) + ((d.x + d.y) + (d.z + d.w)));
        ((LAS float*)(lds + LDS_RINV))[t] = __builtin_amdgcn_rsqf(s * (1.0f / 1024.0f) + EPS); }
    __syncthreads();
}
__device__ __forceinline__ float lds_rinv_read(unsigned addr) { float r; asm volatile("ds_read_b32 %0, %1" : "=v"(r) : "v"(addr)); return r; }
__device__ __forceinline__ f32x4 lds_read4(unsigned addr) { f32x4 r; asm volatile("ds_read_b128 %0, %1" : "=v"(r) : "v"(addr)); return r; }
namespace pg8 {
constexpr int BM = 256, BK = 64, HALF = 128, HTB = HALF * BK * 2, STAGE_BYTES = 8 * HTB, NXCD = 8, WGM = 8;
__host__ __device__ __forceinline__ int lds_byte(int r, int c) { const int st = (r >> 4) * 2 + (c >> 5), rr = r & 15, cc = c & 31, ob = rr * 64 + cc * 2; return st * 1024 + (ob ^ (((ob >> 9) & 1) << 5)); }
__host__ __device__ __forceinline__ void stage_rc(int b, int& R, int& C) { const int st = b / 1024, sb = b % 1024, swz = sb ^ (((sb >> 9) & 1) << 5); R = (st >> 1) * 16 + swz / 64; C = (st & 1) * 32 + (swz % 64) / 2; }
__host__ __device__ __forceinline__ int perm32(int rho) { const int n = rho >> 4, i = rho & 15; return 8 * (i >> 2) + 4 * n + (i & 3); }

struct Unit { int pm, pn, nt, kind; const char* a; const char* b; };

__device__ __forceinline__ bool tile_of(int L, int nM, int nN, int& pm, int& pn) {
    const int nwg = nM * nN; if (L >= nwg) return false;
    int wgid = L; { const int q = nwg / NXCD, r = nwg % NXCD, xcd = wgid % NXCD, off = wgid / NXCD; wgid = (xcd < r ? xcd * (q + 1) : r * (q + 1) + (xcd - r) * q) + off; }
    const int nig = WGM * nN, gid = wgid / nig, fm = gid * WGM, gsz = (nM - fm) < WGM ? (nM - fm) : WGM;
    pm = fm + ((wgid % nig) % gsz); pn = (wgid % nig) / gsz; return true;
}
struct PlainOrder {
    const char* A; const char* Bt; int lda, ldb, nM, nN, nt, G, c;
    __device__ __forceinline__ bool next(int i, Unit& u) const {
        int pm, pn; if (!tile_of(i * G + c, nM, nN, pm, pn)) return false;
        u.pm = pm; u.pn = pn; u.nt = nt; u.kind = 0; u.a = A + (size_t)pm * 256 * lda * 2; u.b = Bt + (size_t)pn * 256 * ldb * 2; return true;
    }
};
struct GateBranchOrder {
    const char* XN; const char* BR; const char* WgT; const char* WbT; int G, c;
    __device__ __forceinline__ bool next(int i, Unit& u) const {
        const int gi = i >> 3, j = i & 7; int pm, pd; if (!tile_of(gi * G + c, 64, 4, pm, pd)) return false;
        const int n = j >> 1, kind = j & 1; u.pm = pm; u.pn = n * 4 + pd; u.kind = kind;
        if (kind == 0) { u.nt = 16; u.a = XN + (size_t)pm * 256 * 1024 * 2; u.b = WgT + (size_t)u.pn * 256 * 1024 * 2; }
        else { u.nt = 4; u.a = BR + ((size_t)pm * 256 * 1024 + n * 256) * 2; u.b = WbT + ((size_t)u.pn * 256 * 1024 + n * 256) * 2; }
        return true;
    }
};

template <int ACT  , int RS  , bool LATSS = false  > struct EpiBf16 {
    static constexpr bool PERM = true; struct State {};
    bf16_t* O; int ldc; const float* rowss; int pm_tab; unsigned tab; float* latss;
    __device__ __forceinline__ void operator()(const f32x4 (&acc)[2][2][4][2], State&, const Unit& u, int wr, int wc, int fr, int fq) const {
        asm volatile("" : "+v"(fr), "+v"(fq));
        const int row0 = u.pm * BM + wr * 64 + fr, col0 = u.pn * BM + wc * 32 + 8 * fq;
        float rv[2][4];
        if (RS == 1) {
            if (u.pm == pm_tab) {
#pragma unroll
                for (int ai = 0; ai < 2; ++ai)
#pragma unroll
                    for (int m = 0; m < 4; ++m) rv[ai][m] = lds_rinv_read(tab + (unsigned)(wr * 64 + fr + ai * HALF + m * 16) * 4u);
                asm volatile("s_waitcnt lgkmcnt(0)" : "+v"(rv[0][0]), "+v"(rv[0][1]), "+v"(rv[0][2]), "+v"(rv[0][3]), "+v"(rv[1][0]), "+v"(rv[1][1]), "+v"(rv[1][2]), "+v"(rv[1][3]));
            } else {
#pragma unroll
                for (int ai = 0; ai < 2; ++ai)
#pragma unroll
                    for (int m = 0; m < 4; ++m) rv[ai][m] = row_rinv(rowss, row0 + ai * HALF + m * 16, fq);
            }
        }
#pragma unroll
        for (int ai = 0; ai < 2; ++ai)
#pragma unroll
            for (int m = 0; m < 4; ++m) { bf16_t* rowp = O + (size_t)(row0 + ai * HALF + m * 16) * ldc + col0;
                float rinv = 1.f; if (RS == 1) rinv = rv[ai][m];
                if (RS == 2) { const f32x4 a = *(const f32x4*)(latss + (size_t)(row0 + ai * HALF + m * 16) * 8 + (u.pn >= 2 ? 4 : 0));
                    rinv = __builtin_amdgcn_rsqf(((a.x + a.y) + (a.z + a.w)) * (u.pn >= 2 ? (1.0f / 128.0f) : (1.0f / 256.0f)) + EPS); }
                float lss = 0.f;
#pragma unroll
                for (int bj = 0; bj < 2; ++bj) { f32x4 v0 = acc[ai][bj][m][0], v1 = acc[ai][bj][m][1];
                    if (RS) { v0 = v0 * rinv; v1 = v1 * rinv; }
                    if (LATSS) { if (bj == 0 || u.pn == 3) lss += ((v0.x * v0.x + v0.y * v0.y) + (v0.z * v0.z + v0.w * v0.w)) + ((v1.x * v1.x + v1.y * v1.y) + (v1.z * v1.z + v1.w * v1.w)); }
                    if (ACT == 2) {
#pragma unroll
                        for (int e = 0; e < 4; ++e) { const float a0 = fmaxf(v0[e], 0.f), a1 = fmaxf(v1[e], 0.f); v0[e] = a0 * a0; v1[e] = a1 * a1; } }
                    u32x4 w; w.x = pk2(v0[0], v0[1]); w.y = pk2(v0[2], v0[3]); w.z = pk2(v1[0], v1[1]); w.w = pk2(v1[2], v1[3]);
                    *(u32x4*)(rowp + bj * HALF) = w; }
                if (LATSS) { if (u.pn == 3 || u.pn == 4) { lss += __shfl_xor(lss, 16); lss += __shfl_xor(lss, 32);
                    if (fq == 0) latss[(size_t)(row0 + ai * HALF + m * 16) * 8 + (u.pn == 4 ? 4 : 0) + wc] = lss; } } }
    }
};
template <bool BASEF32> struct EpiRes {
    static constexpr bool PERM = true; struct State {};
    const void* base; bf16_t* out; float* rowss;
    __device__ __forceinline__ void operator()(const f32x4 (&acc)[2][2][4][2], State&, const Unit& u, int wr, int wc, int fr, int fq) const {
        asm volatile("" : "+v"(fr), "+v"(fq));
        const int row0 = u.pm * BM + wr * 64 + fr, col0 = u.pn * BM + wc * 32 + 8 * fq;
#pragma unroll
        for (int ai = 0; ai < 2; ++ai) {
            f32x4 bs[4][2][2];
#pragma unroll
            for (int m = 0; m < 4; ++m) { const size_t off = (size_t)(row0 + ai * HALF + m * 16) * 1024 + col0;
#pragma unroll
                for (int bj = 0; bj < 2; ++bj) {
                    if (BASEF32) { bs[m][bj][0] = *(const f32x4*)((const float*)base + off + bj * HALF); bs[m][bj][1] = *(const f32x4*)((const float*)base + off + bj * HALF + 4); }
                    else { const u32x4 w = *(const u32x4*)((const bf16_t*)base + off + bj * HALF);
                        bs[m][bj][0] = (f32x4){lo_f(w.x), hi_f(w.x), lo_f(w.y), hi_f(w.y)}; bs[m][bj][1] = (f32x4){lo_f(w.z), hi_f(w.z), lo_f(w.w), hi_f(w.w)}; } } }
            asm volatile("" ::: "memory");
#pragma unroll
            for (int m = 0; m < 4; ++m) { const int row = row0 + ai * HALF + m * 16; const size_t off = (size_t)row * 1024 + col0; float ss = 0.f;
#pragma unroll
                for (int bj = 0; bj < 2; ++bj) { const f32x4 v0 = bs[m][bj][0] + acc[ai][bj][m][0], v1 = bs[m][bj][1] + acc[ai][bj][m][1];
                    u32x4 w; w.x = pk2(v0[0], v0[1]); w.y = pk2(v0[2], v0[3]); w.z = pk2(v1[0], v1[1]); w.w = pk2(v1[2], v1[3]); *(u32x4*)(out + off + bj * HALF) = w;
                    ss += ((v0.x * v0.x + v0.y * v0.y) + (v0.z * v0.z + v0.w * v0.w)) + ((v1.x * v1.x + v1.y * v1.y) + (v1.z * v1.z + v1.w * v1.w)); }
                ss += __shfl_xor(ss, 16); ss += __shfl_xor(ss, 32); if (fq == 0) rowss[(size_t)row * 16 + u.pn * 4 + wc] = ss; }
            asm volatile("" ::: "memory");
        }
    }
};
struct EpiFinal {
    static constexpr bool PERM = true; struct State {};
    const bf16_t* base; float* out; float* rowss; const float* g; unsigned* cnt;
    __device__ __forceinline__ void operator()(const f32x4 (&acc_)[2][2][4][2], State&, const Unit& u, int wr, int wc, int fr, int fq) const {
        asm volatile("" : "+v"(fr), "+v"(fq));
        f32x4 (&acc)[2][2][4][2] = const_cast<f32x4 (&)[2][2][4][2]>(acc_);
        const int row0 = u.pm * BM + wr * 64 + fr, col0 = u.pn * BM + wc * 32 + 8 * fq;
#pragma unroll
        for (int ai = 0; ai < 2; ++ai) {
            u32x4 bs[4][2];
#pragma unroll
            for (int m = 0; m < 4; ++m) { const size_t off = (size_t)(row0 + ai * HALF + m * 16) * 1024 + col0;
#pragma unroll
                for (int bj = 0; bj < 2; ++bj) bs[m][bj] = *(const u32x4*)(base + off + bj * HALF); }
            asm volatile("" ::: "memory");
#pragma unroll
            for (int m = 0; m < 4; ++m) { const int row = row0 + ai * HALF + m * 16; float ss = 0.f;
#pragma unroll
                for (int bj = 0; bj < 2; ++bj) { const u32x4 w = bs[m][bj];
                    const f32x4 v0 = acc[ai][bj][m][0] + (f32x4){lo_f(w.x), hi_f(w.x), lo_f(w.y), hi_f(w.y)}, v1 = acc[ai][bj][m][1] + (f32x4){lo_f(w.z), hi_f(w.z), lo_f(w.w), hi_f(w.w)};
                    acc[ai][bj][m][0] = v0; acc[ai][bj][m][1] = v1;
                    ss += ((v0.x * v0.x + v0.y * v0.y) + (v0.z * v0.z + v0.w * v0.w)) + ((v1.x * v1.x + v1.y * v1.y) + (v1.z * v1.z + v1.w * v1.w)); }
                ss += __shfl_xor(ss, 16); ss += __shfl_xor(ss, 32); if (fq == 0) rowss[(size_t)row * 16 + u.pn * 4 + wc] = ss; }
        }
        asm volatile("s_waitcnt vmcnt(0)" ::: "memory"); __builtin_amdgcn_s_barrier(); asm volatile("" ::: "memory");
        if (threadIdx.x == 0) {
            __builtin_amdgcn_fence(__ATOMIC_RELEASE, "agent"); asm volatile("s_waitcnt vmcnt(0)" ::: "memory");
            unsigned* c = cnt + 64 * u.pm;
            (void)__hip_atomic_fetch_add(c, 1u, __ATOMIC_RELAXED, __HIP_MEMORY_SCOPE_AGENT);
            unsigned sp = 0;
            while (__hip_atomic_load(c, __ATOMIC_RELAXED, __HIP_MEMORY_SCOPE_AGENT) < 4u) { __builtin_amdgcn_s_sleep(1); if (++sp > (1u << 16)) break; }
            __builtin_amdgcn_fence(__ATOMIC_ACQUIRE, "agent"); asm volatile("s_waitcnt vmcnt(0)" ::: "memory");
        }
        asm volatile("" ::: "memory"); __builtin_amdgcn_s_barrier(); asm volatile("" ::: "memory");
        f32x4 gv[2][2];
#pragma unroll
        for (int bj = 0; bj < 2; ++bj)
#pragma unroll
            for (int q = 0; q < 2; ++q) gv[bj][q] = *(const f32x4*)(g + col0 + bj * HALF + 4 * q);
#pragma unroll
        for (int ai = 0; ai < 2; ++ai)
#pragma unroll
            for (int m = 0; m < 4; ++m) { const int row = row0 + ai * HALF + m * 16; const float rinv = row_rinv(rowss, row, fq); float* op = out + (size_t)row * 1024 + col0;
#pragma unroll
                for (int bj = 0; bj < 2; ++bj) { *(f32x4*)(op + bj * HALF) = acc[ai][bj][m][0] * rinv * gv[bj][0]; *(f32x4*)(op + bj * HALF + 4) = acc[ai][bj][m][1] * rinv * gv[bj][1]; } }
    }
};
struct EpiGateBranch {
    static constexpr bool PERM = true;
    struct State { unsigned g8[2][2][4][2]; };
    bf16_t* mixed; const float* bgate; const float* rowss; LAS unsigned* glds; int pm_tab, pd_tab; unsigned tab, btab;
    __device__ __forceinline__ void operator()(const f32x4 (&acc)[2][2][4][2], State& st, const Unit& u, int wr, int wc, int fr, int fq) const {
        asm volatile("" : "+v"(fr), "+v"(fq));
        const int rl0 = wr * 64 + fr, cl0 = wc * 32 + 8 * fq, n = u.pn >> 2, pd = u.pn & 3;
        LAS unsigned* gl = glds + (wr * 4 + wc) * 512 + (fq * 16 + fr) * 8;
        if (u.kind == 0) {
            f32x4 bv[2][2]; float rv[2][4];
            if (u.pm == pm_tab && pd == pd_tab) {
#pragma unroll
                for (int bj = 0; bj < 2; ++bj)
#pragma unroll
                    for (int q = 0; q < 2; ++q) bv[bj][q] = lds_read4(btab + (unsigned)(n * 256 + cl0 + bj * HALF + 4 * q) * 4u);
#pragma unroll
                for (int ai = 0; ai < 2; ++ai)
#pragma unroll
                    for (int m = 0; m < 4; ++m) rv[ai][m] = lds_rinv_read(tab + (unsigned)(rl0 + ai * HALF + m * 16) * 4u);
                asm volatile("s_waitcnt lgkmcnt(0)" : "+v"(bv[0][0]), "+v"(bv[0][1]), "+v"(bv[1][0]), "+v"(bv[1][1]), "+v"(rv[0][0]), "+v"(rv[0][1]), "+v"(rv[0][2]), "+v"(rv[0][3]), "+v"(rv[1][0]), "+v"(rv[1][1]), "+v"(rv[1][2]), "+v"(rv[1][3]));
            } else {
#pragma unroll
                for (int bj = 0; bj < 2; ++bj)
#pragma unroll
                    for (int q = 0; q < 2; ++q) bv[bj][q] = *(const f32x4*)(bgate + u.pn * BM + cl0 + bj * HALF + 4 * q);
#pragma unroll
                for (int ai = 0; ai < 2; ++ai)
#pragma unroll
                    for (int m = 0; m < 4; ++m) rv[ai][m] = row_rinv(rowss, u.pm * BM + rl0 + ai * HALF + m * 16, fq);
            }
#pragma unroll
            for (int ai = 0; ai < 2; ++ai)
#pragma unroll
                for (int m = 0; m < 4; ++m) {
                    const float rinv = rv[ai][m];
#pragma unroll
                    for (int bj = 0; bj < 2; ++bj)
#pragma unroll
                        for (int q = 0; q < 2; ++q) { const f32x4 v = acc[ai][bj][m][q] * rinv + bv[bj][q]; unsigned w = 0u;
#pragma unroll
                            for (int e = 0; e < 4; ++e) w |= (unsigned)(sigmoidf_(v[e]) * 255.0f + 0.5f) << (8 * e);
                            if (ai == 1 && bj == 1) gl[m * 2 + q] = w; else st.g8[ai][bj][m][q] = w; } }
        } else {
#pragma unroll
            for (int ai = 0; ai < 2; ++ai) {
                u32x4 oo[4][2];
#pragma unroll
                for (int m = 0; m < 4; ++m) { const int rl = rl0 + ai * HALF + m * 16; const bf16_t* mp = mixed + (size_t)(u.pm * BM + rl) * 1024 + pd * 256 + cl0;
#pragma unroll
                    for (int bj = 0; bj < 2; ++bj) { oo[m][bj] = (u32x4){0u, 0u, 0u, 0u}; if (n > 0) oo[m][bj] = *(const u32x4*)(mp + bj * HALF); } }
                asm volatile("" ::: "memory");
#pragma unroll
                for (int m = 0; m < 4; ++m) { const int rl = rl0 + ai * HALF + m * 16; bf16_t* mp = mixed + (size_t)(u.pm * BM + rl) * 1024 + pd * 256 + cl0;
#pragma unroll
                    for (int bj = 0; bj < 2; ++bj) { const unsigned g0 = (ai == 1 && bj == 1) ? gl[m * 2] : st.g8[ai][bj][m][0], g1 = (ai == 1 && bj == 1) ? gl[m * 2 + 1] : st.g8[ai][bj][m][1]; const u32x4 o = oo[m][bj]; const f32x4 a0 = acc[ai][bj][m][0] * (1.0f / 255.0f), a1 = acc[ai][bj][m][1] * (1.0f / 255.0f);
                        float v[8];
                        v[0] = fmaf(a0[0], (float)(g0 & 255u), lo_f(o.x)); v[1] = fmaf(a0[1], (float)((g0 >> 8) & 255u), hi_f(o.x)); v[2] = fmaf(a0[2], (float)((g0 >> 16) & 255u), lo_f(o.y)); v[3] = fmaf(a0[3], (float)(g0 >> 24), hi_f(o.y));
                        v[4] = fmaf(a1[0], (float)(g1 & 255u), lo_f(o.z)); v[5] = fmaf(a1[1], (float)((g1 >> 8) & 255u), hi_f(o.z)); v[6] = fmaf(a1[2], (float)((g1 >> 16) & 255u), lo_f(o.w)); v[7] = fmaf(a1[3], (float)(g1 >> 24), hi_f(o.w));
                        u32x4 w; w.x = pk2(v[0], v[1]); w.y = pk2(v[2], v[3]); w.z = pk2(v[4], v[5]); w.w = pk2(v[6], v[7]);
                        *(u32x4*)(mp + bj * HALF) = w; } }
                asm volatile("" ::: "memory");
            }
        }
    }
};

template <class Epi, class Sched>
__device__ __forceinline__ void gemm_phase(LAS unsigned char* lds, const int lda, const int ldb, const Sched& S, const Epi& E) {
    const int tid = fresh_tid(), wid = __builtin_amdgcn_readfirstlane(tid >> 6), lane = tid & 63, wr = wid >> 2, wc = wid & 3, fr = lane & 15, fq = lane >> 4;
    unsigned voffA[2], voffB[2];
#pragma unroll
    for (int i = 0; i < 2; ++i) { int R, C; stage_rc(tid * 16 + i * 8192, R, C); const int Rb = Epi::PERM ? ((R & ~31) + perm32(R & 31)) : R;
        voffA[i] = (unsigned)(R * lda + C) * 2u; voffB[i] = (unsigned)(Rb * ldb + C) * 2u; }
    const size_t kstep = (size_t)(BK * 2);
    const size_t hstepA = (size_t)HALF * lda * 2, hstepB = (size_t)HALF * ldb * 2;
    const unsigned ldsw = (unsigned)wid * 1024u;
    const int aoff = lds_byte(wr * 64 + fr, fq * 8), boff = lds_byte(wc * 32 + fr, fq * 8);
#define PG8_SA(b, h) (((b) * 2 + (h)) * HTB)
#define PG8_SB(b, h) ((4 + (b) * 2 + (h)) * HTB)
#define PG8_STAGE(bufoff, gbase, voff) do { _Pragma("unroll") for (int _i = 0; _i < 2; ++_i) \
        __builtin_amdgcn_global_load_lds((const unsigned*)((const char*)(gbase) + (voff)[_i]), (LAS unsigned*)(lds + (bufoff) + ldsw + _i * 8192), 16, 0, 0); } while (0)
#define PG8_LDA(dst, b, h) do { _Pragma("unroll") for (int m = 0; m < 4; ++m) _Pragma("unroll") for (int k = 0; k < 2; ++k) dst[m][k] = *(const LAS bf16x8*)(lds + PG8_SA(b, h) + aoff + m * 2048 + k * 1024); } while (0)
#define PG8_LDB(dst, b, h) do { _Pragma("unroll") for (int n = 0; n < 2; ++n) _Pragma("unroll") for (int k = 0; k < 2; ++k) dst[n][k] = *(const LAS bf16x8*)(lds + PG8_SB(b, h) + boff + n * 2048 + k * 1024); } while (0)
#define PG8_MMA(ai, bj, At, Bt) do { __builtin_amdgcn_s_setprio(1); _Pragma("unroll") for (int m = 0; m < 4; ++m) _Pragma("unroll") for (int n = 0; n < 2; ++n) _Pragma("unroll") for (int k = 0; k < 2; ++k) \
        acc[ai][bj][m][n] = __builtin_amdgcn_mfma_f32_16x16x32_bf16(Bt[n][k], At[m][k], acc[ai][bj][m][n], 0, 0, 0); __builtin_amdgcn_s_setprio(0); } while (0)
#define PG8_WAIT_V(n) asm volatile("s_waitcnt vmcnt(" #n ")" ::: "memory")
#define PG8_WAIT_L(n) asm volatile("s_waitcnt lgkmcnt(" #n ")" ::: "memory")
#define PG8_BAR __builtin_amdgcn_s_barrier()
#define PG8_SCHED __builtin_amdgcn_sched_barrier(0)
    Unit cur, nxt; int ui = 0;
    if (!S.next(0, cur)) return;
    f32x4 acc[2][2][4][2];
#pragma unroll
    for (int a = 0; a < 2; ++a)
#pragma unroll
        for (int b = 0; b < 2; ++b)
#pragma unroll
            for (int m = 0; m < 4; ++m)
#pragma unroll
                for (int n = 0; n < 2; ++n) acc[a][b][m][n] = (f32x4){0.f, 0.f, 0.f, 0.f};
    bf16x8 At[4][2], B0[2][2], B1[2][2];
    typename Epi::State est;
    const char* cA = cur.a; const char* cB = cur.b;
    PG8_STAGE(PG8_SB(0, 0), cB, voffB); PG8_STAGE(PG8_SB(0, 1), cB + hstepB, voffB); PG8_STAGE(PG8_SA(0, 0), cA, voffA); PG8_STAGE(PG8_SA(0, 1), cA + hstepA, voffA);
    if (wr == 1) PG8_BAR;
    PG8_WAIT_V(2); PG8_BAR;
    PG8_STAGE(PG8_SB(1, 0), cB + kstep, voffB); PG8_STAGE(PG8_SA(1, 0), cA + kstep, voffA); PG8_STAGE(PG8_SB(1, 1), cB + hstepB + kstep, voffB);
    PG8_WAIT_V(6); PG8_BAR;
    for (;;) {
        const bool has_next = S.next(ui + 1, nxt);
        const char* nA = has_next ? nxt.a : cA; const char* nB = has_next ? nxt.b : cB;
        const int nt = cur.nt;
        for (int t = 0; t < nt; t += 2) {
            const bool last = (t == nt - 2);
            const char* a1 = cA + (size_t)(t + 1) * kstep;
            const char* a2 = last ? nA : cA + (size_t)(t + 2) * kstep; const char* b2 = last ? nB : cB + (size_t)(t + 2) * kstep;
            const char* a3 = a2 + kstep; const char* b3 = b2 + kstep;
            PG8_LDB(B0, 0, 0); PG8_LDB(B1, 0, 1); PG8_SCHED; PG8_LDA(At, 0, 0); PG8_STAGE(PG8_SA(1, 1), a1 + hstepA, voffA);
            PG8_WAIT_V(8); PG8_WAIT_L(0); PG8_BAR; PG8_MMA(0, 0, At, B0); PG8_MMA(0, 1, At, B1); PG8_BAR; PG8_SCHED;
            PG8_LDA(At, 0, 1); PG8_STAGE(PG8_SB(0, 0), b2, voffB); PG8_STAGE(PG8_SB(0, 1), b2 + hstepB, voffB); PG8_STAGE(PG8_SA(0, 0), a2, voffA);
            PG8_WAIT_V(8); PG8_WAIT_L(0); PG8_BAR; PG8_MMA(1, 0, At, B0); PG8_MMA(1, 1, At, B1); PG8_BAR; PG8_SCHED;
            PG8_LDB(B0, 1, 0); PG8_LDB(B1, 1, 1); PG8_SCHED; PG8_LDA(At, 1, 0); PG8_STAGE(PG8_SA(0, 1), a2 + hstepA, voffA);
            PG8_WAIT_V(8); PG8_WAIT_L(0); PG8_BAR; PG8_MMA(0, 0, At, B0); PG8_MMA(0, 1, At, B1); PG8_BAR; PG8_SCHED;
            PG8_LDA(At, 1, 1); PG8_STAGE(PG8_SB(1, 0), b3, voffB); PG8_STAGE(PG8_SB(1, 1), b3 + hstepB, voffB); PG8_STAGE(PG8_SA(1, 0), a3, voffA);
            PG8_WAIT_V(8); PG8_WAIT_L(0); PG8_BAR; PG8_MMA(1, 0, At, B0); PG8_MMA(1, 1, At, B1); PG8_BAR; PG8_SCHED;
        }
        if (wr == 0) PG8_BAR;
        E(acc, est, cur, wr, wc, fr, fq);
        if (!has_next) break;
#pragma unroll
        for (int a = 0; a < 2; ++a)
#pragma unroll
            for (int b = 0; b < 2; ++b)
#pragma unroll
                for (int m = 0; m < 4; ++m)
#pragma unroll
                    for (int n = 0; n < 2; ++n) acc[a][b][m][n] = (f32x4){0.f, 0.f, 0.f, 0.f};
        cur = nxt; cA = nA; cB = nB; ++ui;
        if (wr == 1) PG8_BAR;
    }
    PG8_WAIT_V(0);
    PG8_BAR;
#undef PG8_SA
#undef PG8_SB
#undef PG8_STAGE
#undef PG8_LDA
#undef PG8_LDB
#undef PG8_MMA
#undef PG8_WAIT_V
#undef PG8_WAIT_L
#undef PG8_BAR
#undef PG8_SCHED
}
}

namespace att {
constexpr int VP = 144;
typedef short v4i16_t __attribute__((ext_vector_type(4)));
__device__ __forceinline__ int crow(int i, int h) { return (i & 3) + 8 * (i >> 2) + 4 * h; }
__device__ __forceinline__ s16x4 vtr(const LAS unsigned char* p) { return __builtin_bit_cast(s16x4, __builtin_amdgcn_ds_read_tr16_b64_v4i16((LAS v4i16_t*)p)); }
#define MFMA32(a, b, c) __builtin_amdgcn_mfma_f32_32x32x16_bf16((a), (b), (c), 0, 0, 0)

template <int MODE>
__device__ __forceinline__ void unit(int layer, int b, int h, int qb, LAS unsigned char* lds) {
    const cargs_t ap = get_args();
    unsigned char* const ws_ = ap->ws;
    constexpr int DK = MODE == 1 ? 96 : 64, ND = DK / 16, KP = DK * 2 + 16, KBUF = 64 * KP, VBUF = 64 * VP;
    LAS unsigned char* Ks = lds; LAS unsigned char* Vs = lds + 2 * KBUF;
    LAS float* Fs = (LAS float*)(lds + 2 * KBUF + 2 * VBUF); LAS float* Tab = Fs + 128;
    const int tid = fresh_tid(), lane = tid & 63, wid = __builtin_amdgcn_readfirstlane(tid >> 6), r = lane & 31, hh = lane >> 5;
    const size_t tok0 = (size_t)b * SEQ;
    const int qw = qb * 256 + wid * 32, qc = qw >> 6;
    const bf16_t* PROJ = (const bf16_t*)(ws_ + WS_PROJ); const bf16_t* QKVB = (const bf16_t*)(ws_ + WS_QKVB); const bf16_t* KROT = (const bf16_t*)(ws_ + WS_KROT);
    const float* FCUM = (const float*)(ws_ + WS_FCUM) + (size_t)(b * 4 + h) * SEQ;
    bf16_t* BR = (bf16_t*)(ws_ + WS_BR);
    const bf16_t *Qp, *Kp, *Vp; int ldq, ldk;
    if (MODE == 0) { Qp = PROJ + C_AQ + h * 64; Kp = PROJ + C_AK + h * 64; Vp = PROJ + C_AV + h * 64; ldq = PLD; ldk = PLD; }
    else if (MODE == 2) { Qp = PROJ + C_CQ + h * 64; Kp = PROJ + C_CK + h * 64; Vp = PROJ + C_CV + h * 64; ldq = PLD; ldk = PLD; }
    else { Qp = QKVB + h * 96; Kp = QKVB + 512 + h * 128; Vp = Kp + 64; ldq = 1024; ldk = 1024; }
    const int t_lo = (MODE == 0) ? (qb * 4 - 8 > 0 ? qb * 4 - 8 : 0) : 0, t_hi = qb * 4 + 4;
    const float cs = (MODE == 1 ? 0.10206207261596577f : 0.125f) * LOG2E;

    u32x4 kregA, vregA, kr2A, kregB, vregB, kr2B; float fregA = 0.f, fregB = 0.f;
    const int srow = tid >> 3, sch = tid & 7;
#define ATT_LOAD(j, X) do { const int jl_ = (j) < t_lo ? t_lo : (j); const size_t trow = tok0 + (size_t)jl_ * 64; \
        kreg##X = *(const u32x4*)(Kp + (trow + srow) * ldk + sch * 8); vreg##X = *(const u32x4*)(Vp + (trow + srow) * ldk + sch * 8); \
        if (MODE == 1) { kr2##X = *(const u32x4*)(KROT + (trow + ((tid >> 2) & 63)) * 32 + (tid & 3) * 8); } \
        if (MODE == 2) { freg##X = FCUM[jl_ * 64 + (tid & 63)]; } } while (0)
#define ATT_STORE(s, X) do { *(LAS u32x4*)(Ks + (s) * KBUF + srow * KP + sch * 16) = kreg##X; *(LAS u32x4*)(Vs + (s) * VBUF + srow * VP + sch * 16) = vreg##X; \
        if (MODE == 1) { if (tid < 256) *(LAS u32x4*)(Ks + (s) * KBUF + (tid >> 2) * KP + 128 + (tid & 3) * 16) = kr2##X; } \
        if (MODE == 2) { if (tid < 64) Fs[(s) * 64 + tid] = freg##X * LOG2E; } } while (0)

    ATT_LOAD(t_hi - 1, A);
    ATT_LOAD(t_hi - 2, B);
    if (MODE == 0) { if (tid < 257) Tab[tid] = ap->rel_bias[(size_t)(layer * 4 + h) * 257 + tid] * LOG2E; }
    bf16x8 qf[ND];
    { const bf16_t* qrow = Qp + (tok0 + qw + r) * ldq;
#pragma unroll
      for (int d0 = 0; d0 < ND; ++d0) qf[d0] = *(const bf16x8*)(qrow + d0 * 16 + hh * 8); }
    if (MODE == 1) {
        const float pos = (float)ap->pos[tok0 + qw + r];
#pragma unroll
        for (int j = 0; j < 8; ++j) {
            const float invf = exp2f(-(float)(8 * hh + j) * 0.8304820237218406f);
            const float ang = pos * invf, kk = rintf(ang * 0.15915494309189535f);
            float rem = fmaf(-kk, 6.2831854820251465f, ang); rem = fmaf(kk, 1.7484555e-7f, rem);
            const float sn = __sinf(rem), cn = __cosf(rem);
            const float x1 = bf2f((unsigned short)qf[4][j]), x2 = bf2f((unsigned short)qf[5][j]);
            const unsigned w = pk2(x1 * cn - x2 * sn, x2 * cn + x1 * sn);
            qf[4][j] = (short)(w & 0xffffu); qf[5][j] = (short)(w >> 16);
        }
    }
    float fq = 0.f;
    if (MODE == 2) fq = FCUM[qw + r] * LOG2E;
    float m_run = -INFINITY, l_run = 0.f;
    float ub = 0.f; LAS int* wv = (LAS int*)(lds + 131072 + 768);
    if (MODE == 2) {
        float q2 = 0.f;
#pragma unroll
        for (int d0 = 0; d0 < 4; ++d0)
#pragma unroll
            for (int e = 0; e < 8; ++e) { const float x = bf2f((unsigned short)qf[d0][e]); q2 = fmaf(x, x, q2); }
        { auto rr = __builtin_amdgcn_permlane32_swap(__float_as_uint(q2), __float_as_uint(q2), false, false); q2 = __uint_as_float(rr[0]) + __uint_as_float(rr[1]); }
        const unsigned kbits = ((const unsigned*)(ws_ + WS_CTL))[1024 + b * 4 + h];
        ub = sqrtf(q2) * sqrtf(__uint_as_float(kbits)) * cs * 1.0001f + 0.01f;
    }
    f32x16 o0, o1;
#pragma unroll
    for (int i = 0; i < 16; ++i) { o0[i] = 0.f; o1[i] = 0.f; }
    ATT_STORE(0, A);
    __syncthreads();
    const int i16 = lane & 15, vq = i16 >> 2, vp = i16 & 3, vblk = (lane >> 4) & 1;
    const int voff = (4 * hh + vq) * VP + vblk * 32 + vp * 8;

    auto compute = [&](const int j, const int s) __attribute__((always_inline)) {
        const bool active = (MODE == 0) ? (j <= qc && j >= qc - 8) : (j <= qc);
        if (active) {
            const LAS unsigned char* kb = Ks + s * KBUF + r * KP + hh * 16;
            f32x16 p0, p1;
#pragma unroll
            for (int i = 0; i < 16; ++i) { p0[i] = 0.f; p1[i] = 0.f; }
#pragma unroll
            for (int d0 = 0; d0 < ND; ++d0) {
                const bf16x8 kf0 = *(const LAS bf16x8*)(kb + d0 * 32), kf1 = *(const LAS bf16x8*)(kb + 32 * KP + d0 * 32);
                p0 = MFMA32(kf0, qf[d0], p0); p1 = MFMA32(kf1, qf[d0], p1);
            }
            if (MODE == 0) {
                const int delta = qc - j;
                if (delta >= 3) { const float cb = Tab[256];
#pragma unroll
                    for (int i = 0; i < 16; ++i) { p0[i] = fmaf(p0[i], cs, cb); p1[i] = fmaf(p1[i], cs, cb); }
                } else { const int brel = 64 * delta + (qw & 63) + r + 128;
#pragma unroll
                    for (int i = 0; i < 16; ++i) { const int kj = crow(i, hh); int i0 = brel - kj, i1 = brel - kj - 32;
                        i0 = i0 < 0 ? 0 : (i0 > 256 ? 256 : i0); i1 = i1 < 0 ? 0 : (i1 > 256 ? 256 : i1);
                        p0[i] = fmaf(p0[i], cs, Tab[i0]); p1[i] = fmaf(p1[i], cs, Tab[i1]); }
                }
            } else if (MODE == 1) {
            } else {
                const LAS float* fs = Fs + s * 64 + 4 * hh;
#pragma unroll
                for (int g = 0; g < 4; ++g) { const f32x4 f0 = *(const LAS f32x4*)(fs + 8 * g), f1 = *(const LAS f32x4*)(fs + 32 + 8 * g);
#pragma unroll
                    for (int e = 0; e < 4; ++e) { p0[4 * g + e] = fmaf(p0[4 * g + e], cs, fq - f0[e]); p1[4 * g + e] = fmaf(p1[4 * g + e], cs, fq - f1[e]); } }
                if (j == qc) { const int qrel = (qw & 63) + r;
#pragma unroll
                    for (int i = 0; i < 16; ++i) { const int kj = crow(i, hh); if (kj > qrel) p0[i] = -INFINITY; if (kj + 32 > qrel) p1[i] = -INFINITY; } }
            }
            float mx = p0[0];
#pragma unroll
            for (int i = 1; i < 16; ++i) mx = fmaxf(mx, p0[i]);
#pragma unroll
            for (int i = 0; i < 16; ++i) mx = fmaxf(mx, p1[i]);
            { auto rr = __builtin_amdgcn_permlane32_swap(__float_as_uint(mx), __float_as_uint(mx), false, false); mx = fmaxf(__uint_as_float(rr[0]), __uint_as_float(rr[1])); }
            if (MODE == 1) mx *= cs;
            if (__all(mx < m_run - 40.f)) return;
            if (__any(mx > m_run)) {
                const float m_new = fmaxf(m_run, mx);
                const float alpha = __builtin_amdgcn_exp2f(m_run - m_new);
                m_run = m_new; l_run *= alpha;
#pragma unroll
                for (int i = 0; i < 16; ++i) { o0[i] *= alpha; o1[i] *= alpha; }
            }
            float sum = 0.f;
#pragma unroll
            for (int i = 0; i < 16; ++i) { p0[i] = __builtin_amdgcn_exp2f(MODE == 1 ? fmaf(p0[i], cs, -m_run) : p0[i] - m_run); p1[i] = __builtin_amdgcn_exp2f(MODE == 1 ? fmaf(p1[i], cs, -m_run) : p1[i] - m_run); sum += p0[i] + p1[i]; }
            l_run += sum;
            const LAS unsigned char* vb = Vs + s * VBUF + voff;
#pragma unroll
            for (int kbk = 0; kbk < 2; ++kbk)
#pragma unroll
                for (int st = 0; st < 2; ++st) {
                    const f32x16& pp = kbk ? p1 : p0;
                    u32x4 pw; pw.x = pk2(pp[8 * st + 0], pp[8 * st + 1]); pw.y = pk2(pp[8 * st + 2], pp[8 * st + 3]); pw.z = pk2(pp[8 * st + 4], pp[8 * st + 5]); pw.w = pk2(pp[8 * st + 6], pp[8 * st + 7]);
                    const bf16x8 pf = __builtin_bit_cast(bf16x8, pw);
                    const LAS unsigned char* vr = vb + (32 * kbk + 16 * st) * VP;
                    const s16x4 a_lo = vtr(vr), a_hi = vtr(vr + 8 * VP), b_lo = vtr(vr + 64), b_hi = vtr(vr + 8 * VP + 64);
                    const bf16x8 v0 = __builtin_shufflevector(a_lo, a_hi, 0, 1, 2, 3, 4, 5, 6, 7), v1 = __builtin_shufflevector(b_lo, b_hi, 0, 1, 2, 3, 4, 5, 6, 7);
                    o0 = MFMA32(v0, pf, o0); o1 = MFMA32(v1, pf, o1);
                }
        }
    };
    for (int j = t_hi - 1; j >= t_lo; j -= 2) {
        ATT_LOAD(j - 2, A);
        compute(j, 0);
        if (MODE == 2) { const int vote = (j <= qc) ? (int)__all(ub + fq - Fs[0] < m_run - 40.f) : 0; if (lane == 0) wv[wid] = vote; }
        ATT_STORE(1, B);
        __syncthreads();
        if (MODE == 2) { int all = 1;
#pragma unroll
            for (int w = 0; w < 8; ++w) all &= wv[w];
            if (all) break; }
        ATT_LOAD(j - 3, B);
        compute(j - 1, 1);
        if (MODE == 2) { const int vote = (j - 1 <= qc) ? (int)__all(ub + fq - Fs[64] < m_run - 40.f) : 0; if (lane == 0) wv[8 + wid] = vote; }
        ATT_STORE(0, A);
        __syncthreads();
        if (MODE == 2) { int all = 1;
#pragma unroll
            for (int w = 0; w < 8; ++w) all &= wv[8 + w];
            if (all) break; }
    }
    const float l_tot = l_run + __shfl_xor(l_run, 32);
    const float inv = 1.0f / l_tot;
    bf16_t* dst = BR + (tok0 + qw + r) * 1024 + (MODE == 0 ? 0 : (MODE == 1 ? 256 : 512)) + h * 64 + 4 * hh;
#pragma unroll
    for (int g = 0; g < 4; ++g) {
        u32x2 w0, w1;
        w0.x = pk2(o0[4 * g] * inv, o0[4 * g + 1] * inv); w0.y = pk2(o0[4 * g + 2] * inv, o0[4 * g + 3] * inv);
        w1.x = pk2(o1[4 * g] * inv, o1[4 * g + 1] * inv); w1.y = pk2(o1[4 * g + 2] * inv, o1[4 * g + 3] * inv);
        *(u32x2*)(dst + 8 * g) = w0; *(u32x2*)(dst + 32 + 8 * g) = w1;
    }
#undef ATT_LOAD
#undef ATT_STORE
}
}

__device__ __forceinline__ void transpose_item(const float* W, int N, int nblk, bf16_t* WT, int ldt, LAS float* scr, int item, int lane, const float* gk = nullptr) {
    const int kb = item / nblk, nb = item % nblk, k0 = 64 * kb, n0 = 32 * nb;
    const int nn = n0 + (lane & 31); const bool ok = nn < N;
    float tmp[32];
#pragma unroll
    for (int i = 0; i < 32; ++i) { const int kk = 2 * i + (lane >> 5); tmp[i] = ok ? W[(size_t)(k0 + kk) * N + nn] : 0.f; }
#pragma unroll
    for (int i = 0; i < 32; ++i) { const int kk = 2 * i + (lane >> 5); scr[kk * 33 + (lane & 31)] = tmp[i]; }
    LDS_WAIT(); asm volatile("" ::: "memory");
    const int c = lane & 7;
    f32x4 ga = {1.f, 1.f, 1.f, 1.f}, gb = ga;
    if (gk) { ga = *(const f32x4*)(gk + k0 + 8 * c); gb = *(const f32x4*)(gk + k0 + 8 * c + 4); }
#pragma unroll
    for (int j = 0; j < 4; ++j) { const int n = (lane >> 3) + 8 * j; const LAS float* s = scr + (8 * c) * 33 + n;
        u32x4 o; o.x = pk2(s[0 * 33] * ga.x, s[1 * 33] * ga.y); o.y = pk2(s[2 * 33] * ga.z, s[3 * 33] * ga.w); o.z = pk2(s[4 * 33] * gb.x, s[5 * 33] * gb.y); o.w = pk2(s[6 * 33] * gb.z, s[7 * 33] * gb.w);
        *(u32x4*)(WT + (size_t)(n0 + n) * ldt + k0 + 8 * c) = o; }
    LDS_WAIT(); asm volatile("" ::: "memory");
}
__device__ __forceinline__ void prenorm_row(const float* xrow, bf16_t* orow, float* rowss, int lane) {
    const f32x4* xr = (const f32x4*)xrow + lane;
    f32x4 v[4]; float s = 0.f;
#pragma unroll
    for (int j = 0; j < 4; ++j) { v[j] = xr[64 * j]; s += (v[j].x * v[j].x + v[j].y * v[j].y) + (v[j].z * v[j].z + v[j].w * v[j].w); }
    s = wave_sum(s); if (lane < 16) rowss[lane] = (lane == 0) ? s : 0.f;
#pragma unroll
    for (int j = 0; j < 4; ++j) { u32x2 w; w.x = pk2(v[j].x, v[j].y); w.y = pk2(v[j].z, v[j].w); ((u32x2*)orow)[lane + 64 * j] = w; }
}
__device__ __forceinline__ float logsig(float z) { return fminf(z, 0.f) - __logf(1.0f + __expf(-fabsf(z))); }


constexpr int I_G = 16 * 128, I_B = 4 * 32, I_O = 16 * 32, I_U = 16 * 128, I_D = 64 * 32, N_LATE_ITEMS = I_G + 4 * I_B + I_O + I_U + I_D;
__device__ __forceinline__ void late_weight_item(int l, int r, LAS float* scr, int lane) {
    const cargs_t ap = get_args(); unsigned char* const ws = ap->ws;
    if (r < I_G) { transpose_item(ap->w_gate + (size_t)l * 1024 * 4096, 4096, 128, (bf16_t*)(ws + WS_WGT), 1024, scr, r, lane, ap->g_mix + l * 1024); return; } r -= I_G;
    if (r < 4 * I_B) { const int n = r / I_B; transpose_item(ap->w_branch + (size_t)l * 4 * 256 * 1024 + (size_t)n * 256 * 1024, 1024, 32, (bf16_t*)(ws + WS_WBT) + (size_t)n * 1024 * 1024 + n * 256, 1024, scr, r % I_B, lane); return; } r -= 4 * I_B;
    if (r < I_O) { transpose_item(ap->w_o + (size_t)l * 1024 * 1024, 1024, 32, (bf16_t*)(ws + WS_WOT), 1024, scr, r, lane); return; } r -= I_O;
    if (r < I_U) { transpose_item(ap->w_up + (size_t)l * 1024 * 4096, 4096, 128, (bf16_t*)(ws + WS_W1T), 1024, scr, r, lane, ap->g_ffn + l * 1024); return; } r -= I_U;
    transpose_item(ap->w_down + (size_t)l * 4096 * 1024, 1024, 32, (bf16_t*)(ws + WS_W2T), 4096, scr, r, lane);
}
__device__ __forceinline__ void conv_tokens(int l, int t0, int lane) {
    const cargs_t ap = get_args(); unsigned char* const ws = ap->ws;
    const bf16_t* U = (const bf16_t*)(ws + WS_U); bf16_t* BR = (bf16_t*)(ws + WS_BR);
    const float* wdw = ap->w_dw + (size_t)l * 31 * 256; const f32x4 bdw = *(const f32x4*)(ap->b_dw + l * 256 + 4 * lane);
    const f32x4 gln = *(const f32x4*)(ap->g_conv_ln + l * 256 + 4 * lane), bln = *(const f32x4*)(ap->b_conv_ln + l * 256 + 4 * lane);
    const int ts0 = t0 & (SEQ - 1);
    const float* wl = wdw + 4 * lane; asm volatile("" : "+v"(wl));
    u32x2 ur[38];
#pragma unroll
    for (int i = 0; i < 38; ++i) { const int tt = ts0 - 30 + i; ur[i] = (u32x2){0u, 0u}; if (tt >= 0) ur[i] = *(const u32x2*)(U + (size_t)(t0 - 30 + i) * 256 + 4 * lane); }
    f32x4 acc[8];
#pragma unroll
    for (int j = 0; j < 8; ++j) acc[j] = bdw;
#pragma unroll
    for (int k = 0; k < 31; ++k) { const f32x4 w = *(const f32x4*)(wl + k * 256);
#pragma unroll
        for (int j = 0; j < 8; ++j) { const u32x2 u = ur[j + k];
            acc[j].x = fmaf(lo_f(u.x), w.x, acc[j].x); acc[j].y = fmaf(hi_f(u.x), w.y, acc[j].y); acc[j].z = fmaf(lo_f(u.y), w.z, acc[j].z); acc[j].w = fmaf(hi_f(u.y), w.w, acc[j].w); } }
#pragma unroll
    for (int j = 0; j < 8; ++j) {
        const float mean = wave_sum((acc[j].x + acc[j].y) + (acc[j].z + acc[j].w)) * (1.0f / 256.0f);
        const f32x4 d = acc[j] - mean;
        const float rstd = 1.0f / sqrtf(wave_sum((d.x * d.x + d.y * d.y) + (d.z * d.z + d.w * d.w)) * (1.0f / 256.0f) + EPS);
        const f32x4 y = d * rstd * gln + bln;
        u32x2 o; o.x = pk2(y.x * sigmoidf_(y.x), y.y * sigmoidf_(y.y)); o.y = pk2(y.z * sigmoidf_(y.z), y.w * sigmoidf_(y.w));
        *(u32x2*)(BR + (size_t)(t0 + j) * 1024 + 768 + 4 * lane) = o;
    }
}

__device__ __forceinline__ void win_item(int l, int r, LAS float* scr, int lane) {
    const cargs_t ap = get_args();
    transpose_item(ap->w_in + (size_t)l * 1024 * INC, INC, 80, (bf16_t*)(ap->ws + (l == 0 ? WS_WINT : WS_WINT1)), 1024, scr, r, lane, ap->g_mix + l * 1024);
}
__device__ __forceinline__ void wlat_chunk(int l, int c) {
    const cargs_t ap = get_args();
    const float* w_uq = ap->w_uq + (size_t)l * 256 * 384; const float* w_ukv = ap->w_ukv + (size_t)l * 128 * 512; const float* gq = ap->g_q_lat + l * 256; const float* gkv = ap->g_kv_lat + l * 128;
    const int n = c / 48, k0 = (c % 48) * 8; float v[8];
#pragma unroll
    for (int e = 0; e < 8; ++e) { const int k = k0 + e; v[e] = (n < 384 && k < 256) ? gq[k] * w_uq[(size_t)k * 384 + n] : ((n >= 512 && k >= 256) ? gkv[k - 256] * w_ukv[(size_t)(k - 256) * 512 + (n - 512)] : 0.f); }
    u32x4 o; o.x = pk2(v[0], v[1]); o.y = pk2(v[2], v[3]); o.z = pk2(v[4], v[5]); o.w = pk2(v[6], v[7]);
    *(u32x4*)((bf16_t*)(ap->ws + (l == 0 ? WS_WLT : WS_WLT1)) + (size_t)n * 384 + k0) = o;
}

#define XB_TMO      128
#define XB_XCNT(j)  (256  + 64 * (j))
#define XB_XSUB(j)  (1280 + 64 * (j))
#define XB_XGEN(j)  (2304 + 64 * (j))
#define XB_TOP      3328
#define XB_TOPGEN   3392
#define XCD_BAR_WORDS 3456
#define XB_SPIN_CAP (1u << 18)
__device__ __forceinline__ unsigned xb_ld(unsigned* p)              { return __hip_atomic_load(p, __ATOMIC_RELAXED, __HIP_MEMORY_SCOPE_AGENT); }
__device__ __forceinline__ unsigned xb_add(unsigned* p, unsigned v) { return __hip_atomic_fetch_add(p, v, __ATOMIC_RELAXED, __HIP_MEMORY_SCOPE_AGENT); }
__device__ __forceinline__ unsigned xb_xcc_id() { return (unsigned)__builtin_amdgcn_s_getreg((3 << 11) | 20) & 0xFu; }
#define XB_SPIN(cond, bar) do { unsigned _sp = 0; while (cond) { __builtin_amdgcn_s_sleep(1); \
    if ((++_sp & 255u) == 0u) { if (xb_ld(&(bar)[XB_TMO])) break; if (_sp > XB_SPIN_CAP) { atomicAdd(&(bar)[XB_TMO], 1u); break; } } } } while (0)
struct XcdBarrier { unsigned* bar; unsigned x; volatile LAS unsigned* st; };
__device__ __forceinline__ void xcd_barrier_complete(unsigned* bar, unsigned x, unsigned& nloc, unsigned& nx) {
    const unsigned G = gridDim.x * gridDim.y * gridDim.z;
    unsigned sum, cnt, mine, sp = 0u;
    for (;;) {
        sum = 0u; cnt = 0u; mine = 0u;
#pragma unroll
        for (unsigned j = 0; j < 16; ++j) { const unsigned c = xb_ld(&bar[XB_XCNT(j)]); sum += c; cnt += (c > 0u) ? 1u : 0u; mine = (j == x) ? c : mine; }
        if (sum == G) break;
        __builtin_amdgcn_s_sleep(1);
        if ((++sp & 255u) == 0u) { if (xb_ld(&bar[XB_TMO])) break; if (sp > XB_SPIN_CAP) { atomicAdd(&bar[XB_TMO], 1u); break; } }
    }
    nloc = mine > 0u ? mine : 1u; nx = cnt > 0u ? cnt : 1u;
}
__device__ __forceinline__ void xcd_barrier(const XcdBarrier& b) {
    asm volatile("s_waitcnt vmcnt(0)" ::: "memory");
    __syncthreads();
    if (threadIdx.x == 0) {
        unsigned* bar = b.bar;
        __builtin_amdgcn_s_waitcnt(0);
        unsigned nloc = b.st[0], nx = b.st[1];
        if (nloc == 0u) { xcd_barrier_complete(bar, b.x, nloc, nx); b.st[0] = nloc; b.st[1] = nx; }
        const unsigned old = xb_add(&bar[XB_XSUB(b.x)], 1u);
        const unsigned gen = old / nloc;
        if (old + 1u == (gen + 1u) * nloc) {
            __builtin_amdgcn_fence(__ATOMIC_RELEASE, "agent");
            asm volatile("s_waitcnt vmcnt(0)" ::: "memory");
            const unsigned og = xb_add(&bar[XB_TOP], 1u);
            const unsigned tg = og / nx;
            if (og + 1u == (tg + 1u) * nx) xb_add(&bar[XB_TOPGEN], 1u);
            else XB_SPIN(xb_ld(&bar[XB_TOPGEN]) == tg, bar);
            __builtin_amdgcn_fence(__ATOMIC_ACQUIRE, "agent");
            xb_add(&bar[XB_XGEN(b.x)], 1u);
            asm volatile("s_waitcnt vmcnt(0)" ::: "memory");
        } else {
            XB_SPIN(xb_ld(&bar[XB_XGEN(b.x)]) == gen, bar);
            __builtin_amdgcn_fence(__ATOMIC_ACQUIRE, "agent");
            asm volatile("s_waitcnt vmcnt(0)" ::: "memory");
        }
    }
    __syncthreads();
}
constexpr int CTL_BAR_WORD = 4096;
constexpr int LDS_MISC = 131072 + 128;
#define GRID_BAR() do { const cargs_t ap_ = get_args(); XcdBarrier b_; b_.bar = (unsigned*)(ap_->ws + WS_CTL) + CTL_BAR_WORD; b_.x = xb_xcc_id(); \
    b_.st = (volatile LAS unsigned*)(lds + LDS_MISC); xcd_barrier(b_); } while (0)

#define WSP(T, off) ((T*)(ws + (off)))
#define REP_P1 1
#define REP_P2 1
#define REP_P3 1
#define REP_P4 1
#define REP_P5 1
#define REP_P6 1
#define REP_P7 1
#define REP_P8 1
#define REP_P9 1
#define REP_P10 1
#define REP_SYNC 0
#define PHASE_BEGIN(R) _Pragma("unroll 1") for (int rep = 0; rep < (R); ++rep) {
#define PHASE_END GRID_BAR(); }
__global__ void __launch_bounds__(512, 2) fwd_megakernel(Args A_unused) {
    extern __shared__ __attribute__((aligned(16))) unsigned char lds_raw[];
    LAS unsigned char* lds = (LAS unsigned char*)lds_raw;
    {
        if (threadIdx.x < 8) ((LAS unsigned*)(lds + LDS_MISC))[threadIdx.x] = 0u;
        __syncthreads();
        const cargs_t ap = get_args();
        if (threadIdx.x == 0) (void)xb_add((unsigned*)(ap->ws + WS_CTL) + CTL_BAR_WORD + XB_XCNT(xb_xcc_id()), 1u);
    }
    cg::this_grid().sync();

#pragma unroll 1
    for (int l = 0; l < 2; ++l) {
        if (l == 0) {
        PHASE_BEGIN(REP_P1)
            const cargs_t ap = get_args(); unsigned char* const ws = ap->ws;
            const int tid = fresh_tid(), lane = tid & 63, wid = __builtin_amdgcn_readfirstlane(tid >> 6), G = gridDim.x, bx = blockIdx.x, gw = bx * 8 + wid, NGW = G * 8;
            LAS float* scr = (LAS float*)(lds + wid * 16384);
            for (int it = gw; it < 1280; it += NGW) win_item(0, it, scr, lane);
            for (int c = bx * 512 + tid; c < 1024 * 48; c += G * 512) wlat_chunk(0, c);
            const float* xin = ap->x; bf16_t* XN = WSP(bf16_t, WS_XN); float* rss = WSP(float, WS_ROWSS);
            for (int m = gw; m < TOK; m += NGW) prenorm_row(xin + (size_t)m * 1024, XN + (size_t)m * 1024, rss + (size_t)m * 16, lane);
        GRID_BAR(); }
        }
        PHASE_BEGIN(REP_P2)
            const cargs_t ap = get_args(); unsigned char* const ws = ap->ws;
            const char* hin = (l == 0) ? WSP(const char, WS_XN) : (const char*)ap->out;
            pg8::PlainOrder S{hin, (l == 0) ? WSP(const char, WS_WINT) : WSP(const char, WS_WINT1), 1024, 1024, 64, 10, 16, (int)gridDim.x, (int)blockIdx.x};
            const float* slots = WSP(const float, WS_ROWSS) + (size_t)(l * 2) * ROWSS_STRIDE;
            pg8::Unit u0; int pm0 = -1; if (S.next(0, u0)) { pm0 = u0.pm; fill_rinv_table(lds, slots, pm0); }
            pg8::EpiBf16<0, 1, true> E{WSP(bf16_t, WS_PROJ), PLD, slots, pm0, (unsigned)(uintptr_t)(lds + LDS_RINV), WSP(float, WS_LATSS)};
            pg8::gemm_phase(lds, 1024, 1024, S, E);
        PHASE_END
        PHASE_BEGIN(REP_P3)
            const cargs_t ap = get_args(); unsigned char* const ws = ap->ws;
            const int tid = fresh_tid(), lane = tid & 63, wid = __builtin_amdgcn_readfirstlane(tid >> 6), G = gridDim.x, bx = blockIdx.x, gw = bx * 8 + wid, NGW = G * 8;
            const bf16_t* PROJ = WSP(const bf16_t, WS_PROJ);
            if (bx < 16) {
                const int b = bx >> 2, h = bx & 3; const float bf = ap->b_forget[l * 4 + h];
                const bf16_t* src = PROJ + ((size_t)b * SEQ + tid * 8) * PLD + C_CF + h;
                float v[8];
#pragma unroll
                for (int i = 0; i < 8; ++i) v[i] = bf2f(src[(size_t)i * PLD]);
#pragma unroll
                for (int i = 0; i < 8; ++i) { v[i] = logsig(v[i] + bf); if (i) v[i] += v[i - 1]; }
                float incl = v[7];
#pragma unroll
                for (int o = 1; o < 64; o <<= 1) { const float u = __shfl_up(incl, o); if (lane >= o) incl += u; }
                LAS float* wtot = (LAS float*)(lds + 131072 + 64);
                if (lane == 63) wtot[wid] = incl;
                __syncthreads();
                float off = incl - v[7];
                for (int w = 0; w < wid; ++w) off += wtot[w];
                float* dst = WSP(float, WS_FCUM) + (size_t)(b * 4 + h) * SEQ + tid * 8;
                f32x4 o0 = {v[0] + off, v[1] + off, v[2] + off, v[3] + off}, o1 = {v[4] + off, v[5] + off, v[6] + off, v[7] + off};
                *(f32x4*)dst = o0; *(f32x4*)(dst + 4) = o1;
            }
            const int* posp = ap->pos;
            bf16_t* KROT = WSP(bf16_t, WS_KROT); bf16_t* U = WSP(bf16_t, WS_U);
            const float invf = exp2f(-(float)(lane & 15) * 0.8304820237218406f);
            const bool kx = (gridDim.x == 256); unsigned* KMAXp = (unsigned*)(ws + WS_CTL) + 1024; LAS float* kred = (LAS float*)(lds + 131072 + 512); int kiter = 0;
            if (!kx && bx == 0 && tid < 16) atomicMax(KMAXp + tid, 0x7f7fffffu);
            for (int t0 = gw * 4; t0 < TOK; t0 += NGW * 4) {
                u32x2 dv4[4], dg4[4], ck4[4]; float x14[4], x24[4], pos4[4];
#pragma unroll
                for (int j = 0; j < 4; ++j) { const bf16_t* row = PROJ + (size_t)(t0 + j) * PLD;
                    dv4[j] = *(const u32x2*)(row + C_DV + 4 * lane); dg4[j] = *(const u32x2*)(row + C_DG + 4 * lane); ck4[j] = *(const u32x2*)(row + C_CK + 4 * lane);
                    x14[j] = bf2f(row[C_BKR + (lane & 15)]); x24[j] = bf2f(row[C_BKR + 16 + (lane & 15)]); pos4[j] = (float)posp[t0 + j]; }
#pragma unroll
                for (int j = 0; j < 4; ++j) { const int t = t0 + j;
                    if (lane < 16) {
                        const float ang = pos4[j] * invf, kk = rintf(ang * 0.15915494309189535f);
                        float rem = fmaf(-kk, 6.2831854820251465f, ang); rem = fmaf(kk, 1.7484555e-7f, rem);
                        const float sn = __sinf(rem), cn = __cosf(rem);
                        const unsigned w = pk2(x14[j] * cn - x24[j] * sn, x24[j] * cn + x14[j] * sn);
                        KROT[(size_t)t * 32 + lane] = (bf16_t)(w & 0xffffu); KROT[(size_t)t * 32 + 16 + lane] = (bf16_t)(w >> 16);
                    }
                    {
                        const u32x2 v = dv4[j], gt = dg4[j];
                        u32x2 o; o.x = pk2(lo_f(v.x) * sigmoidf_(lo_f(gt.x)), hi_f(v.x) * sigmoidf_(hi_f(gt.x))); o.y = pk2(lo_f(v.y) * sigmoidf_(lo_f(gt.y)), hi_f(v.y) * sigmoidf_(hi_f(gt.y)));
                        *(u32x2*)(U + (size_t)t * 256 + 4 * lane) = o;
                    }
                }
                if (kx) {
                    float km = 0.f;
#pragma unroll
                    for (int j = 0; j < 4; ++j) { const float a0 = lo_f(ck4[j].x), a1 = hi_f(ck4[j].x), a2 = lo_f(ck4[j].y), a3 = hi_f(ck4[j].y); float q = (a0 * a0 + a1 * a1) + (a2 * a2 + a3 * a3);
                        q += __shfl_xor(q, 1); q += __shfl_xor(q, 2); q += __shfl_xor(q, 4); q += __shfl_xor(q, 8); km = fmaxf(km, q); }
                    const int par = kiter & 1; ++kiter;
                    if ((lane & 15) == 0) kred[par * 32 + wid * 4 + (lane >> 4)] = km;
                    __syncthreads();
                    if (tid < 4) { float m = kred[par * 32 + tid];
#pragma unroll
                        for (int w = 1; w < 8; ++w) m = fmaxf(m, kred[par * 32 + w * 4 + tid]);
                        atomicMax(KMAXp + (t0 >> 12) * 4 + tid, __float_as_uint(m)); }
                }
            }
            { const cargs_t ap2 = get_args(); unsigned char* const ws = ap2->ws;
              pg8::PlainOrder S{WSP(const char, WS_PROJ) + C_BQL * 2, (l == 0) ? WSP(const char, WS_WLT) : WSP(const char, WS_WLT1), PLD, 384, 64, 4, 6, (int)gridDim.x, (int)blockIdx.x};
              pg8::EpiBf16<0, 2> E{WSP(bf16_t, WS_QKVB), 1024, nullptr, -1, 0u, WSP(float, WS_LATSS)};
              pg8::gemm_phase(lds, PLD, 384, S, E); }
        PHASE_END
        PHASE_BEGIN(REP_P5)
            LAS int* wq = (LAS int*)(lds + 131072);
            for (;;) {
                __syncthreads();
                if (threadIdx.x == 0) { const cargs_t ap = get_args(); wq[0] = atomicAdd((int*)(ap->ws + WS_CTL) + 16 * (l * 8 + rep), 1); }
                __syncthreads();
                const int it = wq[0];
                if (it >= 768 + 256 + N_LATE_ITEMS / 16 + (l == 0 ? 80 + 96 : 0)) break;
                if (it >= 768) {
                    const int tidq = fresh_tid(), laneq = tidq & 63, widq = __builtin_amdgcn_readfirstlane(tidq >> 6);
                    if (it < 1024) conv_tokens(l, ((it - 768) * 8 + widq) * 8, laneq);
                    else if (it >= 1024 + N_LATE_ITEMS / 16) {
                        const int e = it - (1024 + N_LATE_ITEMS / 16);
                        if (e < 80) { LAS float* scr = (LAS float*)(lds + widq * 16384); win_item(l + 1, e * 16 + widq * 2, scr, laneq); win_item(l + 1, e * 16 + widq * 2 + 1, scr, laneq); }
                        else wlat_chunk(l + 1, (e - 80) * 512 + tidq);
                    }
                    else { LAS float* scr = (LAS float*)(lds + widq * 16384); const int r0 = (it - 1024) * 16 + widq * 2; late_weight_item(l, r0, scr, laneq); late_weight_item(l, r0 + 1, scr, laneq); }
                    continue;
                }
                int mode, bh, qb;
                if (it >= 384 && it < 640) { const int a = it - 384; mode = 0; bh = a & 15; qb = a >> 4; }
                else { const int k = it < 384 ? it : it - 256; const int lvl = k >> 5, w = k & 31; qb = 15 - lvl; mode = (w < 16) ? 1 : 2; bh = w & 15; }
                if (mode == 0) att::unit<0>(l, bh >> 2, bh & 3, qb, lds);
                else if (mode == 1) att::unit<1>(l, bh >> 2, bh & 3, qb, lds);
                else att::unit<2>(l, bh >> 2, bh & 3, qb, lds);
            }
        PHASE_END
        PHASE_BEGIN(REP_P6)
            const cargs_t ap = get_args(); unsigned char* const ws = ap->ws;
            const char* hin = (l == 0) ? WSP(const char, WS_XN) : (const char*)ap->out;
            pg8::GateBranchOrder S{hin, WSP(const char, WS_BR), WSP(const char, WS_WGT), WSP(const char, WS_WBT), (int)gridDim.x, (int)blockIdx.x};
            const float* slots = WSP(const float, WS_ROWSS) + (size_t)(l * 2) * ROWSS_STRIDE; const float* bg = ap->b_gate + (size_t)l * 4096;
            pg8::Unit u0; int pm0 = -1, pd0 = -1;
            if (S.next(0, u0)) { pm0 = u0.pm; pd0 = u0.pn & 3; const int t = fresh_tid();
                ((LAS float*)(lds + LDS_BIAS))[t] = bg[(t >> 8) * 1024 + pd0 * 256 + (t & 255)]; ((LAS float*)(lds + LDS_BIAS))[t + 512] = bg[((t + 512) >> 8) * 1024 + pd0 * 256 + (t & 255)];
                fill_rinv_table(lds, slots, pm0); }
            pg8::EpiGateBranch E{WSP(bf16_t, WS_MIXED), bg, slots, (LAS unsigned*)(lds + 131072 + 1024), pm0, pd0, (unsigned)(uintptr_t)(lds + LDS_RINV), (unsigned)(uintptr_t)(lds + LDS_BIAS)};
            pg8::gemm_phase(lds, 1024, 1024, S, E);
        PHASE_END
        PHASE_BEGIN(REP_P7)
            const cargs_t ap = get_args(); unsigned char* const ws = ap->ws;
            pg8::PlainOrder S{WSP(const char, WS_MIXED), WSP(const char, WS_WOT), 1024, 1024, 64, 4, 16, (int)gridDim.x, (int)blockIdx.x};
            if (l == 0) { pg8::EpiRes<true> E{ap->x, WSP(bf16_t, WS_XA), WSP(float, WS_ROWSS) + (size_t)1 * ROWSS_STRIDE};
                pg8::gemm_phase(lds, 1024, 1024, S, E); }
            else { pg8::EpiRes<false> E{ap->out, WSP(bf16_t, WS_XA), WSP(float, WS_ROWSS) + (size_t)3 * ROWSS_STRIDE};
                pg8::gemm_phase(lds, 1024, 1024, S, E); }
        PHASE_END
        PHASE_BEGIN(REP_P9)
            const cargs_t ap = get_args(); unsigned char* const ws = ap->ws;
            pg8::PlainOrder S{WSP(const char, WS_XA), WSP(const char, WS_W1T), 1024, 1024, 64, 16, 16, (int)gridDim.x, (int)blockIdx.x};
            const float* slots = WSP(const float, WS_ROWSS) + (size_t)(l * 2 + 1) * ROWSS_STRIDE;
            pg8::Unit u0; int pm0 = -1; if (S.next(0, u0)) { pm0 = u0.pm; fill_rinv_table(lds, slots, pm0); }
            pg8::EpiBf16<2, 1> E{WSP(bf16_t, WS_H), 4096, slots, pm0, (unsigned)(uintptr_t)(lds + LDS_RINV), nullptr};
            pg8::gemm_phase(lds, 1024, 1024, S, E);
        PHASE_END
        PHASE_BEGIN(REP_P10)
            const cargs_t ap = get_args(); unsigned char* const ws = ap->ws;
            pg8::PlainOrder S{WSP(const char, WS_H), WSP(const char, WS_W2T), 4096, 4096, 64, 4, 64, (int)gridDim.x, (int)blockIdx.x};
            if (l == 0) { pg8::EpiRes<false> E{WSP(const bf16_t, WS_XA), (bf16_t*)ap->out, WSP(float, WS_ROWSS) + (size_t)2 * ROWSS_STRIDE};
                pg8::gemm_phase(lds, 4096, 4096, S, E); }
            else { pg8::EpiFinal E{WSP(const bf16_t, WS_XA), ap->out, WSP(float, WS_ROWSS) + (size_t)4 * ROWSS_STRIDE, ap->g_final, (unsigned*)(ws + WS_CTL) + 8192};
                pg8::gemm_phase(lds, 4096, 4096, S, E); }
        if (l == 0) GRID_BAR(); }
    }
    _Pragma("unroll 1") for (int i = 0; i < REP_SYNC; ++i) GRID_BAR();
}

extern "C" void kernel_launch(void* const* d_in, const int* in_sizes, int n_in, void* d_out, int out_size, void* d_ws, size_t ws_size, hipStream_t stream) {
    static int grid = 0;
    if (grid == 0) {
        if (n_in != 22 || out_size != TOK * DM || ws_size < WS_END) { fprintf(stderr, "kernel_launch: unexpected shapes (n_in %d out %d ws %zu)\n", n_in, out_size, ws_size); grid = -1; return; }
        int dev = 0, cus = 0, per_cu = 0;
        if (hipGetDevice(&dev) != hipSuccess || hipDeviceGetAttribute(&cus, hipDeviceAttributeMultiprocessorCount, dev) != hipSuccess) { grid = -1; return; }
        if (hipFuncSetAttribute((const void*)fwd_megakernel, hipFuncAttributeMaxDynamicSharedMemorySize, LDS_BYTES) != hipSuccess) { fprintf(stderr, "hipFuncSetAttribute failed\n"); grid = -1; return; }
        if (hipOccupancyMaxActiveBlocksPerMultiprocessor(&per_cu, (const void*)fwd_megakernel, 512, LDS_BYTES) != hipSuccess || per_cu < 1) { fprintf(stderr, "occupancy query: %d blocks per CU\n", per_cu); grid = -1; return; }
        grid = cus;
    }
    if (grid < 0) return;
    (void)hipMemsetAsync((char*)d_ws + WS_CTL, 0, 65536, stream);
    Args a{};
    a.x = (const float*)d_in[0]; a.pos = (const int*)d_in[1]; a.g_mix = (const float*)d_in[2]; a.w_in = (const float*)d_in[3]; a.w_gate = (const float*)d_in[4]; a.b_gate = (const float*)d_in[5];
    a.rel_bias = (const float*)d_in[6]; a.g_q_lat = (const float*)d_in[7]; a.w_uq = (const float*)d_in[8]; a.g_kv_lat = (const float*)d_in[9]; a.w_ukv = (const float*)d_in[10];
    a.b_forget = (const float*)d_in[11]; a.w_dw = (const float*)d_in[12]; a.b_dw = (const float*)d_in[13]; a.g_conv_ln = (const float*)d_in[14]; a.b_conv_ln = (const float*)d_in[15];
    a.w_branch = (const float*)d_in[16]; a.w_o = (const float*)d_in[17]; a.g_ffn = (const float*)d_in[18]; a.w_up = (const float*)d_in[19]; a.w_down = (const float*)d_in[20]; a.g_final = (const float*)d_in[21];
    a.out = (float*)d_out; a.ws = (unsigned char*)d_ws;
    void* args[] = {&a};
    hipError_t e = hipLaunchCooperativeKernel((const void*)fwd_megakernel, dim3(grid), dim3(512), args, LDS_BYTES, stream);
    if (e != hipSuccess) fprintf(stderr, "cooperative launch failed: %s (grid %d)\n", hipGetErrorString(e), grid);
}
```

```cpp
#include <hip/hip_runtime.h>
#include <hip/hip_cooperative_groups.h>
#include <cstdio>
#include <cstdint>
namespace cg = cooperative_groups;

#define LAS __attribute__((address_space(3)))
typedef unsigned short bf16_t;
typedef short bf16x8 __attribute__((ext_vector_type(8)));
typedef short s16x4 __attribute__((ext_vector_type(4)));
typedef float f32x4 __attribute__((ext_vector_type(4)));
typedef float f32x16 __attribute__((ext_vector_type(16)));
typedef unsigned u32x4 __attribute__((ext_vector_type(4)));
typedef unsigned u32x2 __attribute__((ext_vector_type(2)));
typedef float f32x2_t __attribute__((ext_vector_type(2)));
typedef __bf16 bf16x2_t __attribute__((ext_vector_type(2)));

constexpr int NB = 4, SEQ = 4096, DM = 1024, TOK = NB * SEQ, DFF = 4096, INC = 2468, PLD = 2560;
constexpr int C_AQ = 0, C_AK = 256, C_AV = 512, C_BQL = 768, C_BKVL = 1024, C_BKR = 1152, C_CQ = 1184, C_CK = 1440, C_CV = 1696, C_CF = 1952, C_DV = 1956, C_DG = 2212;
constexpr float LOG2E = 1.4426950408889634f;
constexpr float EPS = 1e-6f;
constexpr size_t MiB = 1u << 20;
constexpr size_t WS_W1T = 4 * MiB, WS_W2T = 12 * MiB, WS_XN = 20 * MiB, WS_PROJ = 52 * MiB, WS_XA = 52 * MiB, WS_H = 116 * MiB;
constexpr size_t WS_QKVB = 132 * MiB, WS_MIXED = 132 * MiB, WS_BR = 164 * MiB, WS_LAT = 196 * MiB, WS_U = 208 * MiB;
constexpr size_t WS_WINT = 216 * MiB, WS_WGT = 221 * MiB, WS_WLT = 229 * MiB, WS_WBT = 230 * MiB, WS_WOT = 238 * MiB;
constexpr size_t WS_CTL = 244 * MiB, WS_FCUM = 244 * MiB + 256 * 1024, WS_KROT = 245 * MiB, WS_END = 256 * MiB;
constexpr size_t WS_WINT1 = 251 * MiB, WS_WLT1 = 0, WS_LATSS = 1 * MiB;
constexpr size_t WS_ROWSS = 246 * MiB, ROWSS_STRIDE = (size_t)TOK * 16;
constexpr int LDS_RINV = 131072 + 1024 + 16384;
constexpr int LDS_BIAS = LDS_RINV + 1024;
constexpr int LDS_BYTES = LDS_BIAS + 4096;

struct Args {
    const float* x; const int* pos; const float* g_mix; const float* w_in; const float* w_gate; const float* b_gate; const float* rel_bias;
    const float* g_q_lat; const float* w_uq; const float* g_kv_lat; const float* w_ukv; const float* b_forget; const float* w_dw; const float* b_dw;
    const float* g_conv_ln; const float* b_conv_ln; const float* w_branch; const float* w_o; const float* g_ffn; const float* w_up; const float* w_down; const float* g_final;
    float* out; unsigned char* ws;
};

typedef const __attribute__((address_space(4))) Args* cargs_t;
__device__ __forceinline__ cargs_t get_args() { cargs_t p = (cargs_t)__builtin_amdgcn_kernarg_segment_ptr(); asm volatile("" : "+s"(p)); return p; }
__device__ __forceinline__ int fresh_tid() { int t = threadIdx.x; asm volatile("" : "+v"(t)); return t; }
__device__ __forceinline__ float bf2f(unsigned short b) { return __uint_as_float((unsigned)b << 16); }
__device__ __forceinline__ unsigned pk2(float lo, float hi) { f32x2_t v = {lo, hi}; bf16x2_t b = __builtin_convertvector(v, bf16x2_t); return __builtin_bit_cast(unsigned, b); }
__device__ __forceinline__ float lo_f(unsigned w) { return __uint_as_float(w << 16); }
__device__ __forceinline__ float hi_f(unsigned w) { return __uint_as_float(w & 0xffff0000u); }
__device__ __forceinline__ float wave_sum(float v) {
#pragma unroll
    for (int o = 1; o < 64; o <<= 1) v += __shfl_xor(v, o);
    return v;
}
__device__ __forceinline__ float sigmoidf_(float x) { return 1.0f / (1.0f + __expf(-x)); }
#define LDS_WAIT() asm volatile("s_waitcnt lgkmcnt(0)" ::: "memory")
__device__ __forceinline__ float row_rinv(const float* slots, int row, int fq) {
    const f32x4 a = *(const f32x4*)(slots + (size_t)row * 16 + 4 * fq);
    float s = (a.x + a.y) + (a.z + a.w);
    s += __shfl_xor(s, 16); s += __shfl_xor(s, 32);
    return __builtin_amdgcn_rsqf(s * (1.0f / 1024.0f) + EPS);
}
__device__ __forceinline__ void fill_rinv_table(LAS unsigned char* lds, const float* slots, int pm) {
    const int t = fresh_tid();
    if (t < 256) { const f32x4* p = (const f32x4*)(slots + (size_t)(pm * 256 + t) * 16); const f32x4 a = p[0], b = p[1], c = p[2], d = p[3];
        const float s = (((a.x + a.y) + (a.z + a.w)) + ((b.x + b.y) + (b.z + b.w))) + (((c.x + c.y) + (c.z + c.w)) + ((d.x + d.y) + (d.z + d.w)));
        ((LAS float*)(lds + LDS_RINV))[t] = __builtin_amdgcn_rsqf(s * (1.0f / 1024.0f) + EPS); }
    __syncthreads();
}
__device__ __forceinline__ float lds_rinv_read(unsigned addr) { float r; asm volatile("ds_read_b32 %0, %1" : "=v"(r) : "v"(addr)); return r; }
__device__ __forceinline__ f32x4 lds_read4(unsigned addr) { f32x4 r; asm volatile("ds_read_b128 %0, %1" : "=v"(r) : "v"(addr)); return r; }
namespace pg8 {
constexpr int BM = 256, BK = 64, HALF = 128, HTB = HALF * BK * 2, STAGE_BYTES = 8 * HTB, NXCD = 8, WGM = 8;
__host__ __device__ __forceinline__ int lds_byte(int r, int c) { const int st = (r >> 4) * 2 + (c >> 5), rr = r & 15, cc = c & 31, ob = rr * 64 + cc * 2; return st * 1024 + (ob ^ (((ob >> 9) & 1) << 5)); }
__host__ __device__ __forceinline__ void stage_rc(int b, int& R, int& C) { const int st = b / 1024, sb = b % 1024, swz = sb ^ (((sb >> 9) & 1) << 5); R = (st >> 1) * 16 + swz / 64; C = (st & 1) * 32 + (swz % 64) / 2; }
__host__ __device__ __forceinline__ int perm32(int rho) { const int n = rho >> 4, i = rho & 15; return 8 * (i >> 2) + 4 * n + (i & 3); }

struct Unit { int pm, pn, nt, kind; const char* a; const char* b; };

__device__ __forceinline__ bool tile_of(int L, int nM, int nN, int& pm, int& pn) {
    const int nwg = nM * nN; if (L >= nwg) return false;
    int wgid = L; { const int q = nwg / NXCD, r = nwg % NXCD, xcd = wgid % NXCD, off = wgid / NXCD; wgid = (xcd < r ? xcd * (q + 1) : r * (q + 1) + (xcd - r) * q) + off; }
    const int nig = WGM * nN, gid = wgid / nig, fm = gid * WGM, gsz = (nM - fm) < WGM ? (nM - fm) : WGM;
    pm = fm + ((wgid % nig) % gsz); pn = (wgid % nig) / gsz; return true;
}
struct PlainOrder {
    const char* A; const char* Bt; int lda, ldb, nM, nN, nt, G, c;
    __device__ __forceinline__ bool next(int i, Unit& u) const {
        int pm, pn; if (!tile_of(i * G + c, nM, nN, pm, pn)) return false;
        u.pm = pm; u.pn = pn; u.nt = nt; u.kind = 0; u.a = A + (size_t)pm * 256 * lda * 2; u.b = Bt + (size_t)pn * 256 * ldb * 2; return true;
    }
};
struct GateBranchOrder {
    const char* XN; const char* BR; const char* WgT; const char* WbT; int G, c;
    __device__ __forceinline__ bool next(int i, Unit& u) const {
        const int gi = i >> 3, j = i & 7; int pm, pd; if (!tile_of(gi * G + c, 64, 4, pm, pd)) return false;
        const int n = j >> 1, kind = j & 1; u.pm = pm; u.pn = n * 4 + pd; u.kind = kind;
        if (kind == 0) { u.nt = 16; u.a = XN + (size_t)pm * 256 * 1024 * 2; u.b = WgT + (size_t)u.pn * 256 * 1024 * 2; }
        else { u.nt = 4; u.a = BR + ((size_t)pm * 256 * 1024 + n * 256) * 2; u.b = WbT + ((size_t)u.pn * 256 * 1024 + n * 256) * 2; }
        return true;
    }
};

template <int ACT  , int RS  , bool LATSS = false  > struct EpiBf16 {
    static constexpr bool PERM = true; struct State {};
    bf16_t* O; int ldc; const float* rowss; int pm_tab; unsigned tab; float* latss;
    __device__ __forceinline__ void operator()(const f32x4 (&acc)[2][2][4][2], State&, const Unit& u, int wr, int wc, int fr, int fq) const {
        asm volatile("" : "+v"(fr), "+v"(fq));
        const int row0 = u.pm * BM + wr * 64 + fr, col0 = u.pn * BM + wc * 32 + 8 * fq;
        float rv[2][4];
        if (RS == 1) {
            if (u.pm == pm_tab) {
#pragma unroll
                for (int ai = 0; ai < 2; ++ai)
#pragma unroll
                    for (int m = 0; m < 4; ++m) rv[ai][m] = lds_rinv_read(tab + (unsigned)(wr * 64 + fr + ai * HALF + m * 16) * 4u);
                asm volatile("s_waitcnt lgkmcnt(0)" : "+v"(rv[0][0]), "+v"(rv[0][1]), "+v"(rv[0][2]), "+v"(rv[0][3]), "+v"(rv[1][0]), "+v"(rv[1][1]), "+v"(rv[1][2]), "+v"(rv[1][3]));
            } else {
#pragma unroll
                for (int ai = 0; ai < 2; ++ai)
#pragma unroll
                    for (int m = 0; m < 4; ++m) rv[ai][m] = row_rinv(rowss, row0 + ai * HALF + m * 16, fq);
            }
        }
#pragma unroll
        for (int ai = 0; ai < 2; ++ai)
#pragma unroll
            for (int m = 0; m < 4; ++m) { bf16_t* rowp = O + (size_t)(row0 + ai * HALF + m * 16) * ldc + col0;
                float rinv = 1.f; if (RS == 1) rinv = rv[ai][m];
                if (RS == 2) { const f32x4 a = *(const f32x4*)(latss + (size_t)(row0 + ai * HALF + m * 16) * 8 + (u.pn >= 2 ? 4 : 0));
                    rinv = __builtin_amdgcn_rsqf(((a.x + a.y) + (a.z + a.w)) * (u.pn >= 2 ? (1.0f / 128.0f) : (1.0f / 256.0f)) + EPS); }
                float lss = 0.f;
#pragma unroll
                for (int bj = 0; bj < 2; ++bj) { f32x4 v0 = acc[ai][bj][m][0], v1 = acc[ai][bj][m][1];
                    if (RS) { v0 = v0 * rinv; v1 = v1 * rinv; }
                    if (LATSS) { if (bj == 0 || u.pn == 3) lss += ((v0.x * v0.x + v0.y * v0.y) + (v0.z * v0.z + v0.w * v0.w)) + ((v1.x * v1.x + v1.y * v1.y) + (v1.z * v1.z + v1.w * v1.w)); }
                    if (ACT == 2) {
#pragma unroll
                        for (int e = 0; e < 4; ++e) { const float a0 = fmaxf(v0[e], 0.f), a1 = fmaxf(v1[e], 0.f); v0[e] = a0 * a0; v1[e] = a1 * a1; } }
                    u32x4 w; w.x = pk2(v0[0], v0[1]); w.y = pk2(v0[2], v0[3]); w.z = pk2(v1[0], v1[1]); w.w = pk2(v1[2], v1[3]);
                    *(u32x4*)(rowp + bj * HALF) = w; }
                if (LATSS) { if (u.pn == 3 || u.pn == 4) { lss += __shfl_xor(lss, 16); lss += __shfl_xor(lss, 32);
                    if (fq == 0) latss[(size_t)(row0 + ai * HALF + m * 16) * 8 + (u.pn == 4 ? 4 : 0) + wc] = lss; } } }
    }
};
template <bool BASEF32> struct EpiRes {
    static constexpr bool PERM = true; struct State {};
    const void* base; bf16_t* out; float* rowss;
    __device__ __forceinline__ void operator()(const f32x4 (&acc)[2][2][4][2], State&, const Unit& u, int wr, int wc, int fr, int fq) const {
        asm volatile("" : "+v"(fr), "+v"(fq));
        const int row0 = u.pm * BM + wr * 64 + fr, col0 = u.pn * BM + wc * 32 + 8 * fq;
#pragma unroll
        for (int ai = 0; ai < 2; ++ai) {
            f32x4 bs[4][2][2];
#pragma unroll
            for (int m = 0; m < 4; ++m) { const size_t off = (size_t)(row0 + ai * HALF + m * 16) * 1024 + col0;
#pragma unroll
                for (int bj = 0; bj < 2; ++bj) {
                    if (BASEF32) { bs[m][bj][0] = *(const f32x4*)((const float*)base + off + bj * HALF); bs[m][bj][1] = *(const f32x4*)((const float*)base + off + bj * HALF + 4); }
                    else { const u32x4 w = *(const u32x4*)((const bf16_t*)base + off + bj * HALF);
                        bs[m][bj][0] = (f32x4){lo_f(w.x), hi_f(w.x), lo_f(w.y), hi_f(w.y)}; bs[m][bj][1] = (f32x4){lo_f(w.z), hi_f(w.z), lo_f(w.w), hi_f(w.w)}; } } }
            asm volatile("" ::: "memory");
#pragma unroll
            for (int m = 0; m < 4; ++m) { const int row = row0 + ai * HALF + m * 16; const size_t off = (size_t)row * 1024 + col0; float ss = 0.f;
#pragma unroll
                for (int bj = 0; bj < 2; ++bj) { const f32x4 v0 = bs[m][bj][0] + acc[ai][bj][m][0], v1 = bs[m][bj][1] + acc[ai][bj][m][1];
                    u32x4 w; w.x = pk2(v0[0], v0[1]); w.y = pk2(v0[2], v0[3]); w.z = pk2(v1[0], v1[1]); w.w = pk2(v1[2], v1[3]); *(u32x4*)(out + off + bj * HALF) = w;
                    ss += ((v0.x * v0.x + v0.y * v0.y) + (v0.z * v0.z + v0.w * v0.w)) + ((v1.x * v1.x + v1.y * v1.y) + (v1.z * v1.z + v1.w * v1.w)); }
                ss += __shfl_xor(ss, 16); ss += __shfl_xor(ss, 32); if (fq == 0) rowss[(size_t)row * 16 + u.pn * 4 + wc] = ss; }
            asm volatile("" ::: "memory");
        }
    }
};
struct EpiFinal {
    static constexpr bool PERM = true; struct State {};
    const bf16_t* base; float* out; float* rowss; const float* g; unsigned* cnt;
    __device__ __forceinline__ void operator()(const f32x4 (&acc_)[2][2][4][2], State&, const Unit& u, int wr, int wc, int fr, int fq) const {
        asm volatile("" : "+v"(fr), "+v"(fq));
        f32x4 (&acc)[2][2][4][2] = const_cast<f32x4 (&)[2][2][4][2]>(acc_);
        const int row0 = u.pm * BM + wr * 64 + fr, col0 = u.pn * BM + wc * 32 + 8 * fq;
#pragma unroll
        for (int ai = 0; ai < 2; ++ai) {
            u32x4 bs[4][2];
#pragma unroll
            for (int m = 0; m < 4; ++m) { const size_t off = (size_t)(row0 + ai * HALF + m * 16) * 1024 + col0;
#pragma unroll
                for (int bj = 0; bj < 2; ++bj) bs[m][bj] = *(const u32x4*)(base + off + bj * HALF); }
            asm volatile("" ::: "memory");
#pragma unroll
            for (int m = 0; m < 4; ++m) { const int row = row0 + ai * HALF + m * 16; float ss = 0.f;
#pragma unroll
                for (int bj = 0; bj < 2; ++bj) { const u32x4 w = bs[m][bj];
                    const f32x4 v0 = acc[ai][bj][m][0] + (f32x4){lo_f(w.x), hi_f(w.x), lo_f(w.y), hi_f(w.y)}, v1 = acc[ai][bj][m][1] + (f32x4){lo_f(w.z), hi_f(w.z), lo_f(w.w), hi_f(w.w)};
                    acc[ai][bj][m][0] = v0; acc[ai][bj][m][1] = v1;
                    ss += ((v0.x * v0.x + v0.y * v0.y) + (v0.z * v0.z + v0.w * v0.w)) + ((v1.x * v1.x + v1.y * v1.y) + (v1.z * v1.z + v1.w * v1.w)); }
                ss += __shfl_xor(ss, 16); ss += __shfl_xor(ss, 32); if (fq == 0) rowss[(size_t)row * 16 + u.pn * 4 + wc] = ss; }
        }
        asm volatile("s_waitcnt vmcnt(0)" ::: "memory"); __builtin_amdgcn_s_barrier(); asm volatile("" ::: "memory");
        if (threadIdx.x == 0) {
            __builtin_amdgcn_fence(__ATOMIC_RELEASE, "agent"); asm volatile("s_waitcnt vmcnt(0)" ::: "memory");
            unsigned* c = cnt + 64 * u.pm;
            (void)__hip_atomic_fetch_add(c, 1u, __ATOMIC_RELAXED, __HIP_MEMORY_SCOPE_AGENT);
            unsigned sp = 0;
            while (__hip_atomic_load(c, __ATOMIC_RELAXED, __HIP_MEMORY_SCOPE_AGENT) < 4u) { __builtin_amdgcn_s_sleep(1); if (++sp > (1u << 16)) break; }
            __builtin_amdgcn_fence(__ATOMIC_ACQUIRE, "agent"); asm volatile("s_waitcnt vmcnt(0)" ::: "memory");
        }
        asm volatile("" ::: "memory"); __builtin_amdgcn_s_barrier(); asm volatile("" ::: "memory");
        f32x4 gv[2][2];
#pragma unroll
        for (int bj = 0; bj < 2; ++bj)
#pragma unroll
            for (int q = 0; q < 2; ++q) gv[bj][q] = *(const f32x4*)(g + col0 + bj * HALF + 4 * q);
#pragma unroll
        for (int ai = 0; ai < 2; ++ai)
#pragma unroll
            for (int m = 0; m < 4; ++m) { const int row = row0 + ai * HALF + m * 16; const float rinv = row_rinv(rowss, row, fq); float* op = out + (size_t)row * 1024 + col0;
#pragma unroll
                for (int bj = 0; bj < 2; ++bj) { *(f32x4*)(op + bj * HALF) = acc[ai][bj][m][0] * rinv * gv[bj][0]; *(f32x4*)(op + bj * HALF + 4) = acc[ai][bj][m][1] * rinv * gv[bj][1]; } }
    }
};
struct EpiGateBranch {
    static constexpr bool PERM = true;
    struct State { unsigned g8[2][2][4][2]; };
    bf16_t* mixed; const float* bgate; const float* rowss; LAS unsigned* glds; int pm_tab, pd_tab; unsigned tab, btab;
    __device__ __forceinline__ void operator()(const f32x4 (&acc)[2][2][4][2], State& st, const Unit& u, int wr, int wc, int fr, int fq) const {
        asm volatile("" : "+v"(fr), "+v"(fq));
        const int rl0 = wr * 64 + fr, cl0 = wc * 32 + 8 * fq, n = u.pn >> 2, pd = u.pn & 3;
        LAS unsigned* gl = glds + (wr * 4 + wc) * 512 + (fq * 16 + fr) * 8;
        if (u.kind == 0) {
            f32x4 bv[2][2]; float rv[2][4];
            if (u.pm == pm_tab && pd == pd_tab) {
#pragma unroll
                for (int bj = 0; bj < 2; ++bj)
#pragma unroll
                    for (int q = 0; q < 2; ++q) bv[bj][q] = lds_read4(btab + (unsigned)(n * 256 + cl0 + bj * HALF + 4 * q) * 4u);
#pragma unroll
                for (int ai = 0; ai < 2; ++ai)
#pragma unroll
                    for (int m = 0; m < 4; ++m) rv[ai][m] = lds_rinv_read(tab + (unsigned)(rl0 + ai * HALF + m * 16) * 4u);
                asm volatile("s_waitcnt lgkmcnt(0)" : "+v"(bv[0][0]), "+v"(bv[0][1]), "+v"(bv[1][0]), "+v"(bv[1][1]), "+v"(rv[0][0]), "+v"(rv[0][1]), "+v"(rv[0][2]), "+v"(rv[0][3]), "+v"(rv[1][0]), "+v"(rv[1][1]), "+v"(rv[1][2]), "+v"(rv[1][3]));
            } else {
#pragma unroll
                for (int bj = 0; bj < 2; ++bj)
#pragma unroll
                    for (int q = 0; q < 2; ++q) bv[bj][q] = *(const f32x4*)(bgate + u.pn * BM + cl0 + bj * HALF + 4 * q);
#pragma unroll
                for (int ai = 0; ai < 2; ++ai)
#pragma unroll
                    for (int m = 0; m < 4; ++m) rv[ai][m] = row_rinv(rowss, u.pm * BM + rl0 + ai * HALF + m * 16, fq);
            }
#pragma unroll
            for (int bj = 0; bj < 2; ++bj)
#pragma unroll
                for (int q = 0; q < 2; ++q) bv[bj][q] = bv[bj][q] * (-LOG2E);
#pragma unroll
            for (int ai = 0; ai < 2; ++ai)
#pragma unroll
                for (int m = 0; m < 4; ++m) {
                    const float rinv = rv[ai][m] * (-LOG2E);
#pragma unroll
                    for (int bj = 0; bj < 2; ++bj)
#pragma unroll
                        for (int q = 0; q < 2; ++q) { const f32x4 t = acc[ai][bj][m][q] * rinv + bv[bj][q]; unsigned w = 0u;
#pragma unroll
                            for (int e = 0; e < 4; ++e) w |= (unsigned)(__builtin_amdgcn_rcpf(1.0f + __builtin_amdgcn_exp2f(t[e])) * 255.0f + 0.5f) << (8 * e);
                            if (ai == 1 && bj == 1) gl[m * 2 + q] = w; else st.g8[ai][bj][m][q] = w; } }
        } else {
#pragma unroll
            for (int ai = 0; ai < 2; ++ai) {
                u32x4 oo[4][2];
#pragma unroll
                for (int m = 0; m < 4; ++m) { const int rl = rl0 + ai * HALF + m * 16; const bf16_t* mp = mixed + (size_t)(u.pm * BM + rl) * 1024 + pd * 256 + cl0;
#pragma unroll
                    for (int bj = 0; bj < 2; ++bj) { oo[m][bj] = (u32x4){0u, 0u, 0u, 0u}; if (n > 0) oo[m][bj] = *(const u32x4*)(mp + bj * HALF); } }
                asm volatile("" ::: "memory");
#pragma unroll
                for (int m = 0; m < 4; ++m) { const int rl = rl0 + ai * HALF + m * 16; bf16_t* mp = mixed + (size_t)(u.pm * BM + rl) * 1024 + pd * 256 + cl0;
#pragma unroll
                    for (int bj = 0; bj < 2; ++bj) { const unsigned g0 = (ai == 1 && bj == 1) ? gl[m * 2] : st.g8[ai][bj][m][0], g1 = (ai == 1 && bj == 1) ? gl[m * 2 + 1] : st.g8[ai][bj][m][1]; const u32x4 o = oo[m][bj]; const f32x4 a0 = acc[ai][bj][m][0] * (1.0f / 255.0f), a1 = acc[ai][bj][m][1] * (1.0f / 255.0f);
                        float v[8];
                        v[0] = fmaf(a0[0], (float)(g0 & 255u), lo_f(o.x)); v[1] = fmaf(a0[1], (float)((g0 >> 8) & 255u), hi_f(o.x)); v[2] = fmaf(a0[2], (float)((g0 >> 16) & 255u), lo_f(o.y)); v[3] = fmaf(a0[3], (float)(g0 >> 24), hi_f(o.y));
                        v[4] = fmaf(a1[0], (float)(g1 & 255u), lo_f(o.z)); v[5] = fmaf(a1[1], (float)((g1 >> 8) & 255u), hi_f(o.z)); v[6] = fmaf(a1[2], (float)((g1 >> 16) & 255u), lo_f(o.w)); v[7] = fmaf(a1[3], (float)(g1 >> 24), hi_f(o.w));
                        u32x4 w; w.x = pk2(v[0], v[1]); w.y = pk2(v[2], v[3]); w.z = pk2(v[4], v[5]); w.w = pk2(v[6], v[7]);
                        *(u32x4*)(mp + bj * HALF) = w; } }
                asm volatile("" ::: "memory");
            }
        }
    }
};

template <class Epi, class Sched>
__device__ __forceinline__ void gemm_phase(LAS unsigned char* lds, const int lda, const int ldb, const Sched& S, const Epi& E) {
    const int tid = fresh_tid(), wid = __builtin_amdgcn_readfirstlane(tid >> 6), lane = tid & 63, wr = wid >> 2, wc = wid & 3, fr = lane & 15, fq = lane >> 4;
    unsigned voffA[2], voffB[2];
#pragma unroll
    for (int i = 0; i < 2; ++i) { int R, C; stage_rc(tid * 16 + i * 8192, R, C); const int Rb = Epi::PERM ? ((R & ~31) + perm32(R & 31)) : R;
        voffA[i] = (unsigned)(R * lda + C) * 2u; voffB[i] = (unsigned)(Rb * ldb + C) * 2u; }
    const size_t kstep = (size_t)(BK * 2);
    const size_t hstepA = (size_t)HALF * lda * 2, hstepB = (size_t)HALF * ldb * 2;
    const unsigned ldsw = (unsigned)wid * 1024u;
    const int aoff = lds_byte(wr * 64 + fr, fq * 8), boff = lds_byte(wc * 32 + fr, fq * 8);
#define PG8_SA(b, h) (((b) * 2 + (h)) * HTB)
#define PG8_SB(b, h) ((4 + (b) * 2 + (h)) * HTB)
#define PG8_STAGE(bufoff, gbase, voff) do { _Pragma("unroll") for (int _i = 0; _i < 2; ++_i) \
        __builtin_amdgcn_global_load_lds((const unsigned*)((const char*)(gbase) + (voff)[_i]), (LAS unsigned*)(lds + (bufoff) + ldsw + _i * 8192), 16, 0, 0); } while (0)
#define PG8_LDA(dst, b, h) do { _Pragma("unroll") for (int m = 0; m < 4; ++m) _Pragma("unroll") for (int k = 0; k < 2; ++k) dst[m][k] = *(const LAS bf16x8*)(lds + PG8_SA(b, h) + aoff + m * 2048 + k * 1024); } while (0)
#define PG8_LDB(dst, b, h) do { _Pragma("unroll") for (int n = 0; n < 2; ++n) _Pragma("unroll") for (int k = 0; k < 2; ++k) dst[n][k] = *(const LAS bf16x8*)(lds + PG8_SB(b, h) + boff + n * 2048 + k * 1024); } while (0)
#define PG8_MMA(ai, bj, At, Bt) do { __builtin_amdgcn_s_setprio(1); _Pragma("unroll") for (int m = 0; m < 4; ++m) _Pragma("unroll") for (int n = 0; n < 2; ++n) _Pragma("unroll") for (int k = 0; k < 2; ++k) \
        acc[ai][bj][m][n] = __builtin_amdgcn_mfma_f32_16x16x32_bf16(Bt[n][k], At[m][k], acc[ai][bj][m][n], 0, 0, 0); __builtin_amdgcn_s_setprio(0); } while (0)
#define PG8_WAIT_V(n) asm volatile("s_waitcnt vmcnt(" #n ")" ::: "memory")
#define PG8_WAIT_L(n) asm volatile("s_waitcnt lgkmcnt(" #n ")" ::: "memory")
#define PG8_BAR __builtin_amdgcn_s_barrier()
#define PG8_SCHED __builtin_amdgcn_sched_barrier(0)
    Unit cur, nxt; int ui = 0;
    if (!S.next(0, cur)) return;
    f32x4 acc[2][2][4][2];
#pragma unroll
    for (int a = 0; a < 2; ++a)
#pragma unroll
        for (int b = 0; b < 2; ++b)
#pragma unroll
            for (int m = 0; m < 4; ++m)
#pragma unroll
                for (int n = 0; n < 2; ++n) acc[a][b][m][n] = (f32x4){0.f, 0.f, 0.f, 0.f};
    bf16x8 At[4][2], B0[2][2], B1[2][2];
    typename Epi::State est;
    const char* cA = cur.a; const char* cB = cur.b;
    PG8_STAGE(PG8_SB(0, 0), cB, voffB); PG8_STAGE(PG8_SB(0, 1), cB + hstepB, voffB); PG8_STAGE(PG8_SA(0, 0), cA, voffA); PG8_STAGE(PG8_SA(0, 1), cA + hstepA, voffA);
    if (wr == 1) PG8_BAR;
    PG8_WAIT_V(2); PG8_BAR;
    PG8_STAGE(PG8_SB(1, 0), cB + kstep, voffB); PG8_STAGE(PG8_SA(1, 0), cA + kstep, voffA); PG8_STAGE(PG8_SB(1, 1), cB + hstepB + kstep, voffB);
    PG8_WAIT_V(6); PG8_BAR;
    for (;;) {
        const bool has_next = S.next(ui + 1, nxt);
        const char* nA = has_next ? nxt.a : cA; const char* nB = has_next ? nxt.b : cB;
        const int nt = cur.nt;
        for (int t = 0; t < nt; t += 2) {
            const bool last = (t == nt - 2);
            const char* a1 = cA + (size_t)(t + 1) * kstep;
            const char* a2 = last ? nA : cA + (size_t)(t + 2) * kstep; const char* b2 = last ? nB : cB + (size_t)(t + 2) * kstep;
            const char* a3 = a2 + kstep; const char* b3 = b2 + kstep;
            PG8_LDB(B0, 0, 0); PG8_LDB(B1, 0, 1); PG8_SCHED; PG8_LDA(At, 0, 0); PG8_STAGE(PG8_SA(1, 1), a1 + hstepA, voffA);
            PG8_WAIT_V(8); PG8_WAIT_L(0); PG8_BAR; PG8_MMA(0, 0, At, B0); PG8_MMA(0, 1, At, B1); PG8_BAR; PG8_SCHED;
            PG8_LDA(At, 0, 1); PG8_STAGE(PG8_SB(0, 0), b2, voffB); PG8_STAGE(PG8_SB(0, 1), b2 + hstepB, voffB); PG8_STAGE(PG8_SA(0, 0), a2, voffA);
            PG8_WAIT_V(8); PG8_WAIT_L(0); PG8_BAR; PG8_MMA(1, 0, At, B0); PG8_MMA(1, 1, At, B1); PG8_BAR; PG8_SCHED;
            PG8_LDB(B0, 1, 0); PG8_LDB(B1, 1, 1); PG8_SCHED; PG8_LDA(At, 1, 0); PG8_STAGE(PG8_SA(0, 1), a2 + hstepA, voffA);
            PG8_WAIT_V(8); PG8_WAIT_L(0); PG8_BAR; PG8_MMA(0, 0, At, B0); PG8_MMA(0, 1, At, B1); PG8_BAR; PG8_SCHED;
            PG8_LDA(At, 1, 1); PG8_STAGE(PG8_SB(1, 0), b3, voffB); PG8_STAGE(PG8_SB(1, 1), b3 + hstepB, voffB); PG8_STAGE(PG8_SA(1, 0), a3, voffA);
            PG8_WAIT_V(8); PG8_WAIT_L(0); PG8_BAR; PG8_MMA(1, 0, At, B0); PG8_MMA(1, 1, At, B1); PG8_BAR; PG8_SCHED;
        }
        if (wr == 0) PG8_BAR;
        E(acc, est, cur, wr, wc, fr, fq);
        if (!has_next) break;
#pragma unroll
        for (int a = 0; a < 2; ++a)
#pragma unroll
            for (int b = 0; b < 2; ++b)
#pragma unroll
                for (int m = 0; m < 4; ++m)
#pragma unroll
                    for (int n = 0; n < 2; ++n) acc[a][b][m][n] = (f32x4){0.f, 0.f, 0.f, 0.f};
        cur = nxt; cA = nA; cB = nB; ++ui;
        if (wr == 1) PG8_BAR;
    }
    PG8_WAIT_V(0);
    PG8_BAR;
#undef PG8_SA
#undef PG8_SB
#undef PG8_STAGE
#undef PG8_LDA
#undef PG8_LDB
#undef PG8_MMA
#undef PG8_WAIT_V
#undef PG8_WAIT_L
#undef PG8_BAR
#undef PG8_SCHED
}
}

namespace att {
constexpr int VP = 144;
typedef short v4i16_t __attribute__((ext_vector_type(4)));
__device__ __forceinline__ int crow(int i, int h) { return (i & 3) + 8 * (i >> 2) + 4 * h; }
__device__ __forceinline__ s16x4 vtr(const LAS unsigned char* p) { return __builtin_bit_cast(s16x4, __builtin_amdgcn_ds_read_tr16_b64_v4i16((LAS v4i16_t*)p)); }
#define MFMA32(a, b, c) __builtin_amdgcn_mfma_f32_32x32x16_bf16((a), (b), (c), 0, 0, 0)

template <int MODE>
__device__ __forceinline__ void unit(int layer, int b, int h, int qb, LAS unsigned char* lds) {
    const cargs_t ap = get_args();
    unsigned char* const ws_ = ap->ws;
    constexpr int DK = MODE == 1 ? 96 : 64, ND = DK / 16, KP = DK * 2 + 16, KBUF = 64 * KP, VBUF = 64 * VP;
    LAS unsigned char* Ks = lds; LAS unsigned char* Vs = lds + 2 * KBUF;
    LAS float* Fs = (LAS float*)(lds + 2 * KBUF + 2 * VBUF); LAS float* Tab = Fs + 128;
    const int tid = fresh_tid(), lane = tid & 63, wid = __builtin_amdgcn_readfirstlane(tid >> 6), r = lane & 31, hh = lane >> 5;
    const size_t tok0 = (size_t)b * SEQ;
    const int qw = qb * 256 + wid * 32, qc = qw >> 6;
    const bf16_t* PROJ = (const bf16_t*)(ws_ + WS_PROJ); const bf16_t* QKVB = (const bf16_t*)(ws_ + WS_QKVB); const bf16_t* KROT = (const bf16_t*)(ws_ + WS_KROT);
    const float* FCUM = (const float*)(ws_ + WS_FCUM) + (size_t)(b * 4 + h) * SEQ;
    bf16_t* BR = (bf16_t*)(ws_ + WS_BR);
    const bf16_t *Qp, *Kp, *Vp; int ldq, ldk;
    if (MODE == 0) { Qp = PROJ + C_AQ + h * 64; Kp = PROJ + C_AK + h * 64; Vp = PROJ + C_AV + h * 64; ldq = PLD; ldk = PLD; }
    else if (MODE == 2) { Qp = PROJ + C_CQ + h * 64; Kp = PROJ + C_CK + h * 64; Vp = PROJ + C_CV + h * 64; ldq = PLD; ldk = PLD; }
    else { Qp = QKVB + h * 96; Kp = QKVB + 512 + h * 128; Vp = Kp + 64; ldq = 1024; ldk = 1024; }
    const int t_lo = (MODE == 0) ? (qb * 4 - 8 > 0 ? qb * 4 - 8 : 0) : 0, t_hi = qb * 4 + 4;
    const float cs = (MODE == 1 ? 0.10206207261596577f : 0.125f) * LOG2E;

    u32x4 kregA, vregA, kr2A, kregB, vregB, kr2B; float fregA = 0.f, fregB = 0.f;
    const int srow = tid >> 3, sch = tid & 7;
#define ATT_LOAD(j, X) do { const int jl_ = (j) < t_lo ? t_lo : (j); const size_t trow = tok0 + (size_t)jl_ * 64; \
        kreg##X = *(const u32x4*)(Kp + (trow + srow) * ldk + sch * 8); vreg##X = *(const u32x4*)(Vp + (trow + srow) * ldk + sch * 8); \
        if (MODE == 1) { kr2##X = *(const u32x4*)(KROT + (trow + ((tid >> 2) & 63)) * 32 + (tid & 3) * 8); } \
        if (MODE == 2) { freg##X = FCUM[jl_ * 64 + (tid & 63)]; } } while (0)
#define ATT_STORE(s, X) do { *(LAS u32x4*)(Ks + (s) * KBUF + srow * KP + sch * 16) = kreg##X; *(LAS u32x4*)(Vs + (s) * VBUF + srow * VP + sch * 16) = vreg##X; \
        if (MODE == 1) { if (tid < 256) *(LAS u32x4*)(Ks + (s) * KBUF + (tid >> 2) * KP + 128 + (tid & 3) * 16) = kr2##X; } \
        if (MODE == 2) { if (tid < 64) Fs[(s) * 64 + tid] = freg##X * LOG2E; } } while (0)

    ATT_LOAD(t_hi - 1, A);
    ATT_LOAD(t_hi - 2, B);
    if (MODE == 0) { if (tid < 257) Tab[tid] = ap->rel_bias[(size_t)(layer * 4 + h) * 257 + tid] * LOG2E; }
    bf16x8 qf[ND];
    { const bf16_t* qrow = Qp + (tok0 + qw + r) * ldq;
#pragma unroll
      for (int d0 = 0; d0 < ND; ++d0) qf[d0] = *(const bf16x8*)(qrow + d0 * 16 + hh * 8); }
    if (MODE == 1) {
        const float pos = (float)ap->pos[tok0 + qw + r];
#pragma unroll
        for (int j = 0; j < 8; ++j) {
            const float invf = exp2f(-(float)(8 * hh + j) * 0.8304820237218406f);
            const float ang = pos * invf, kk = rintf(ang * 0.15915494309189535f);
            float rem = fmaf(-kk, 6.2831854820251465f, ang); rem = fmaf(kk, 1.7484555e-7f, rem);
            const float sn = __sinf(rem), cn = __cosf(rem);
            const float x1 = bf2f((unsigned short)qf[4][j]), x2 = bf2f((unsigned short)qf[5][j]);
            const unsigned w = pk2(x1 * cn - x2 * sn, x2 * cn + x1 * sn);
            qf[4][j] = (short)(w & 0xffffu); qf[5][j] = (short)(w >> 16);
        }
    }
    float fq = 0.f;
    if (MODE == 2) fq = FCUM[qw + r] * LOG2E;
    float m_run = -INFINITY, l_run = 0.f;
    float ub = 0.f; LAS int* wv = (LAS int*)(lds + 131072 + 768);
    if (MODE == 2) {
        float q2 = 0.f;
#pragma unroll
        for (int d0 = 0; d0 < 4; ++d0)
#pragma unroll
            for (int e = 0; e < 8; ++e) { const float x = bf2f((unsigned short)qf[d0][e]); q2 = fmaf(x, x, q2); }
        { auto rr = __builtin_amdgcn_permlane32_swap(__float_as_uint(q2), __float_as_uint(q2), false, false); q2 = __uint_as_float(rr[0]) + __uint_as_float(rr[1]); }
        const unsigned kbits = ((const unsigned*)(ws_ + WS_CTL))[1024 + b * 4 + h];
        ub = sqrtf(q2) * sqrtf(__uint_as_float(kbits)) * cs * 1.0001f + 0.01f;
    }
    f32x16 o0, o1;
#pragma unroll
    for (int i = 0; i < 16; ++i) { o0[i] = 0.f; o1[i] = 0.f; }
    ATT_STORE(0, A);
    __syncthreads();
    const int i16 = lane & 15, vq = i16 >> 2, vp = i16 & 3, vblk = (lane >> 4) & 1;
    const int voff = (4 * hh + vq) * VP + vblk * 32 + vp * 8;

    auto compute = [&](const int j, const int s) __attribute__((always_inline)) {
        const bool active = (MODE == 0) ? (j <= qc && j >= qc - 8) : (j <= qc);
        if (active) {
            const LAS unsigned char* kb = Ks + s * KBUF + r * KP + hh * 16;
            f32x16 p0, p1;
#pragma unroll
            for (int i = 0; i < 16; ++i) { p0[i] = 0.f; p1[i] = 0.f; }
#pragma unroll
            for (int d0 = 0; d0 < ND; ++d0) {
                const bf16x8 kf0 = *(const LAS bf16x8*)(kb + d0 * 32), kf1 = *(const LAS bf16x8*)(kb + 32 * KP + d0 * 32);
                p0 = MFMA32(kf0, qf[d0], p0); p1 = MFMA32(kf1, qf[d0], p1);
            }
            if (MODE == 0) {
                const int delta = qc - j;
                if (delta >= 3) { const float cb = Tab[256];
#pragma unroll
                    for (int i = 0; i < 16; ++i) { p0[i] = fmaf(p0[i], cs, cb); p1[i] = fmaf(p1[i], cs, cb); }
                } else { const int brel = 64 * delta + (qw & 63) + r + 128;
#pragma unroll
                    for (int i = 0; i < 16; ++i) { const int kj = crow(i, hh); int i0 = brel - kj, i1 = brel - kj - 32;
                        i0 = i0 < 0 ? 0 : (i0 > 256 ? 256 : i0); i1 = i1 < 0 ? 0 : (i1 > 256 ? 256 : i1);
                        p0[i] = fmaf(p0[i], cs, Tab[i0]); p1[i] = fmaf(p1[i], cs, Tab[i1]); }
                }
            } else if (MODE == 1) {
            } else {
                const LAS float* fs = Fs + s * 64 + 4 * hh;
#pragma unroll
                for (int g = 0; g < 4; ++g) { const f32x4 f0 = *(const LAS f32x4*)(fs + 8 * g), f1 = *(const LAS f32x4*)(fs + 32 + 8 * g);
#pragma unroll
                    for (int e = 0; e < 4; ++e) { p0[4 * g + e] = fmaf(p0[4 * g + e], cs, fq - f0[e]); p1[4 * g + e] = fmaf(p1[4 * g + e], cs, fq - f1[e]); } }
                if (j == qc) { const int qrel = (qw & 63) + r;
#pragma unroll
                    for (int i = 0; i < 16; ++i) { const int kj = crow(i, hh); if (kj > qrel) p0[i] = -INFINITY; if (kj + 32 > qrel) p1[i] = -INFINITY; } }
            }
            float mx = p0[0];
#pragma unroll
            for (int i = 1; i < 16; ++i) mx = fmaxf(mx, p0[i]);
#pragma unroll
            for (int i = 0; i < 16; ++i) mx = fmaxf(mx, p1[i]);
            { auto rr = __builtin_amdgcn_permlane32_swap(__float_as_uint(mx), __float_as_uint(mx), false, false); mx = fmaxf(__uint_as_float(rr[0]), __uint_as_float(rr[1])); }
            if (MODE == 1) mx *= cs;
            if (__all(mx < m_run - 40.f)) return;
            if (__any(mx > m_run)) {
                const float m_new = fmaxf(m_run, mx);
                const float alpha = __builtin_amdgcn_exp2f(m_run - m_new);
                m_run = m_new; l_run *= alpha;
#pragma unroll
                for (int i = 0; i < 16; ++i) { o0[i] *= alpha; o1[i] *= alpha; }
            }
            float sum = 0.f;
#pragma unroll
            for (int i = 0; i < 16; ++i) { p0[i] = __builtin_amdgcn_exp2f(MODE == 1 ? fmaf(p0[i], cs, -m_run) : p0[i] - m_run); p1[i] = __builtin_amdgcn_exp2f(MODE == 1 ? fmaf(p1[i], cs, -m_run) : p1[i] - m_run); sum += p0[i] + p1[i]; }
            l_run += sum;
            const LAS unsigned char* vb = Vs + s * VBUF + voff;
#pragma unroll
            for (int kbk = 0; kbk < 2; ++kbk)
#pragma unroll
                for (int st = 0; st < 2; ++st) {
                    const f32x16& pp = kbk ? p1 : p0;
                    u32x4 pw; pw.x = pk2(pp[8 * st + 0], pp[8 * st + 1]); pw.y = pk2(pp[8 * st + 2], pp[8 * st + 3]); pw.z = pk2(pp[8 * st + 4], pp[8 * st + 5]); pw.w = pk2(pp[8 * st + 6], pp[8 * st + 7]);
                    const bf16x8 pf = __builtin_bit_cast(bf16x8, pw);
                    const LAS unsigned char* vr = vb + (32 * kbk + 16 * st) * VP;
                    const s16x4 a_lo = vtr(vr), a_hi = vtr(vr + 8 * VP), b_lo = vtr(vr + 64), b_hi = vtr(vr + 8 * VP + 64);
                    const bf16x8 v0 = __builtin_shufflevector(a_lo, a_hi, 0, 1, 2, 3, 4, 5, 6, 7), v1 = __builtin_shufflevector(b_lo, b_hi, 0, 1, 2, 3, 4, 5, 6, 7);
                    o0 = MFMA32(v0, pf, o0); o1 = MFMA32(v1, pf, o1);
                }
        }
    };
    for (int j = t_hi - 1; j >= t_lo; j -= 2) {
        ATT_LOAD(j - 2, A);
        compute(j, 0);
        if (MODE == 2) { const int vote = (j <= qc) ? (int)__all(ub + fq - Fs[0] < m_run - 40.f) : 0; if (lane == 0) wv[wid] = vote; }
        ATT_STORE(1, B);
        __syncthreads();
        if (MODE == 2) { int all = 1;
#pragma unroll
            for (int w = 0; w < 8; ++w) all &= wv[w];
            if (all) break; }
        ATT_LOAD(j - 3, B);
        compute(j - 1, 1);
        if (MODE == 2) { const int vote = (j - 1 <= qc) ? (int)__all(ub + fq - Fs[64] < m_run - 40.f) : 0; if (lane == 0) wv[8 + wid] = vote; }
        ATT_STORE(0, A);
        __syncthreads();
        if (MODE == 2) { int all = 1;
#pragma unroll
            for (int w = 0; w < 8; ++w) all &= wv[8 + w];
            if (all) break; }
    }
    const float l_tot = l_run + __shfl_xor(l_run, 32);
    const float inv = 1.0f / l_tot;
    bf16_t* dst = BR + (tok0 + qw + r) * 1024 + (MODE == 0 ? 0 : (MODE == 1 ? 256 : 512)) + h * 64 + 4 * hh;
#pragma unroll
    for (int g = 0; g < 4; ++g) {
        u32x2 w0, w1;
        w0.x = pk2(o0[4 * g] * inv, o0[4 * g + 1] * inv); w0.y = pk2(o0[4 * g + 2] * inv, o0[4 * g + 3] * inv);
        w1.x = pk2(o1[4 * g] * inv, o1[4 * g + 1] * inv); w1.y = pk2(o1[4 * g + 2] * inv, o1[4 * g + 3] * inv);
        *(u32x2*)(dst + 8 * g) = w0; *(u32x2*)(dst + 32 + 8 * g) = w1;
    }
#undef ATT_LOAD
#undef ATT_STORE
}
}

__device__ __forceinline__ void transpose_item(const float* W, int N, int nblk, bf16_t* WT, int ldt, LAS float* scr, int item, int lane, const float* gk = nullptr) {
    const int kb = item / nblk, nb = item % nblk, k0 = 64 * kb, n0 = 32 * nb;
    const int nn = n0 + (lane & 31); const bool ok = nn < N;
    float tmp[32];
#pragma unroll
    for (int i = 0; i < 32; ++i) { const int kk = 2 * i + (lane >> 5); tmp[i] = ok ? W[(size_t)(k0 + kk) * N + nn] : 0.f; }
#pragma unroll
    for (int i = 0; i < 32; ++i) { const int kk = 2 * i + (lane >> 5); scr[kk * 33 + (lane & 31)] = tmp[i]; }
    LDS_WAIT(); asm volatile("" ::: "memory");
    const int c = lane & 7;
    f32x4 ga = {1.f, 1.f, 1.f, 1.f}, gb = ga;
    if (gk) { ga = *(const f32x4*)(gk + k0 + 8 * c); gb = *(const f32x4*)(gk + k0 + 8 * c + 4); }
#pragma unroll
    for (int j = 0; j < 4; ++j) { const int n = (lane >> 3) + 8 * j; const LAS float* s = scr + (8 * c) * 33 + n;
        u32x4 o; o.x = pk2(s[0 * 33] * ga.x, s[1 * 33] * ga.y); o.y = pk2(s[2 * 33] * ga.z, s[3 * 33] * ga.w); o.z = pk2(s[4 * 33] * gb.x, s[5 * 33] * gb.y); o.w = pk2(s[6 * 33] * gb.z, s[7 * 33] * gb.w);
        *(u32x4*)(WT + (size_t)(n0 + n) * ldt + k0 + 8 * c) = o; }
    LDS_WAIT(); asm volatile("" ::: "memory");
}
__device__ __forceinline__ void prenorm_row(const float* xrow, bf16_t* orow, float* rowss, int lane) {
    const f32x4* xr = (const f32x4*)xrow + lane;
    f32x4 v[4]; float s = 0.f;
#pragma unroll
    for (int j = 0; j < 4; ++j) { v[j] = xr[64 * j]; s += (v[j].x * v[j].x + v[j].y * v[j].y) + (v[j].z * v[j].z + v[j].w * v[j].w); }
    s = wave_sum(s); if (lane < 16) rowss[lane] = (lane == 0) ? s : 0.f;
#pragma unroll
    for (int j = 0; j < 4; ++j) { u32x2 w; w.x = pk2(v[j].x, v[j].y); w.y = pk2(v[j].z, v[j].w); ((u32x2*)orow)[lane + 64 * j] = w; }
}
__device__ __forceinline__ float logsig(float z) { return fminf(z, 0.f) - __logf(1.0f + __expf(-fabsf(z))); }


constexpr int I_G = 16 * 128, I_B = 4 * 32, I_O = 16 * 32, I_U = 16 * 128, I_D = 64 * 32, N_LATE_ITEMS = I_G + 4 * I_B + I_O + I_U + I_D;
__device__ __forceinline__ void late_weight_item(int l, int r, LAS float* scr, int lane) {
    const cargs_t ap = get_args(); unsigned char* const ws = ap->ws;
    if (r < I_G) { transpose_item(ap->w_gate + (size_t)l * 1024 * 4096, 4096, 128, (bf16_t*)(ws + WS_WGT), 1024, scr, r, lane, ap->g_mix + l * 1024); return; } r -= I_G;
    if (r < 4 * I_B) { const int n = r / I_B; transpose_item(ap->w_branch + (size_t)l * 4 * 256 * 1024 + (size_t)n * 256 * 1024, 1024, 32, (bf16_t*)(ws + WS_WBT) + (size_t)n * 1024 * 1024 + n * 256, 1024, scr, r % I_B, lane); return; } r -= 4 * I_B;
    if (r < I_O) { transpose_item(ap->w_o + (size_t)l * 1024 * 1024, 1024, 32, (bf16_t*)(ws + WS_WOT), 1024, scr, r, lane); return; } r -= I_O;
    if (r < I_U) { transpose_item(ap->w_up + (size_t)l * 1024 * 4096, 4096, 128, (bf16_t*)(ws + WS_W1T), 1024, scr, r, lane, ap->g_ffn + l * 1024); return; } r -= I_U;
    transpose_item(ap->w_down + (size_t)l * 4096 * 1024, 1024, 32, (bf16_t*)(ws + WS_W2T), 4096, scr, r, lane);
}
__device__ __forceinline__ void conv_tokens(int l, int t0, int lane) {
    const cargs_t ap = get_args(); unsigned char* const ws = ap->ws;
    const bf16_t* U = (const bf16_t*)(ws + WS_U); bf16_t* BR = (bf16_t*)(ws + WS_BR);
    const float* wdw = ap->w_dw + (size_t)l * 31 * 256; const f32x4 bdw = *(const f32x4*)(ap->b_dw + l * 256 + 4 * lane);
    const f32x4 gln = *(const f32x4*)(ap->g_conv_ln + l * 256 + 4 * lane), bln = *(const f32x4*)(ap->b_conv_ln + l * 256 + 4 * lane);
    const int ts0 = t0 & (SEQ - 1);
    const float* wl = wdw + 4 * lane; asm volatile("" : "+v"(wl));
    u32x2 ur[38];
#pragma unroll
    for (int i = 0; i < 38; ++i) { const int tt = ts0 - 30 + i; ur[i] = (u32x2){0u, 0u}; if (tt >= 0) ur[i] = *(const u32x2*)(U + (size_t)(t0 - 30 + i) * 256 + 4 * lane); }
    f32x4 acc[8];
#pragma unroll
    for (int j = 0; j < 8; ++j) acc[j] = bdw;
#pragma unroll
    for (int k = 0; k < 31; ++k) { const f32x4 w = *(const f32x4*)(wl + k * 256);
#pragma unroll
        for (int j = 0; j < 8; ++j) { const u32x2 u = ur[j + k];
            acc[j].x = fmaf(lo_f(u.x), w.x, acc[j].x); acc[j].y = fmaf(hi_f(u.x), w.y, acc[j].y); acc[j].z = fmaf(lo_f(u.y), w.z, acc[j].z); acc[j].w = fmaf(hi_f(u.y), w.w, acc[j].w); } }
#pragma unroll
    for (int j = 0; j < 8; ++j) {
        const float mean = wave_sum((acc[j].x + acc[j].y) + (acc[j].z + acc[j].w)) * (1.0f / 256.0f);
        const f32x4 d = acc[j] - mean;
        const float rstd = 1.0f / sqrtf(wave_sum((d.x * d.x + d.y * d.y) + (d.z * d.z + d.w * d.w)) * (1.0f / 256.0f) + EPS);
        const f32x4 y = d * rstd * gln + bln;
        u32x2 o; o.x = pk2(y.x * sigmoidf_(y.x), y.y * sigmoidf_(y.y)); o.y = pk2(y.z * sigmoidf_(y.z), y.w * sigmoidf_(y.w));
        *(u32x2*)(BR + (size_t)(t0 + j) * 1024 + 768 + 4 * lane) = o;
    }
}

__device__ __forceinline__ void win_item(int l, int r, LAS float* scr, int lane) {
    const cargs_t ap = get_args();
    transpose_item(ap->w_in + (size_t)l * 1024 * INC, INC, 80, (bf16_t*)(ap->ws + (l == 0 ? WS_WINT : WS_WINT1)), 1024, scr, r, lane, ap->g_mix + l * 1024);
}
__device__ __forceinline__ void wlat_chunk(int l, int c) {
    const cargs_t ap = get_args();
    const float* w_uq = ap->w_uq + (size_t)l * 256 * 384; const float* w_ukv = ap->w_ukv + (size_t)l * 128 * 512; const float* gq = ap->g_q_lat + l * 256; const float* gkv = ap->g_kv_lat + l * 128;
    const int n = c / 48, k0 = (c % 48) * 8; float v[8];
#pragma unroll
    for (int e = 0; e < 8; ++e) { const int k = k0 + e; v[e] = (n < 384 && k < 256) ? gq[k] * w_uq[(size_t)k * 384 + n] : ((n >= 512 && k >= 256) ? gkv[k - 256] * w_ukv[(size_t)(k - 256) * 512 + (n - 512)] : 0.f); }
    u32x4 o; o.x = pk2(v[0], v[1]); o.y = pk2(v[2], v[3]); o.z = pk2(v[4], v[5]); o.w = pk2(v[6], v[7]);
    *(u32x4*)((bf16_t*)(ap->ws + (l == 0 ? WS_WLT : WS_WLT1)) + (size_t)n * 384 + k0) = o;
}

#define XB_TMO      128
#define XB_XCNT(j)  (256  + 64 * (j))
#define XB_XSUB(j)  (1280 + 64 * (j))
#define XB_XGEN(j)  (2304 + 64 * (j))
#define XB_TOP      3328
#define XB_TOPGEN   3392
#define XCD_BAR_WORDS 3456
#define XB_SPIN_CAP (1u << 18)
__device__ __forceinline__ unsigned xb_ld(unsigned* p)              { return __hip_atomic_load(p, __ATOMIC_RELAXED, __HIP_MEMORY_SCOPE_AGENT); }
__device__ __forceinline__ unsigned xb_add(unsigned* p, unsigned v) { return __hip_atomic_fetch_add(p, v, __ATOMIC_RELAXED, __HIP_MEMORY_SCOPE_AGENT); }
__device__ __forceinline__ unsigned xb_xcc_id() { return (unsigned)__builtin_amdgcn_s_getreg((3 << 11) | 20) & 0xFu; }
#define XB_SPIN(cond, bar) do { unsigned _sp = 0; while (cond) { __builtin_amdgcn_s_sleep(1); \
    if ((++_sp & 255u) == 0u) { if (xb_ld(&(bar)[XB_TMO])) break; if (_sp > XB_SPIN_CAP) { atomicAdd(&(bar)[XB_TMO], 1u); break; } } } } while (0)
struct XcdBarrier { unsigned* bar; unsigned x; volatile LAS unsigned* st; };
__device__ __forceinline__ void xcd_barrier_complete(unsigned* bar, unsigned x, unsigned& nloc, unsigned& nx) {
    const unsigned G = gridDim.x * gridDim.y * gridDim.z;
    unsigned sum, cnt, mine, sp = 0u;
    for (;;) {
        sum = 0u; cnt = 0u; mine = 0u;
#pragma unroll
        for (unsigned j = 0; j < 16; ++j) { const unsigned c = xb_ld(&bar[XB_XCNT(j)]); sum += c; cnt += (c > 0u) ? 1u : 0u; mine = (j == x) ? c : mine; }
        if (sum == G) break;
        __builtin_amdgcn_s_sleep(1);
        if ((++sp & 255u) == 0u) { if (xb_ld(&bar[XB_TMO])) break; if (sp > XB_SPIN_CAP) { atomicAdd(&bar[XB_TMO], 1u); break; } }
    }
    nloc = mine > 0u ? mine : 1u; nx = cnt > 0u ? cnt : 1u;
}
__device__ __forceinline__ void xcd_barrier(const XcdBarrier& b) {
    asm volatile("s_waitcnt vmcnt(0)" ::: "memory");
    __syncthreads();
    if (threadIdx.x == 0) {
        unsigned* bar = b.bar;
        __builtin_amdgcn_s_waitcnt(0);
        unsigned nloc = b.st[0], nx = b.st[1];
        if (nloc == 0u) { xcd_barrier_complete(bar, b.x, nloc, nx); b.st[0] = nloc; b.st[1] = nx; }
        const unsigned old = xb_add(&bar[XB_XSUB(b.x)], 1u);
        const unsigned gen = old / nloc;
        if (old + 1u == (gen + 1u) * nloc) {
            __builtin_amdgcn_fence(__ATOMIC_RELEASE, "agent");
            asm volatile("s_waitcnt vmcnt(0)" ::: "memory");
            const unsigned og = xb_add(&bar[XB_TOP], 1u);
            const unsigned tg = og / nx;
            if (og + 1u == (tg + 1u) * nx) xb_add(&bar[XB_TOPGEN], 1u);
            else XB_SPIN(xb_ld(&bar[XB_TOPGEN]) == tg, bar);
            __builtin_amdgcn_fence(__ATOMIC_ACQUIRE, "agent");
            xb_add(&bar[XB_XGEN(b.x)], 1u);
            asm volatile("s_waitcnt vmcnt(0)" ::: "memory");
        } else {
            XB_SPIN(xb_ld(&bar[XB_XGEN(b.x)]) == gen, bar);
            __builtin_amdgcn_fence(__ATOMIC_ACQUIRE, "agent");
            asm volatile("s_waitcnt vmcnt(0)" ::: "memory");
        }
    }
    __syncthreads();
}
constexpr int CTL_BAR_WORD = 4096;
constexpr int LDS_MISC = 131072 + 128;
#define GRID_BAR() do { const cargs_t ap_ = get_args(); XcdBarrier b_; b_.bar = (unsigned*)(ap_->ws + WS_CTL) + CTL_BAR_WORD; b_.x = xb_xcc_id(); \
    b_.st = (volatile LAS unsigned*)(lds + LDS_MISC); xcd_barrier(b_); } while (0)

#define WSP(T, off) ((T*)(ws + (off)))
#define REP_P1 1
#define REP_P2 1
#define REP_P3 1
#define REP_P4 1
#define REP_P5 1
#define REP_P6 1
#define REP_P7 1
#define REP_P8 1
#define REP_P9 1
#define REP_P10 1
#define REP_SYNC 0
#define PHASE_BEGIN(R) _Pragma("unroll 1") for (int rep = 0; rep < (R); ++rep) {
#define PHASE_END GRID_BAR(); }
__global__ void __launch_bounds__(512, 2) fwd_megakernel(Args A_unused) {
    extern __shared__ __attribute__((aligned(16))) unsigned char lds_raw[];
    LAS unsigned char* lds = (LAS unsigned char*)lds_raw;
    {
        if (threadIdx.x < 8) ((LAS unsigned*)(lds + LDS_MISC))[threadIdx.x] = 0u;
        __syncthreads();
        const cargs_t ap = get_args();
        if (threadIdx.x == 0) (void)xb_add((unsigned*)(ap->ws + WS_CTL) + CTL_BAR_WORD + XB_XCNT(xb_xcc_id()), 1u);
    }
    cg::this_grid().sync();

#pragma unroll 1
    for (int l = 0; l < 2; ++l) {
        if (l == 0) {
        PHASE_BEGIN(REP_P1)
            const cargs_t ap = get_args(); unsigned char* const ws = ap->ws;
            const int tid = fresh_tid(), lane = tid & 63, wid = __builtin_amdgcn_readfirstlane(tid >> 6), G = gridDim.x, bx = blockIdx.x, gw = bx * 8 + wid, NGW = G * 8;
            LAS float* scr = (LAS float*)(lds + wid * 16384);
            for (int it = gw; it < 1280; it += NGW) win_item(0, it, scr, lane);
            for (int c = bx * 512 + tid; c < 1024 * 48; c += G * 512) wlat_chunk(0, c);
            const float* xin = ap->x; bf16_t* XN = WSP(bf16_t, WS_XN); float* rss = WSP(float, WS_ROWSS);
            for (int m = gw; m < TOK; m += NGW) prenorm_row(xin + (size_t)m * 1024, XN + (size_t)m * 1024, rss + (size_t)m * 16, lane);
        GRID_BAR(); }
        }
        PHASE_BEGIN(REP_P2)
            const cargs_t ap = get_args(); unsigned char* const ws = ap->ws;
            const char* hin = (l == 0) ? WSP(const char, WS_XN) : (const char*)ap->out;
            pg8::PlainOrder S{hin, (l == 0) ? WSP(const char, WS_WINT) : WSP(const char, WS_WINT1), 1024, 1024, 64, 10, 16, (int)gridDim.x, (int)blockIdx.x};
            const float* slots = WSP(const float, WS_ROWSS) + (size_t)(l * 2) * ROWSS_STRIDE;
            pg8::Unit u0; int pm0 = -1; if (S.next(0, u0)) { pm0 = u0.pm; fill_rinv_table(lds, slots, pm0); }
            pg8::EpiBf16<0, 1, true> E{WSP(bf16_t, WS_PROJ), PLD, slots, pm0, (unsigned)(uintptr_t)(lds + LDS_RINV), WSP(float, WS_LATSS)};
            pg8::gemm_phase(lds, 1024, 1024, S, E);
        PHASE_END
        PHASE_BEGIN(REP_P3)
            const cargs_t ap = get_args(); unsigned char* const ws = ap->ws;
            const int tid = fresh_tid(), lane = tid & 63, wid = __builtin_amdgcn_readfirstlane(tid >> 6), G = gridDim.x, bx = blockIdx.x, gw = bx * 8 + wid, NGW = G * 8;
            const bf16_t* PROJ = WSP(const bf16_t, WS_PROJ);
            if (bx < 16) {
                const int b = bx >> 2, h = bx & 3; const float bf = ap->b_forget[l * 4 + h];
                const bf16_t* src = PROJ + ((size_t)b * SEQ + tid * 8) * PLD + C_CF + h;
                float v[8];
#pragma unroll
                for (int i = 0; i < 8; ++i) v[i] = bf2f(src[(size_t)i * PLD]);
#pragma unroll
                for (int i = 0; i < 8; ++i) { v[i] = logsig(v[i] + bf); if (i) v[i] += v[i - 1]; }
                float incl = v[7];
#pragma unroll
                for (int o = 1; o < 64; o <<= 1) { const float u = __shfl_up(incl, o); if (lane >= o) incl += u; }
                LAS float* wtot = (LAS float*)(lds + 131072 + 64);
                if (lane == 63) wtot[wid] = incl;
                __syncthreads();
                float off = incl - v[7];
                for (int w = 0; w < wid; ++w) off += wtot[w];
                float* dst = WSP(float, WS_FCUM) + (size_t)(b * 4 + h) * SEQ + tid * 8;
                f32x4 o0 = {v[0] + off, v[1] + off, v[2] + off, v[3] + off}, o1 = {v[4] + off, v[5] + off, v[6] + off, v[7] + off};
                *(f32x4*)dst = o0; *(f32x4*)(dst + 4) = o1;
            }
            const int* posp = ap->pos;
            bf16_t* KROT = WSP(bf16_t, WS_KROT); bf16_t* U = WSP(bf16_t, WS_U);
            const float invf = exp2f(-(float)(lane & 15) * 0.8304820237218406f);
            const bool kx = (gridDim.x == 256); unsigned* KMAXp = (unsigned*)(ws + WS_CTL) + 1024; LAS float* kred = (LAS float*)(lds + 131072 + 512); int kiter = 0;
            if (!kx && bx == 0 && tid < 16) atomicMax(KMAXp + tid, 0x7f7fffffu);
            for (int t0 = gw * 4; t0 < TOK; t0 += NGW * 4) {
                u32x2 dv4[4], dg4[4], ck4[4]; float x14[4], x24[4], pos4[4];
#pragma unroll
                for (int j = 0; j < 4; ++j) { const bf16_t* row = PROJ + (size_t)(t0 + j) * PLD;
                    dv4[j] = *(const u32x2*)(row + C_DV + 4 * lane); dg4[j] = *(const u32x2*)(row + C_DG + 4 * lane); ck4[j] = *(const u32x2*)(row + C_CK + 4 * lane);
                    x14[j] = bf2f(row[C_BKR + (lane & 15)]); x24[j] = bf2f(row[C_BKR + 16 + (lane & 15)]); pos4[j] = (float)posp[t0 + j]; }
#pragma unroll
                for (int j = 0; j < 4; ++j) { const int t = t0 + j;
                    if (lane < 16) {
                        const float ang = pos4[j] * invf, kk = rintf(ang * 0.15915494309189535f);
                        float rem = fmaf(-kk, 6.2831854820251465f, ang); rem = fmaf(kk, 1.7484555e-7f, rem);
                        const float sn = __sinf(rem), cn = __cosf(rem);
                        const unsigned w = pk2(x14[j] * cn - x24[j] * sn, x24[j] * cn + x14[j] * sn);
                        KROT[(size_t)t * 32 + lane] = (bf16_t)(w & 0xffffu); KROT[(size_t)t * 32 + 16 + lane] = (bf16_t)(w >> 16);
                    }
                    {
                        const u32x2 v = dv4[j], gt = dg4[j];
                        u32x2 o; o.x = pk2(lo_f(v.x) * sigmoidf_(lo_f(gt.x)), hi_f(v.x) * sigmoidf_(hi_f(gt.x))); o.y = pk2(lo_f(v.y) * sigmoidf_(lo_f(gt.y)), hi_f(v.y) * sigmoidf_(hi_f(gt.y)));
                        *(u32x2*)(U + (size_t)t * 256 + 4 * lane) = o;
                    }
                }
                if (kx) {
                    float km = 0.f;
#pragma unroll
                    for (int j = 0; j < 4; ++j) { const float a0 = lo_f(ck4[j].x), a1 = hi_f(ck4[j].x), a2 = lo_f(ck4[j].y), a3 = hi_f(ck4[j].y); float q = (a0 * a0 + a1 * a1) + (a2 * a2 + a3 * a3);
                        q += __shfl_xor(q, 1); q += __shfl_xor(q, 2); q += __shfl_xor(q, 4); q += __shfl_xor(q, 8); km = fmaxf(km, q); }
                    const int par = kiter & 1; ++kiter;
                    if ((lane & 15) == 0) kred[par * 32 + wid * 4 + (lane >> 4)] = km;
                    __syncthreads();
                    if (tid < 4) { float m = kred[par * 32 + tid];
#pragma unroll
                        for (int w = 1; w < 8; ++w) m = fmaxf(m, kred[par * 32 + w * 4 + tid]);
                        atomicMax(KMAXp + (t0 >> 12) * 4 + tid, __float_as_uint(m)); }
                }
            }
            { const cargs_t ap2 = get_args(); unsigned char* const ws = ap2->ws;
              pg8::PlainOrder S{WSP(const char, WS_PROJ) + C_BQL * 2, (l == 0) ? WSP(const char, WS_WLT) : WSP(const char, WS_WLT1), PLD, 384, 64, 4, 6, (int)gridDim.x, (int)blockIdx.x};
              pg8::EpiBf16<0, 2> E{WSP(bf16_t, WS_QKVB), 1024, nullptr, -1, 0u, WSP(float, WS_LATSS)};
              pg8::gemm_phase(lds, PLD, 384, S, E); }
        PHASE_END
        PHASE_BEGIN(REP_P5)
            LAS int* wq = (LAS int*)(lds + 131072);
            for (;;) {
                __syncthreads();
                if (threadIdx.x == 0) { const cargs_t ap = get_args(); wq[0] = atomicAdd((int*)(ap->ws + WS_CTL) + 16 * (l * 8 + rep), 1); }
                __syncthreads();
                const int it = wq[0];
                if (it >= 768 + 256 + N_LATE_ITEMS / 16 + (l == 0 ? 80 + 96 : 0)) break;
                if (it >= 768) {
                    const int tidq = fresh_tid(), laneq = tidq & 63, widq = __builtin_amdgcn_readfirstlane(tidq >> 6);
                    if (it < 1024) conv_tokens(l, ((it - 768) * 8 + widq) * 8, laneq);
                    else if (it >= 1024 + N_LATE_ITEMS / 16) {
                        const int e = it - (1024 + N_LATE_ITEMS / 16);
                        if (e < 80) { LAS float* scr = (LAS float*)(lds + widq * 16384); win_item(l + 1, e * 16 + widq * 2, scr, laneq); win_item(l + 1, e * 16 + widq * 2 + 1, scr, laneq); }
                        else wlat_chunk(l + 1, (e - 80) * 512 + tidq);
                    }
                    else { LAS float* scr = (LAS float*)(lds + widq * 16384); const int r0 = (it - 1024) * 16 + widq * 2; late_weight_item(l, r0, scr, laneq); late_weight_item(l, r0 + 1, scr, laneq); }
                    continue;
                }
                int mode, bh, qb;
                if (it >= 384 && it < 640) { const int a = it - 384; mode = 0; bh = a & 15; qb = a >> 4; }
                else { const int k = it < 384 ? it : it - 256; const int lvl = k >> 5, w = k & 31; qb = 15 - lvl; mode = (w < 16) ? 1 : 2; bh = w & 15; }
                if (mode == 0) att::unit<0>(l, bh >> 2, bh & 3, qb, lds);
                else if (mode == 1) att::unit<1>(l, bh >> 2, bh & 3, qb, lds);
                else att::unit<2>(l, bh >> 2, bh & 3, qb, lds);
            }
        PHASE_END
        PHASE_BEGIN(REP_P6)
            const cargs_t ap = get_args(); unsigned char* const ws = ap->ws;
            const char* hin = (l == 0) ? WSP(const char, WS_XN) : (const char*)ap->out;
            pg8::GateBranchOrder S{hin, WSP(const char, WS_BR), WSP(const char, WS_WGT), WSP(const char, WS_WBT), (int)gridDim.x, (int)blockIdx.x};
            const float* slots = WSP(const float, WS_ROWSS) + (size_t)(l * 2) * ROWSS_STRIDE; const float* bg = ap->b_gate + (size_t)l * 4096;
            pg8::Unit u0; int pm0 = -1, pd0 = -1;
            if (S.next(0, u0)) { pm0 = u0.pm; pd0 = u0.pn & 3; const int t = fresh_tid();
                ((LAS float*)(lds + LDS_BIAS))[t] = bg[(t >> 8) * 1024 + pd0 * 256 + (t & 255)]; ((LAS float*)(lds + LDS_BIAS))[t + 512] = bg[((t + 512) >> 8) * 1024 + pd0 * 256 + (t & 255)];
                fill_rinv_table(lds, slots, pm0); }
            pg8::EpiGateBranch E{WSP(bf16_t, WS_MIXED), bg, slots, (LAS unsigned*)(lds + 131072 + 1024), pm0, pd0, (unsigned)(uintptr_t)(lds + LDS_RINV), (unsigned)(uintptr_t)(lds + LDS_BIAS)};
            pg8::gemm_phase(lds, 1024, 1024, S, E);
        PHASE_END
        PHASE_BEGIN(REP_P7)
            const cargs_t ap = get_args(); unsigned char* const ws = ap->ws;
            pg8::PlainOrder S{WSP(const char, WS_MIXED), WSP(const char, WS_WOT), 1024, 1024, 64, 4, 16, (int)gridDim.x, (int)blockIdx.x};
            if (l == 0) { pg8::EpiRes<true> E{ap->x, WSP(bf16_t, WS_XA), WSP(float, WS_ROWSS) + (size_t)1 * ROWSS_STRIDE};
                pg8::gemm_phase(lds, 1024, 1024, S, E); }
            else { pg8::EpiRes<false> E{ap->out, WSP(bf16_t, WS_XA), WSP(float, WS_ROWSS) + (size_t)3 * ROWSS_STRIDE};
                pg8::gemm_phase(lds, 1024, 1024, S, E); }
        PHASE_END
        PHASE_BEGIN(REP_P9)
            const cargs_t ap = get_args(); unsigned char* const ws = ap->ws;
            pg8::PlainOrder S{WSP(const char, WS_XA), WSP(const char, WS_W1T), 1024, 1024, 64, 16, 16, (int)gridDim.x, (int)blockIdx.x};
            const float* slots = WSP(const float, WS_ROWSS) + (size_t)(l * 2 + 1) * ROWSS_STRIDE;
            pg8::Unit u0; int pm0 = -1; if (S.next(0, u0)) { pm0 = u0.pm; fill_rinv_table(lds, slots, pm0); }
            pg8::EpiBf16<2, 1> E{WSP(bf16_t, WS_H), 4096, slots, pm0, (unsigned)(uintptr_t)(lds + LDS_RINV), nullptr};
            pg8::gemm_phase(lds, 1024, 1024, S, E);
        PHASE_END
        PHASE_BEGIN(REP_P10)
            const cargs_t ap = get_args(); unsigned char* const ws = ap->ws;
            pg8::PlainOrder S{WSP(const char, WS_H), WSP(const char, WS_W2T), 4096, 4096, 64, 4, 64, (int)gridDim.x, (int)blockIdx.x};
            if (l == 0) { pg8::EpiRes<false> E{WSP(const bf16_t, WS_XA), (bf16_t*)ap->out, WSP(float, WS_ROWSS) + (size_t)2 * ROWSS_STRIDE};
                pg8::gemm_phase(lds, 4096, 4096, S, E); }
            else { pg8::EpiFinal E{WSP(const bf16_t, WS_XA), ap->out, WSP(float, WS_ROWSS) + (size_t)4 * ROWSS_STRIDE, ap->g_final, (unsigned*)(ws + WS_CTL) + 8192};
                pg8::gemm_phase(lds, 4096, 4096, S, E); }
        if (l == 0) GRID_BAR(); }
    }
    _Pragma("unroll 1") for (int i = 0; i < REP_SYNC; ++i) GRID_BAR();
}

extern "C" void kernel_launch(void* const* d_in, const int* in_sizes, int n_in, void* d_out, int out_size, void* d_ws, size_t ws_size, hipStream_t stream) {
    static int grid = 0;
    if (grid == 0) {
        if (n_in != 22 || out_size != TOK * DM || ws_size < WS_END) { fprintf(stderr, "kernel_launch: unexpected shapes (n_in %d out %d ws %zu)\n", n_in, out_size, ws_size); grid = -1; return; }
        int dev = 0, cus = 0, per_cu = 0;
        if (hipGetDevice(&dev) != hipSuccess || hipDeviceGetAttribute(&cus, hipDeviceAttributeMultiprocessorCount, dev) != hipSuccess) { grid = -1; return; }
        if (hipFuncSetAttribute((const void*)fwd_megakernel, hipFuncAttributeMaxDynamicSharedMemorySize, LDS_BYTES) != hipSuccess) { fprintf(stderr, "hipFuncSetAttribute failed\n"); grid = -1; return; }
        if (hipOccupancyMaxActiveBlocksPerMultiprocessor(&per_cu, (const void*)fwd_megakernel, 512, LDS_BYTES) != hipSuccess || per_cu < 1) { fprintf(stderr, "occupancy query: %d blocks per CU\n", per_cu); grid = -1; return; }
        grid = cus;
    }
    if (grid < 0) return;
    (void)hipMemsetAsync((char*)d_ws + WS_CTL, 0, 65536, stream);
    Args a{};
    a.x = (const float*)d_in[0]; a.pos = (const int*)d_in[1]; a.g_mix = (const float*)d_in[2]; a.w_in = (const float*)d_in[3]; a.w_gate = (const float*)d_in[4]; a.b_gate = (const float*)d_in[5];
    a.rel_bias = (const float*)d_in[6]; a.g_q_lat = (const float*)d_in[7]; a.w_uq = (const float*)d_in[8]; a.g_kv_lat = (const float*)d_in[9]; a.w_ukv = (const float*)d_in[10];
    a.b_forget = (const float*)d_in[11]; a.w_dw = (const float*)d_in[12]; a.b_dw = (const float*)d_in[13]; a.g_conv_ln = (const float*)d_in[14]; a.b_conv_ln = (const float*)d_in[15];
    a.w_branch = (const float*)d_in[16]; a.w_o = (const float*)d_in[17]; a.g_ffn = (const float*)d_in[18]; a.w_up = (const float*)d_in[19]; a.w_down = (const float*)d_in[20]; a.g_final = (const float*)d_in[21];
    a.out = (float*)d_out; a.ws = (unsigned char*)d_ws;
    void* args[] = {&a};
    hipError_t e = hipLaunchCooperativeKernel((const void*)fwd_megakernel, dim3(grid), dim3(512), args, LDS_BYTES, stream);
    if (e != hipSuccess) fprintf(stderr, "cooperative launch failed: %s (grid %d)\n", hipGetErrorString(e), grid);
}
```
